# Optimizing an MI355X kernel written in HIP

```python
import math
import jax
import jax.numpy as jnp
from jax import lax
import numpy as np

D_MODEL = 1024
BATCH = 8
SEQ = 4096
DEPTH = 4

N_BRANCH = 5
BRANCH_W = D_MODEL // 4
HG_HEADS = 4
HG_DK = BRANCH_W // HG_HEADS
HG_CHUNK = 64
CONF_K = 31
SC_K = 3
AT_HEADS = 4
AT_KV_HEADS = 2
AT_HD = BRANCH_W // AT_HEADS
AT_BLOCK = 128
AT_WINDOW = 128
REL_BUCKETS = 32
REL_MAX_DIST = 128
MEM_LEN = 256
MEM_HEADS = 4
MEM_HD = BRANCH_W // MEM_HEADS
EPS = 1e-6

IN_COLS = (
    BRANCH_W, BRANCH_W, BRANCH_W, BRANCH_W, BRANCH_W,
    BRANCH_W, BRANCH_W, BRANCH_W,
    BRANCH_W, BRANCH_W, BRANCH_W, BRANCH_W,
    BRANCH_W, AT_KV_HEADS * AT_HD, AT_KV_HEADS * AT_HD, BRANCH_W,
    BRANCH_W, BRANCH_W,
)
IN_WIDTH = sum(IN_COLS)

kernel_name = 'hybrid_parallel_gated_encoder'

F32 = jnp.float32


def rmsnorm(x, g):
    xf = x.astype(F32)
    y = xf * lax.rsqrt(jnp.mean(xf * xf, axis=-1, keepdims=True) + EPS) * g.astype(F32)
    return y.astype(x.dtype)


def split_cols(u):
    offs = np.cumsum(IN_COLS)[:-1].tolist()
    return jnp.split(u, offs, axis=-1)


def depthwise_conv(x, w):
    k = w.shape[0]
    return lax.conv_general_dilated(
        x, w[:, None, :].astype(x.dtype), window_strides=(1,),
        padding=[((k - 1) // 2, (k - 1) // 2)],
        dimension_numbers=('NWC', 'WIO', 'NWC'),
        feature_group_count=x.shape[-1])


def gla_scan(q, k, v, log_f):
    B_, S_, H, dk = q.shape
    dv = v.shape[-1]
    nc = S_ // HG_CHUNK

    def chunks(t):
        return t.reshape(B_, nc, HG_CHUNK, H, t.shape[-1]).transpose(1, 0, 3, 2, 4)

    incl = jnp.tril(jnp.ones((HG_CHUNK, HG_CHUNK), bool))[..., None]

    def step(state, blk):
        qc, kc, vc, gc = blk
        a = jnp.cumsum(gc, axis=2)
        diff = a[:, :, :, None, :] - a[:, :, None, :, :]
        decay = jnp.exp(jnp.where(incl, diff, -jnp.inf))
        scores = jnp.einsum('bhtk,bhsk,bhtsk->bhts', qc, kc, decay)
        o = (jnp.einsum('bhts,bhsv->bhtv', scores, vc)
             + jnp.einsum('bhtk,bhkv->bhtv', qc * jnp.exp(a), state))
        a_end = a[:, :, -1:, :]
        state = (state * jnp.exp(a_end[:, :, 0, :, None])
                 + jnp.einsum('bhsk,bhsv->bhkv', kc * jnp.exp(a_end - a), vc))
        return state, o

    init = jnp.zeros((B_, H, dk, dv), F32)
    _, oc = lax.scan(step, init, (chunks(q), chunks(k), chunks(v), chunks(log_f)))
    return oc.transpose(1, 0, 3, 2, 4).reshape(B_, S_, H, dv)


def hgrn2_branch(q, f_fwd, f_bwd, i, z, lb, onorm):
    B_, S_, _ = q.shape

    def heads(t):
        return t.astype(F32).reshape(B_, S_, HG_HEADS, HG_DK)

    qh, ih = heads(q), heads(i)

    def direction(f_logit, lb_d):
        f = lb_d + (1.0 - lb_d) * jax.nn.sigmoid(f_logit.astype(F32))
        return heads(1.0 - f), heads(jnp.log(f))

    k_f, g_f = direction(f_fwd, lb[0])
    k_b, g_b = direction(f_bwd, lb[1])
    o_fwd = gla_scan(qh, k_f, ih, g_f)
    rev = lambda t: jnp.flip(t, axis=1)
    o_bwd = rev(gla_scan(rev(qh), rev(k_b), rev(ih), rev(g_b)))
    o = rmsnorm(o_fwd + o_bwd, onorm).reshape(B_, S_, BRANCH_W).astype(q.dtype)
    return o * jax.nn.silu(z)


def conformer_branch(a, b, z, w_dw, b_dw, ln_g, ln_b):
    u = a * jax.nn.sigmoid(b)
    c = (depthwise_conv(u, w_dw) + b_dw.astype(u.dtype)).astype(F32)
    mu = jnp.mean(c, axis=-1, keepdims=True)
    var = jnp.mean(jnp.square(c - mu), axis=-1, keepdims=True)
    n = (c - mu) * lax.rsqrt(var + EPS) * ln_g.astype(F32) + ln_b.astype(F32)
    return jax.nn.silu(n).astype(a.dtype) * jax.nn.silu(z)


def short_conv_branch(b, c, v, z, w):
    return b * depthwise_conv(c * v, w) * jax.nn.silu(z)


def t5_bucket(rel):
    half = REL_BUCKETS // 2
    n = -rel
    ret = jnp.where(n < 0, half, 0)
    n = jnp.abs(n)
    max_exact = half // 2
    large = max_exact + (jnp.log(jnp.maximum(n, 1).astype(F32) / max_exact)
                         / math.log(REL_MAX_DIST / max_exact)
                         * (half - max_exact)).astype(jnp.int32)
    large = jnp.minimum(large, half - 1)
    return ret + jnp.where(n < max_exact, n, large)


def banded_position_bias(rel_bias):
    qi = jnp.arange(AT_BLOCK)[:, None]
    sj = jnp.arange(3 * AT_BLOCK)[None, :]
    rel = (sj - AT_BLOCK) - qi
    return jnp.transpose(rel_bias[t5_bucket(rel)], (2, 0, 1)).astype(F32)


def window_attention(q, k, v, sink, pos_bias):
    B_, S_, _ = q.shape
    nb = S_ // AT_BLOCK
    G = AT_HEADS // AT_KV_HEADS
    qb = q.reshape(B_, nb, AT_BLOCK, AT_KV_HEADS, G, AT_HD)

    def band(t):
        tp = jnp.pad(t.reshape(B_, S_, AT_KV_HEADS, AT_HD),
                     ((0, 0), (AT_BLOCK, AT_BLOCK), (0, 0), (0, 0)))
        tp = tp.reshape(B_, nb + 2, AT_BLOCK, AT_KV_HEADS, AT_HD)
        return jnp.concatenate([tp[:, :-2], tp[:, 1:-1], tp[:, 2:]], axis=2)

    kb, vb = band(k), band(v)
    logits = jnp.einsum('bnqkgd,bnskd->bnkgqs', qb, kb).astype(F32) * AT_HD ** -0.5
    logits = logits + pos_bias.reshape(AT_KV_HEADS, G, AT_BLOCK, 3 * AT_BLOCK)
    qi = jnp.arange(AT_BLOCK)[None, :, None]
    sj = jnp.arange(3 * AT_BLOCK)[None, None, :]
    blk = jnp.arange(nb)[:, None, None]
    qpos = blk * AT_BLOCK + qi
    kpos = (blk - 1) * AT_BLOCK + sj
    valid = (jnp.abs(kpos - qpos) <= AT_WINDOW) & (kpos >= 0) & (kpos < S_)
    logits = jnp.where(valid[None, :, None, None], logits, -jnp.inf)
    sink_col = jnp.broadcast_to(sink.astype(F32).reshape(1, 1, AT_KV_HEADS, G, 1, 1),
                                logits.shape[:-1] + (1,))
    p = jax.nn.softmax(jnp.concatenate([logits, sink_col], axis=-1), axis=-1)[..., :-1]
    o = jnp.einsum('bnkgqs,bnskd->bnqkgd', p.astype(v.dtype), vb)
    return o.reshape(B_, S_, BRANCH_W)


def memory_cross_attention(q, mem_kv):
    B_, S_, _ = q.shape
    M = mem_kv.shape[1]
    k, v = jnp.split(mem_kv, 2, axis=-1)
    qh = q.reshape(B_, S_, MEM_HEADS, MEM_HD)
    kh = k.reshape(B_, M, MEM_HEADS, MEM_HD)
    vh = v.reshape(B_, M, MEM_HEADS, MEM_HD)
    logits = jnp.einsum('bshd,bmhd->bhsm', qh, kh).astype(F32) * MEM_HD ** -0.5
    p = jax.nn.softmax(logits, axis=-1).astype(v.dtype)
    return jnp.einsum('bhsm,bmhd->bshd', p, vh).reshape(B_, S_, BRANCH_W)


def setup_inputs(seed: int = 0) -> dict:
    key = jax.random.key(seed)
    ks = jax.random.split(key, 20)

    def nrm(k, shape, scale):
        return jax.random.normal(k, shape, F32) * scale

    W = BRANCH_W
    return {
        'x': nrm(ks[0], (BATCH, SEQ, D_MODEL), 1.0),
        'mem': nrm(ks[1], (BATCH, MEM_LEN, D_MODEL), 1.0),
        'norm_pre': 1.0 + nrm(ks[2], (DEPTH, D_MODEL), 0.05),
        'norm_post': 1.0 + nrm(ks[3], (DEPTH, D_MODEL), 0.05),
        'w_in': nrm(ks[4], (DEPTH, D_MODEL, IN_WIDTH), D_MODEL ** -0.5),
        'hg_lb_logits': nrm(ks[5], (DEPTH, 2, W), 0.1),
        'hg_onorm': 1.0 + nrm(ks[6], (DEPTH, HG_DK), 0.05),
        'conf_dw_w': nrm(ks[7], (DEPTH, CONF_K, W), CONF_K ** -0.5),
        'conf_dw_b': nrm(ks[8], (DEPTH, W), 0.02),
        'conf_ln_g': 1.0 + nrm(ks[9], (DEPTH, W), 0.05),
        'conf_ln_b': nrm(ks[10], (DEPTH, W), 0.02),
        'sc_w': nrm(ks[11], (DEPTH, SC_K, W), SC_K ** -0.5),
        'attn_sink': nrm(ks[12], (DEPTH, AT_HEADS), 0.5),
        'rel_bias': nrm(ks[13], (REL_BUCKETS, AT_HEADS), 0.5),
        'mem_norm': 1.0 + nrm(ks[14], (DEPTH, D_MODEL), 0.05),
        'w_mem_kv': nrm(ks[15], (DEPTH, D_MODEL, 2 * BRANCH_W), D_MODEL ** -0.5),
        'w_gate': nrm(ks[16], (DEPTH, N_BRANCH, D_MODEL, D_MODEL), D_MODEL ** -0.5),
        'w_branch': nrm(ks[17], (DEPTH, N_BRANCH, W, D_MODEL), W ** -0.5),
        'w_out': nrm(ks[18], (DEPTH, D_MODEL, D_MODEL), D_MODEL ** -0.5),
    }


def reference(x, mem, norm_pre, norm_post, w_in, hg_lb_logits, hg_onorm, conf_dw_w, conf_dw_b,
              conf_ln_g, conf_ln_b, sc_w, attn_sink, rel_bias, mem_norm, w_mem_kv, w_gate,
              w_branch, w_out):
    lb_soft = jax.nn.softmax(hg_lb_logits.astype(F32), axis=0)
    lower_bounds = jnp.cumsum(lb_soft, axis=0) - lb_soft[0]
    pos_bias = banded_position_bias(rel_bias)
    for l in range(DEPTH):
        h = rmsnorm(x, norm_pre[l])
        (hq, hf_f, hf_b, hi, hz, ca, cb, cz, sb, sc, sv, sz,
         aq, ak, av, az, mq, mz) = split_cols(h @ w_in[l])
        y_hg = hgrn2_branch(hq, hf_f, hf_b, hi, hz, lower_bounds[l], hg_onorm[l])
        y_cf = conformer_branch(ca, cb, cz, conf_dw_w[l], conf_dw_b[l], conf_ln_g[l], conf_ln_b[l])
        y_sc = short_conv_branch(sb, sc, sv, sz, sc_w[l])
        y_at = window_attention(aq, ak, av, attn_sink[l], pos_bias) * jax.nn.silu(az)
        mem_kv = rmsnorm(mem, mem_norm[l]) @ w_mem_kv[l]
        y_mem = memory_cross_attention(mq, mem_kv) * jax.nn.silu(mz)
        merged = None
        for n, yb in enumerate((y_hg, y_cf, y_sc, y_at, y_mem)):
            term = jax.nn.sigmoid(h @ w_gate[l, n]) * (yb @ w_branch[l, n])
            merged = term if merged is None else merged + term
        x = x + rmsnorm(merged @ w_out[l], norm_post[l])
    return x
```

```cpp
#include <hip/hip_runtime.h>
#include <cstdio>
#include <cstdint>
#include <cmath>

typedef unsigned short bf16_t;
#define GAS __attribute__((address_space(1)))
typedef unsigned gu32x4 __attribute__((ext_vector_type(4)));
typedef unsigned gu32x2 __attribute__((ext_vector_type(2)));
typedef float gf32x4 __attribute__((ext_vector_type(4)));
typedef float gf32x2 __attribute__((ext_vector_type(2)));

constexpr int NB = 8, NS = 4096, ND = 1024, NL = 4, NM = NB * NS, NW = 256, NU = 4352, NY = 1280;
constexpr int MEML = 256;
constexpr float EPSF = 1e-6f;
constexpr int C_HQ = 0, C_HFF = 256, C_HFB = 512, C_HI = 768, C_HZ = 1024, C_CA = 1280, C_CB = 1536, C_CZ = 1792,
              C_SB = 2048, C_SC = 2304, C_SV = 2560, C_SZ = 2816, C_AQ = 3072, C_AK = 3328, C_AV = 3456, C_AZ = 3584,
              C_MQ = 3840, C_MZ = 4096;

constexpr size_t MiB = 1u << 20;
constexpr size_t WS_CTL = 0;
constexpr size_t CTL_ZERO_BYTES = 512 * 1024;
constexpr size_t WS_LB = 640 * 1024;
constexpr size_t WS_BIAS = 704 * 1024;
constexpr size_t WS_MEMKV = 1 * MiB;
constexpr size_t WS_WIN = 9 * MiB;
constexpr size_t WS_WG = WS_WIN + 4352u * 1024 * 2;
constexpr size_t WS_WB = WS_WG + 5120u * 1024 * 2;
constexpr size_t WS_WO = WS_WB + 5120u * 256 * 2;
constexpr size_t WS_H = 33 * MiB;
constexpr size_t WS_U = 97 * MiB;
constexpr size_t WS_ST = 369 * MiB;
constexpr size_t WS_Y = 417 * MiB;
constexpr size_t WS_END = 497 * MiB;
static_assert(WS_WO + 1024u * 1024 * 2 <= WS_H, "weights fit");

__device__ __forceinline__ float bf2f(bf16_t v) { return __uint_as_float((unsigned)v << 16); }
__device__ __forceinline__ bf16_t f2bf(float f) { unsigned u = __float_as_uint(f); return (bf16_t)((u + 0x7fffu + ((u >> 16) & 1u)) >> 16); }
__device__ __forceinline__ float sigmoidf_(float x) { return __builtin_amdgcn_rcpf(1.f + __expf(-x)); }
__device__ __forceinline__ float siluf_(float x) { return x * __builtin_amdgcn_rcpf(1.f + __expf(-x)); }

__global__ void n_prep(const float* lb_logits, const float* rel_bias, float* LB, float* BIAS) {
    const int tid = threadIdx.x;
    {
        float v[NL], mx = -1e30f, s = 0.f;
        for (int l = 0; l < NL; ++l) { v[l] = lb_logits[l * 512 + tid]; mx = fmaxf(mx, v[l]); }
        for (int l = 0; l < NL; ++l) { v[l] = __expf(v[l] - mx); s += v[l]; }
        float c = 0.f;
        for (int l = 0; l < NL; ++l) { if (l > 0) c += v[l] / s; LB[l * 512 + tid] = c; }
    }
    for (int i = tid; i < 4 * 257; i += blockDim.x) {
        const int h = i / 257, rel = i % 257 - 128;
        int n = -rel; int ret = (n < 0) ? 16 : 0; n = n < 0 ? -n : n;
        int bucket;
        if (n < 8) bucket = n;
        else {
            int large;
            if (n < 12) large = 8; else if (n < 16) large = 9; else if (n < 23) large = 10; else if (n < 32) large = 11;
            else if (n < 46) large = 12; else if (n < 64) large = 13; else if (n < 91) large = 14; else large = 15;
            bucket = large;
        }
        BIAS[i] = rel_bias[(ret + bucket) * 4 + h];
    }
}

__global__ void n_rmsnorm_rows(const float* x, const float* g, bf16_t* out, int rows) {
    const int wave = (blockIdx.x * blockDim.x + threadIdx.x) >> 6, lane = threadIdx.x & 63;
    if (wave >= rows) return;
    const float* xr = x + (size_t)wave * ND;
    float v[16], s = 0.f;
#pragma unroll
    for (int j = 0; j < 16; ++j) { v[j] = xr[lane + 64 * j]; s += v[j] * v[j]; }
#pragma unroll
    for (int o = 1; o < 64; o <<= 1) s += __shfl_xor(s, o);
    const float r = rsqrtf(s * (1.f / ND) + EPSF);
#pragma unroll
    for (int j = 0; j < 16; ++j) out[(size_t)wave * ND + lane + 64 * j] = f2bf(v[j] * r * g[lane + 64 * j]);
}

__global__ void n_memkv(const float* mem, const float* mem_norm, const float* w, bf16_t* out) {
    __shared__ float row[ND]; __shared__ float red[8];
    const int r = blockIdx.x, l = blockIdx.y, tid = threadIdx.x;
    float s = 0.f;
    for (int i = tid; i < ND; i += 512) { float v = mem[(size_t)r * ND + i]; row[i] = v; s += v * v; }
#pragma unroll
    for (int o = 1; o < 64; o <<= 1) s += __shfl_xor(s, o);
    if ((tid & 63) == 0) red[tid >> 6] = s;
    __syncthreads();
    float tot = 0.f; for (int i = 0; i < 8; ++i) tot += red[i];
    const float rs = rsqrtf(tot * (1.f / ND) + EPSF);
    const float* g = mem_norm + l * ND; const float* wl = w + (size_t)l * ND * 512;
    float acc = 0.f;
    for (int k = 0; k < ND; ++k) acc += row[k] * g[k] * wl[(size_t)k * 512 + tid];
    out[((size_t)l * (NB * MEML) + r) * 512 + tid] = f2bf(acc * rs);
}

__global__ __launch_bounds__(256) void n_gemm(const bf16_t* A, int lda, const float* Wt, int ldw, bf16_t* C, int ldc, int K) {
    __shared__ float As[16][132]; __shared__ float Bs[16][132];
    const int tid = threadIdx.x, tx = tid & 15, ty = tid >> 4;
    const int row0 = blockIdx.y * 128, col0 = blockIdx.x * 128;
    float acc[8][8];
#pragma unroll
    for (int i = 0; i < 8; ++i)
#pragma unroll
        for (int j = 0; j < 8; ++j) acc[i][j] = 0.f;
    for (int k0 = 0; k0 < K; k0 += 16) {
#pragma unroll
        for (int it = 0; it < 8; ++it) { const int i = tid + it * 256, r = i >> 4, k = i & 15; As[k][r] = bf2f(A[(size_t)(row0 + r) * lda + k0 + k]); }
#pragma unroll
        for (int it = 0; it < 8; ++it) { const int i = tid + it * 256, k = i >> 7, c = i & 127; Bs[k][c] = Wt[(size_t)(k0 + k) * ldw + col0 + c]; }
        __syncthreads();
#pragma unroll
        for (int k = 0; k < 16; ++k) {
            float a[8], b[8];
#pragma unroll
            for (int i = 0; i < 8; ++i) { a[i] = As[k][ty * 8 + i]; b[i] = Bs[k][tx * 8 + i]; }
#pragma unroll
            for (int i = 0; i < 8; ++i)
#pragma unroll
                for (int j = 0; j < 8; ++j) acc[i][j] += a[i] * b[j];
        }
        __syncthreads();
    }
#pragma unroll
    for (int i = 0; i < 8; ++i)
#pragma unroll
        for (int j = 0; j < 8; ++j) C[(size_t)(row0 + ty * 8 + i) * ldc + col0 + tx * 8 + j] = f2bf(acc[i][j]);
}

__global__ __launch_bounds__(256) void n_merge(const bf16_t* H, const bf16_t* Y, const float* Wg, const float* Wb, bf16_t* MG) {
    __shared__ float As[16][68]; __shared__ float Bs[16][68];
    const int tid = threadIdx.x, tx = tid & 15, ty = tid >> 4;
    const int row0 = blockIdx.y * 64, col0 = blockIdx.x * 64;
    float mg[4][4];
#pragma unroll
    for (int i = 0; i < 4; ++i)
#pragma unroll
        for (int j = 0; j < 4; ++j) mg[i][j] = 0.f;
    for (int n = 0; n < 5; ++n) {
        float ag[4][4], ab[4][4];
#pragma unroll
        for (int i = 0; i < 4; ++i)
#pragma unroll
            for (int j = 0; j < 4; ++j) { ag[i][j] = 0.f; ab[i][j] = 0.f; }
        const float* wg = Wg + (size_t)n * ND * ND;
        for (int k0 = 0; k0 < ND; k0 += 16) {
#pragma unroll
            for (int it = 0; it < 4; ++it) { const int i = tid + it * 256, r = i >> 4, k = i & 15; As[k][r] = bf2f(H[(size_t)(row0 + r) * ND + k0 + k]); }
#pragma unroll
            for (int it = 0; it < 4; ++it) { const int i = tid + it * 256, k = i >> 6, c = i & 63; Bs[k][c] = wg[(size_t)(k0 + k) * ND + col0 + c]; }
            __syncthreads();
#pragma unroll
            for (int k = 0; k < 16; ++k) {
                float a[4], b[4];
#pragma unroll
                for (int i = 0; i < 4; ++i) { a[i] = As[k][ty * 4 + i]; b[i] = Bs[k][tx * 4 + i]; }
#pragma unroll
                for (int i = 0; i < 4; ++i)
#pragma unroll
                    for (int j = 0; j < 4; ++j) ag[i][j] += a[i] * b[j];
            }
            __syncthreads();
        }
        const float* wb = Wb + (size_t)n * NW * ND;
        for (int k0 = 0; k0 < NW; k0 += 16) {
#pragma unroll
            for (int it = 0; it < 4; ++it) { const int i = tid + it * 256, r = i >> 4, k = i & 15; As[k][r] = bf2f(Y[(size_t)(row0 + r) * NY + n * NW + k0 + k]); }
#pragma unroll
            for (int it = 0; it < 4; ++it) { const int i = tid + it * 256, k = i >> 6, c = i & 63; Bs[k][c] = wb[(size_t)(k0 + k) * ND + col0 + c]; }
            __syncthreads();
#pragma unroll
            for (int k = 0; k < 16; ++k) {
                float a[4], b[4];
#pragma unroll
                for (int i = 0; i < 4; ++i) { a[i] = As[k][ty * 4 + i]; b[i] = Bs[k][tx * 4 + i]; }
#pragma unroll
                for (int i = 0; i < 4; ++i)
#pragma unroll
                    for (int j = 0; j < 4; ++j) ab[i][j] += a[i] * b[j];
            }
            __syncthreads();
        }
#pragma unroll
        for (int i = 0; i < 4; ++i)
#pragma unroll
            for (int j = 0; j < 4; ++j) mg[i][j] += sigmoidf_(ag[i][j]) * ab[i][j];
    }
#pragma unroll
    for (int i = 0; i < 4; ++i)
#pragma unroll
        for (int j = 0; j < 4; ++j) MG[(size_t)(row0 + ty * 4 + i) * ND + col0 + tx * 4 + j] = f2bf(mg[i][j]);
}

__global__ void n_shortconv(const bf16_t* U, const float* w  , bf16_t* Y) {
    const size_t idx = (size_t)blockIdx.x * blockDim.x + threadIdx.x;
    const int c = idx & 255; const int m = (int)(idx >> 8); const int t = m & (NS - 1);
    float conv = 0.f;
#pragma unroll
    for (int j = 0; j < 3; ++j) { const int tt = t + j - 1; if (tt >= 0 && tt < NS) { const size_t r = (size_t)(m + j - 1) * NU; conv += w[j * 256 + c] * bf2f(U[r + C_SC + c]) * bf2f(U[r + C_SV + c]); } }
    const size_t r = (size_t)m * NU;
    Y[(size_t)m * NY + 2 * NW + c] = f2bf(bf2f(U[r + C_SB + c]) * conv * siluf_(bf2f(U[r + C_SZ + c])));
}

__global__ void n_conformer(const bf16_t* U, const float* dw_w  , const float* dw_b, const float* ln_g, const float* ln_b, bf16_t* Y) {
    __shared__ float red[4];
    const int m = blockIdx.x, c = threadIdx.x, t = m & (NS - 1);
    float conv = dw_b[c];
    for (int j = 0; j < 31; ++j) { const int tt = t + j - 15; if (tt >= 0 && tt < NS) { const size_t r = (size_t)(m + j - 15) * NU; conv += dw_w[j * 256 + c] * bf2f(U[r + C_CA + c]) * sigmoidf_(bf2f(U[r + C_CB + c])); } }
    float s = conv;
#pragma unroll
    for (int o = 1; o < 64; o <<= 1) s += __shfl_xor(s, o);
    if ((c & 63) == 0) red[c >> 6] = s;
    __syncthreads();
    const float mu = (red[0] + red[1] + red[2] + red[3]) * (1.f / 256.f);
    __syncthreads();
    const float d = conv - mu; float q = d * d;
#pragma unroll
    for (int o = 1; o < 64; o <<= 1) q += __shfl_xor(q, o);
    if ((c & 63) == 0) red[c >> 6] = q;
    __syncthreads();
    const float var = (red[0] + red[1] + red[2] + red[3]) * (1.f / 256.f);
    const float n = d * rsqrtf(var + EPSF) * ln_g[c] + ln_b[c];
    Y[(size_t)m * NY + 1 * NW + c] = f2bf(siluf_(n) * siluf_(bf2f(U[(size_t)m * NU + C_CZ + c])));
}


__device__ __forceinline__ float dot64(const float (&q)[64], const bf16_t* kp) {
    float s = 0.f;
#pragma unroll
    for (int c = 0; c < 8; ++c) { const uint4 w = *(const uint4*)(kp + 8 * c); const unsigned ww[4] = {w.x, w.y, w.z, w.w};
#pragma unroll
        for (int e = 0; e < 4; ++e) { s += q[8 * c + 2 * e] * __uint_as_float(ww[e] << 16); s += q[8 * c + 2 * e + 1] * __uint_as_float(ww[e] & 0xffff0000u); } }
    return s;
}
__device__ __forceinline__ void axpy64(float (&acc)[64], float sc, float p, const bf16_t* vp) {
#pragma unroll
    for (int c = 0; c < 8; ++c) { const uint4 w = *(const uint4*)(vp + 8 * c); const unsigned ww[4] = {w.x, w.y, w.z, w.w};
#pragma unroll
        for (int e = 0; e < 4; ++e) { acc[8 * c + 2 * e] = acc[8 * c + 2 * e] * sc + p * __uint_as_float(ww[e] << 16); acc[8 * c + 2 * e + 1] = acc[8 * c + 2 * e + 1] * sc + p * __uint_as_float(ww[e] & 0xffff0000u); } }
}
__global__ __launch_bounds__(64) void n_winattn(const bf16_t* U, const float* BIAS, const float* sink, bf16_t* Y) {
    const int idx = blockIdx.x * blockDim.x + threadIdx.x;
    const int m = idx, h = blockIdx.y, t = m & (NS - 1), kvh = h >> 1;
    float q[64], acc[64];
    const bf16_t* qp = U + (size_t)m * NU + C_AQ + h * 64;
#pragma unroll
    for (int d = 0; d < 64; ++d) { q[d] = bf2f(qp[d]) * 0.125f; acc[d] = 0.f; }
    float mx = sink[h], l = 1.f;
    const int j0 = (t - 128 < 0) ? 0 : t - 128, j1 = (t + 128 > NS - 1) ? NS - 1 : t + 128;
    const float* bias = BIAS + h * 257;
    for (int j = j0; j <= j1; ++j) {
        const bf16_t* kp = U + (size_t)(m - t + j) * NU + C_AK + kvh * 64;
        const bf16_t* vp = U + (size_t)(m - t + j) * NU + C_AV + kvh * 64;
        float s = dot64(q, kp);
        s += bias[j - t + 128];
        const float nm = fmaxf(mx, s), sc = __expf(mx - nm), p = __expf(s - nm);
        l = l * sc + p; mx = nm;
        axpy64(acc, sc, p, vp);
    }
    const float inv = 1.f / l;
    const bf16_t* zp = U + (size_t)m * NU + C_AZ + h * 64;
    bf16_t* yp = Y + (size_t)m * NY + 3 * NW + h * 64;
#pragma unroll
    for (int d = 0; d < 64; ++d) yp[d] = f2bf(acc[d] * inv * siluf_(bf2f(zp[d])));
}

__global__ __launch_bounds__(64) void n_memattn(const bf16_t* U, const bf16_t* MKV  , bf16_t* Y) {
    const int m = blockIdx.x * blockDim.x + threadIdx.x, h = blockIdx.y, b = m / NS;
    float q[64], acc[64];
    const bf16_t* qp = U + (size_t)m * NU + C_MQ + h * 64;
#pragma unroll
    for (int d = 0; d < 64; ++d) { q[d] = bf2f(qp[d]) * 0.125f; acc[d] = 0.f; }
    float mx = -1e30f, l = 0.f;
    for (int j = 0; j < MEML; ++j) {
        const bf16_t* kp = MKV + (size_t)(b * MEML + j) * 512 + h * 64;
        const bf16_t* vp = kp + 256;
        const float s = dot64(q, kp);
        const float nm = fmaxf(mx, s), sc = __expf(mx - nm), p = __expf(s - nm);
        l = l * sc + p; mx = nm;
        axpy64(acc, sc, p, vp);
    }
    const float inv = 1.f / l;
    const bf16_t* zp = U + (size_t)m * NU + C_MZ + h * 64;
    bf16_t* yp = Y + (size_t)m * NY + 4 * NW + h * 64;
#pragma unroll
    for (int d = 0; d < 64; ++d) yp[d] = f2bf(acc[d] * inv * siluf_(bf2f(zp[d])));
}

__global__ __launch_bounds__(1024) void n_hgrn_scan(const bf16_t* U, const float* LBl  , bf16_t* OHG  ) {
    __shared__ float sq[64], sf[64], sk[64], sv[64]; __shared__ float red[16][64];
    const int b = blockIdx.x >> 3, h = (blockIdx.x >> 1) & 3, dir = blockIdx.x & 1;
    const int tid = threadIdx.x, v = tid & 63, kg = tid >> 6;
    float S[4] = {0.f, 0.f, 0.f, 0.f};
    const float lb = (tid < 64) ? LBl[dir * 256 + h * 64 + tid] : 0.f;
    for (int step = 0; step < NS; ++step) {
        const int t = dir ? (NS - 1 - step) : step;
        const size_t r = ((size_t)b * NS + t) * NU;
        if (tid < 64) {
            const float fl = bf2f(U[r + (dir ? C_HFB : C_HFF) + h * 64 + tid]);
            const float f = lb + (1.f - lb) * sigmoidf_(fl);
            sf[tid] = f; sk[tid] = 1.f - f;
            sq[tid] = bf2f(U[r + C_HQ + h * 64 + tid]);
            sv[tid] = bf2f(U[r + C_HI + h * 64 + tid]);
        }
        __syncthreads();
        const float vv = sv[v]; float part = 0.f;
#pragma unroll
        for (int j = 0; j < 4; ++j) { const int k = kg * 4 + j; S[j] = sf[k] * S[j] + sk[k] * vv; part += sq[k] * S[j]; }
        red[kg][v] = part;
        __syncthreads();
        if (tid < 64) { float o = 0.f;
#pragma unroll
            for (int g = 0; g < 16; ++g) o += red[g][tid];
            OHG[((size_t)dir * NM + (size_t)b * NS + t) * 256 + h * 64 + tid] = f2bf(o); }
    }
}
__global__ void n_hgrn_out(const bf16_t* OHG, const bf16_t* U, const float* onorm  , bf16_t* Y) {
    const int wave = (blockIdx.x * blockDim.x + threadIdx.x) >> 6, lane = threadIdx.x & 63;
    const int m = wave >> 2, h = wave & 3;
    const float o = bf2f(OHG[(size_t)m * 256 + h * 64 + lane]) + bf2f(OHG[((size_t)NM + m) * 256 + h * 64 + lane]);
    float s = o * o;
#pragma unroll
    for (int k = 1; k < 64; k <<= 1) s += __shfl_xor(s, k);
    const float y = o * rsqrtf(s * (1.f / 64.f) + EPSF) * onorm[lane];
    Y[(size_t)m * NY + h * 64 + lane] = f2bf(y * siluf_(bf2f(U[(size_t)m * NU + C_HZ + h * 64 + lane])));
}

__global__ void n_post(const float* xin, const bf16_t* outraw, const float* g_post, const float* g_next, float* xout, bf16_t* H, int has_next) {
    const int wave = (blockIdx.x * blockDim.x + threadIdx.x) >> 6, lane = threadIdx.x & 63;
    const size_t base = (size_t)wave * ND;
    float o[16], s = 0.f;
#pragma unroll
    for (int j = 0; j < 16; ++j) { o[j] = bf2f(outraw[base + lane + 64 * j]); s += o[j] * o[j]; }
#pragma unroll
    for (int k = 1; k < 64; k <<= 1) s += __shfl_xor(s, k);
    const float r = rsqrtf(s * (1.f / ND) + EPSF);
    float s2 = 0.f;
#pragma unroll
    for (int j = 0; j < 16; ++j) { o[j] = xin[base + lane + 64 * j] + o[j] * r * g_post[lane + 64 * j]; s2 += o[j] * o[j]; xout[base + lane + 64 * j] = o[j]; }
    if (has_next) {
#pragma unroll
        for (int k = 1; k < 64; k <<= 1) s2 += __shfl_xor(s2, k);
        const float r2 = rsqrtf(s2 * (1.f / ND) + EPSF);
#pragma unroll
        for (int j = 0; j < 16; ++j) H[base + lane + 64 * j] = f2bf(o[j] * r2 * g_next[lane + 64 * j]);
    }
}


namespace pg8 {
#define PG8_LAS __attribute__((address_space(3)))
typedef short bf16x8 __attribute__((ext_vector_type(8)));
typedef float f32x4 __attribute__((ext_vector_type(4)));
typedef unsigned u32x4 __attribute__((ext_vector_type(4)));
constexpr int BM = 256, BK = 64, HALF = 128, HTB = HALF * BK * 2  , STAGE_BYTES = 8 * HTB, NXCD = 8, WGM = 8;

__host__ __device__ __forceinline__ int lds_byte(int r, int c) { const int st = (r >> 4) * 2 + (c >> 5), rr = r & 15, cc = c & 31, ob = rr * 64 + cc * 2; return st * 1024 + (ob ^ (((ob >> 9) & 1) << 5)); }
__host__ __device__ __forceinline__ void stage_rc(int b, int& R, int& C) { const int st = b / 1024, sb = b % 1024, swz = sb ^ (((sb >> 9) & 1) << 5); R = (st >> 1) * 16 + swz / 64; C = (st & 1) * 32 + (swz % 64) / 2; }
__host__ __device__ __forceinline__ int perm32(int rho) { const int n = rho >> 4, i = rho & 15; return 8 * (i >> 2) + 4 * n + (i & 3); }

struct Unit { int pm, pn, pz; };
struct Gemm { const bf16_t* A; const bf16_t* Bt; int lda, ldb, K; unsigned zA, zB; };

template <int NZ> struct TileOrder {
    int nM, nN, nwg, G, c;
    __device__ void init(int M, int N, int G_, int c_) { nM = M / BM; nN = N / BM; nwg = nM * nN; G = G_; c = c_; }
    __device__ bool next(int i, Unit& u) const {
        const int ti = i / NZ; u.pz = i - ti * NZ;
        const long L = (long)ti * G + c; if (L >= nwg) return false;
        int wgid = (int)L; { const int q = nwg / NXCD, r = nwg % NXCD, xcd = wgid % NXCD, off = wgid / NXCD; wgid = (xcd < r ? xcd * (q + 1) : r * (q + 1) + (xcd - r) * q) + off; }
        const int nig = WGM * nN, gid = wgid / nig, fm = gid * WGM, gsz = (nM - fm) < WGM ? (nM - fm) : WGM;
        u.pm = fm + ((wgid % nig) % gsz); u.pn = (wgid % nig) / gsz; return true;
    }
};

template <int NZ> struct TileRound {
    TileOrder<NZ> T; int ti;
    __device__ bool next(int i, Unit& u) const { if (i >= NZ) return false; return T.next(ti * NZ + i, u); }
};
__device__ __forceinline__ unsigned cvt_pk_bf16(float lo, float hi) { unsigned r; asm volatile("v_cvt_pk_bf16_f32 %0, %1, %2" : "=v"(r) : "v"(lo), "v"(hi)); return r; }
__device__ __forceinline__ float bflo(unsigned w) { return __uint_as_float(w << 16); }
__device__ __forceinline__ float bfhi(unsigned w) { return __uint_as_float(w & 0xffff0000u); }

struct EpiStore {
    static constexpr bool PERM = true, CHAINED = false;
    GAS bf16_t* O; int ldc;
    __device__ __forceinline__ void operator()(f32x4 (&acc)[2][2][4][2], const Unit& u, int wr, int wc, int fr, int fq) const {
        const int row0 = u.pm * BM + wr * 64 + fr, col0 = u.pn * BM + wc * 32 + 8 * fq;
#pragma unroll
        for (int ai = 0; ai < 2; ++ai)
#pragma unroll
            for (int m = 0; m < 4; ++m) { GAS bf16_t* rowp = O + (size_t)(row0 + ai * HALF + m * 16) * ldc + col0;
#pragma unroll
                for (int bj = 0; bj < 2; ++bj) { const f32x4 v0 = acc[ai][bj][m][0], v1 = acc[ai][bj][m][1];
                    u32x4 w; w.x = cvt_pk_bf16(v0[0], v0[1]); w.y = cvt_pk_bf16(v0[2], v0[3]); w.z = cvt_pk_bf16(v1[0], v1[1]); w.w = cvt_pk_bf16(v1[2], v1[3]);
                    *(GAS u32x4*)(rowp + bj * HALF) = w; } }
    }
};
constexpr int GS_LD = 256, GS_SLOT = 256 * 256;
struct EpiGate {
    static constexpr bool PERM = true, CHAINED = false;
    GAS bf16_t* GS;
    __device__ __forceinline__ void operator()(f32x4 (&acc)[2][2][4][2], const Unit& u, int wr, int wc, int fr, int fq) const {
        const int n = u.pz;
        GAS bf16_t* base = GS + (size_t)(wr * 64 + fr) * GS_LD + wc * 32 + 8 * fq;
        u32x4 pw[2][4][2];
        if (n > 0) {
#pragma unroll
            for (int ai = 0; ai < 2; ++ai)
#pragma unroll
                for (int m = 0; m < 4; ++m)
#pragma unroll
                    for (int bj = 0; bj < 2; ++bj) pw[ai][m][bj] = *(const GAS u32x4*)(base + (ai * HALF + m * 16) * GS_LD + bj * HALF);
            asm volatile("" ::: "memory");
        }
#pragma unroll
        for (int ai = 0; ai < 2; ++ai)
#pragma unroll
            for (int m = 0; m < 4; ++m) {
#pragma unroll
                for (int bj = 0; bj < 2; ++bj) {
                    float e[8];
#pragma unroll
                    for (int j = 0; j < 4; ++j) { e[j] = 1.f + __expf(-__builtin_amdgcn_fmed3f(acc[ai][bj][m][0][j], -30.f, 30.f)); e[4 + j] = 1.f + __expf(-__builtin_amdgcn_fmed3f(acc[ai][bj][m][1][j], -30.f, 30.f)); }
                    GAS bf16_t* p0 = base + (ai * HALF + m * 16) * GS_LD + bj * HALF;
                    if (n > 0) {
                        const u32x4 q = pw[ai][m][bj];
                        u32x4 w; w.x = cvt_pk_bf16(bflo(q.x) * e[0], bfhi(q.x) * e[1]); w.y = cvt_pk_bf16(bflo(q.y) * e[2], bfhi(q.y) * e[3]);
                        w.z = cvt_pk_bf16(bflo(q.z) * e[4], bfhi(q.z) * e[5]); w.w = cvt_pk_bf16(bflo(q.w) * e[6], bfhi(q.w) * e[7]);
                        *(GAS u32x4*)(p0 + n * GS_SLOT) = w;
                    }
#pragma unroll
                    for (int j = 0; j < 8; ++j) e[j] = __builtin_amdgcn_rcpf(e[j]);
                    u32x4 w; w.x = cvt_pk_bf16(e[0], e[1]); w.y = cvt_pk_bf16(e[2], e[3]); w.z = cvt_pk_bf16(e[4], e[5]); w.w = cvt_pk_bf16(e[6], e[7]);
                    *(GAS u32x4*)p0 = w;
                } }
    }
};
struct EpiMerge {
    static constexpr bool PERM = true, CHAINED = true;
    const GAS bf16_t* GS; GAS bf16_t* MG;
    __device__ __forceinline__ void operator()(f32x4 (&acc)[2][2][4][2], const Unit& u, int wr, int wc, int fr, int fq) const {
        const int row0 = u.pm * BM + wr * 64 + fr, col0 = u.pn * BM + wc * 32 + 8 * fq, n = u.pz;
        const int slot = (n < 4) ? (n + 1) : 0;
        const GAS bf16_t* base = GS + (size_t)slot * GS_SLOT + (size_t)(wr * 64 + fr) * GS_LD + wc * 32 + 8 * fq;
        u32x4 pw[2][4][2];
#pragma unroll
        for (int ai = 0; ai < 2; ++ai)
#pragma unroll
            for (int m = 0; m < 4; ++m)
#pragma unroll
                for (int bj = 0; bj < 2; ++bj) pw[ai][m][bj] = *(const GAS u32x4*)(base + (ai * HALF + m * 16) * GS_LD + bj * HALF);
        asm volatile("" ::: "memory");
#pragma unroll
        for (int ai = 0; ai < 2; ++ai)
#pragma unroll
            for (int m = 0; m < 4; ++m) { const size_t row = (size_t)(row0 + ai * HALF + m * 16);
#pragma unroll
                for (int bj = 0; bj < 2; ++bj) {
                    const u32x4 q = pw[ai][m][bj];
                    f32x4 v0 = acc[ai][bj][m][0], v1 = acc[ai][bj][m][1];
                    v0[0] *= bflo(q.x); v0[1] *= bfhi(q.x); v0[2] *= bflo(q.y); v0[3] *= bfhi(q.y);
                    v1[0] *= bflo(q.z); v1[1] *= bfhi(q.z); v1[2] *= bflo(q.w); v1[3] *= bfhi(q.w);
                    acc[ai][bj][m][0] = v0; acc[ai][bj][m][1] = v1;
                    if (n == 4) { u32x4 w; w.x = cvt_pk_bf16(v0[0], v0[1]); w.y = cvt_pk_bf16(v0[2], v0[3]); w.z = cvt_pk_bf16(v1[0], v1[1]); w.w = cvt_pk_bf16(v1[2], v1[3]);
                        *(GAS u32x4*)(MG + row * 1024 + col0 + bj * HALF) = w; }
                } }
    }
};
struct EpiStoreZ {
    static constexpr bool PERM = true, CHAINED = false;
    GAS bf16_t* O; int ldc; size_t zO;
    __device__ __forceinline__ void operator()(f32x4 (&acc)[2][2][4][2], const Unit& u, int wr, int wc, int fr, int fq) const {
        const int row0 = u.pm * BM + wr * 64 + fr, col0 = u.pn * BM + wc * 32 + 8 * fq; GAS bf16_t* Ob = O + (size_t)u.pz * zO;
#pragma unroll
        for (int ai = 0; ai < 2; ++ai)
#pragma unroll
            for (int m = 0; m < 4; ++m) { GAS bf16_t* rowp = Ob + (size_t)(row0 + ai * HALF + m * 16) * ldc + col0;
#pragma unroll
                for (int bj = 0; bj < 2; ++bj) { const f32x4 v0 = acc[ai][bj][m][0], v1 = acc[ai][bj][m][1];
                    u32x4 w; w.x = cvt_pk_bf16(v0[0], v0[1]); w.y = cvt_pk_bf16(v0[2], v0[3]); w.z = cvt_pk_bf16(v1[0], v1[1]); w.w = cvt_pk_bf16(v1[2], v1[3]);
                    *(GAS u32x4*)(rowp + bj * HALF) = w; } }
    }
};
struct OneUnit { Unit u; bool valid; __device__ bool next(int i, Unit& o) const { if (i == 0 && valid) { o = u; return true; } return false; } };

template <class Epi, class Sched, bool ALIGN_EPI>
__device__ __forceinline__ void gemm_phase(PG8_LAS unsigned char* lds, const Gemm g, const Sched& S, const Epi& E) {
    int tid_ = threadIdx.x; asm volatile("" : "+v"(tid_));
    const int tid = tid_, wid = __builtin_amdgcn_readfirstlane(tid >> 6), lane = tid & 63, wr = wid >> 2, wc = wid & 3, fr = lane & 15, fq = lane >> 4;
    const int nt = g.K / BK;
    unsigned voffA[2], voffB[2];
#pragma unroll
    for (int i = 0; i < 2; ++i) { int R, C; stage_rc(tid * 16 + i * 8192, R, C); const int Rb = Epi::PERM ? ((R & ~31) + perm32(R & 31)) : R;
        voffA[i] = (unsigned)(R * g.lda + C) * 2u; voffB[i] = (unsigned)(Rb * g.ldb + C) * 2u; }
    const size_t kstep = (size_t)(BK * 2);
    const size_t hstepA = (size_t)HALF * g.lda * 2, tstepA = 2 * hstepA, hstepB = (size_t)HALF * g.ldb * 2, tstepB = 2 * hstepB;
    const unsigned ldsw = (unsigned)wid * 1024u;
    const int aoff = lds_byte(wr * 64 + fr, fq * 8), boff = lds_byte(wc * 32 + fr, fq * 8);
#define PG8_SA(b, h) (((b) * 2 + (h)) * HTB)
#define PG8_SB(b, h) ((4 + (b) * 2 + (h)) * HTB)
#define PG8_STAGE(bufoff, gbase, voff) do { _Pragma("unroll") for (int _i = 0; _i < 2; ++_i) \
        __builtin_amdgcn_global_load_lds((const unsigned*)((const char*)(gbase) + (voff)[_i]), (PG8_LAS unsigned*)(lds + (bufoff) + ldsw + _i * 8192), 16, 0, 0); } while (0)
#define PG8_LDA(dst, b, h) do { _Pragma("unroll") for (int m = 0; m < 4; ++m) _Pragma("unroll") for (int k = 0; k < 2; ++k) dst[m][k] = *(const PG8_LAS bf16x8*)(lds + PG8_SA(b, h) + aoff + m * 2048 + k * 1024); } while (0)
#define PG8_LDB(dst, b, h) do { _Pragma("unroll") for (int n = 0; n < 2; ++n) _Pragma("unroll") for (int k = 0; k < 2; ++k) dst[n][k] = *(const PG8_LAS bf16x8*)(lds + PG8_SB(b, h) + boff + n * 2048 + k * 1024); } while (0)
#define PG8_MMA(ai, bj, At, Bt) do { __builtin_amdgcn_s_setprio(1); _Pragma("unroll") for (int m = 0; m < 4; ++m) _Pragma("unroll") for (int n = 0; n < 2; ++n) _Pragma("unroll") for (int k = 0; k < 2; ++k) \
        acc[ai][bj][m][n] = __builtin_amdgcn_mfma_f32_16x16x32_bf16(Bt[n][k], At[m][k], acc[ai][bj][m][n], 0, 0, 0); __builtin_amdgcn_s_setprio(0); } while (0)
#define PG8_WAIT_V(n) asm volatile("s_waitcnt vmcnt(" #n ")" ::: "memory")
#define PG8_WAIT_L(n) asm volatile("s_waitcnt lgkmcnt(" #n ")" ::: "memory")
#define PG8_BAR __builtin_amdgcn_s_barrier()
#define PG8_SCHED __builtin_amdgcn_sched_barrier(0)
    Unit cur, nxt; int ui = 0;
    if (!S.next(0, cur)) return;
    f32x4 acc[2][2][4][2];
#pragma unroll
    for (int a = 0; a < 2; ++a)
#pragma unroll
        for (int b = 0; b < 2; ++b)
#pragma unroll
            for (int m = 0; m < 4; ++m)
#pragma unroll
                for (int n = 0; n < 2; ++n) acc[a][b][m][n] = (f32x4){0.f, 0.f, 0.f, 0.f};
    bf16x8 At[4][2], B0[2][2], B1[2][2];
    const char* cA = (const char*)g.A + (size_t)cur.pm * tstepA + (size_t)cur.pz * g.zA; const char* cB = (const char*)g.Bt + (size_t)cur.pn * tstepB + (size_t)cur.pz * g.zB;
    PG8_STAGE(PG8_SB(0, 0), cB, voffB); PG8_STAGE(PG8_SB(0, 1), cB + hstepB, voffB); PG8_STAGE(PG8_SA(0, 0), cA, voffA); PG8_STAGE(PG8_SA(0, 1), cA + hstepA, voffA);
    if (wr == 1) PG8_BAR;
    PG8_WAIT_V(2); PG8_BAR;
    PG8_STAGE(PG8_SB(1, 0), cB + kstep, voffB); PG8_STAGE(PG8_SA(1, 0), cA + kstep, voffA); PG8_STAGE(PG8_SB(1, 1), cB + hstepB + kstep, voffB);
    PG8_WAIT_V(6); PG8_BAR;
    for (;;) {
        const bool has_next = S.next(ui + 1, nxt);
        const char* nA = has_next ? (const char*)g.A + (size_t)nxt.pm * tstepA + (size_t)nxt.pz * g.zA : cA; const char* nB = has_next ? (const char*)g.Bt + (size_t)nxt.pn * tstepB + (size_t)nxt.pz * g.zB : cB;
        for (int t = 0; t < nt; t += 2) {
            const bool last = (t == nt - 2);
            const char* a1 = cA + (size_t)(t + 1) * kstep;
            const char* a2 = last ? nA : cA + (size_t)(t + 2) * kstep; const char* b2 = last ? nB : cB + (size_t)(t + 2) * kstep;
            const char* a3 = a2 + kstep; const char* b3 = b2 + kstep;
            PG8_LDB(B0, 0, 0); PG8_LDB(B1, 0, 1); PG8_SCHED; PG8_LDA(At, 0, 0); PG8_STAGE(PG8_SA(1, 1), a1 + hstepA, voffA);
            PG8_WAIT_V(8); PG8_WAIT_L(0); PG8_BAR; PG8_MMA(0, 0, At, B0); PG8_MMA(0, 1, At, B1); PG8_BAR; PG8_SCHED;
            PG8_LDA(At, 0, 1); PG8_STAGE(PG8_SB(0, 0), b2, voffB); PG8_STAGE(PG8_SB(0, 1), b2 + hstepB, voffB); PG8_STAGE(PG8_SA(0, 0), a2, voffA);
            PG8_WAIT_V(8); PG8_WAIT_L(0); PG8_BAR; PG8_MMA(1, 0, At, B0); PG8_MMA(1, 1, At, B1); PG8_BAR; PG8_SCHED;
            PG8_LDB(B0, 1, 0); PG8_LDB(B1, 1, 1); PG8_SCHED; PG8_LDA(At, 1, 0); PG8_STAGE(PG8_SA(0, 1), a2 + hstepA, voffA);
            PG8_WAIT_V(8); PG8_WAIT_L(0); PG8_BAR; PG8_MMA(0, 0, At, B0); PG8_MMA(0, 1, At, B1); PG8_BAR; PG8_SCHED;
            PG8_LDA(At, 1, 1); PG8_STAGE(PG8_SB(1, 0), b3, voffB); PG8_STAGE(PG8_SB(1, 1), b3 + hstepB, voffB); PG8_STAGE(PG8_SA(1, 0), a3, voffA);
            PG8_WAIT_V(8); PG8_WAIT_L(0); PG8_BAR; PG8_MMA(1, 0, At, B0); PG8_MMA(1, 1, At, B1); PG8_BAR; PG8_SCHED;
        }
        if constexpr (ALIGN_EPI) { if (wr == 0) PG8_BAR; }
        E(acc, cur, wr, wc, fr, fq);
        if (!has_next) break;
        if (!Epi::CHAINED || nxt.pz == 0) {
#pragma unroll
            for (int a = 0; a < 2; ++a)
#pragma unroll
                for (int b = 0; b < 2; ++b)
#pragma unroll
                    for (int m = 0; m < 4; ++m)
#pragma unroll
                        for (int n = 0; n < 2; ++n) acc[a][b][m][n] = (f32x4){0.f, 0.f, 0.f, 0.f};
        }
        cur = nxt; cA = nA; cB = nB; ++ui;
        if constexpr (ALIGN_EPI) { if (wr == 1) PG8_BAR; }
    }
    PG8_WAIT_V(0);
    if constexpr (!ALIGN_EPI) { if (wr == 0) PG8_BAR; }
    PG8_BAR;
#undef PG8_SA
#undef PG8_SB
#undef PG8_STAGE
#undef PG8_LDA
#undef PG8_LDB
#undef PG8_MMA
#undef PG8_WAIT_V
#undef PG8_WAIT_L
#undef PG8_BAR
#undef PG8_SCHED
}
}

#define LAS __attribute__((address_space(3)))
#define XB_TMO      128
#define XB_XCNT(j)  (256  + 64 * (j))
#define XB_XSUB(j)  (1280 + 64 * (j))
#define XB_XGEN(j)  (2304 + 64 * (j))
#define XB_TOP      3328
#define XB_TOPGEN   3392
#define XCD_BAR_WORDS 3456
#define XB_SPIN_CAP (1u << 18)
__device__ __forceinline__ unsigned xb_ld(unsigned* p)              { return __hip_atomic_load(p, __ATOMIC_RELAXED, __HIP_MEMORY_SCOPE_AGENT); }
__device__ __forceinline__ unsigned xb_add(unsigned* p, unsigned v) { return __hip_atomic_fetch_add(p, v, __ATOMIC_RELAXED, __HIP_MEMORY_SCOPE_AGENT); }
__device__ __forceinline__ unsigned xb_xcc_id() { return (unsigned)__builtin_amdgcn_s_getreg((3 << 11) | 20) & 0xFu; }
#define XB_SPIN(cond, bar) do { unsigned _sp = 0; while (cond) { __builtin_amdgcn_s_sleep(1); \
    if ((++_sp & 255u) == 0u) { if (xb_ld(&(bar)[XB_TMO])) break; if (_sp > XB_SPIN_CAP) { atomicAdd(&(bar)[XB_TMO], 1u); break; } } } } while (0)
struct XcdBarrier { unsigned* bar; unsigned x; volatile LAS unsigned* st; };
__device__ __forceinline__ XcdBarrier xcd_barrier_post(unsigned* bar, volatile LAS unsigned* st) {
    XcdBarrier b; b.bar = bar; b.x = xb_xcc_id(); b.st = st;
    if (threadIdx.x == 0) (void)xb_add(&bar[XB_XCNT(b.x)], 1u);
    return b;
}
__device__ __forceinline__ void xcd_barrier_complete(unsigned* bar, unsigned x, unsigned& nloc, unsigned& nx) {
    const unsigned G = gridDim.x * gridDim.y * gridDim.z;
    unsigned sum, cnt, mine, sp = 0u;
    for (;;) {
        sum = 0u; cnt = 0u; mine = 0u;
#pragma unroll
        for (unsigned j = 0; j < 16; ++j) { const unsigned c = xb_ld(&bar[XB_XCNT(j)]); sum += c; cnt += (c > 0u) ? 1u : 0u; mine = (j == x) ? c : mine; }
        if (sum == G) break;
        __builtin_amdgcn_s_sleep(1);
        if ((++sp & 255u) == 0u) { if (xb_ld(&bar[XB_TMO])) break; if (sp > XB_SPIN_CAP) { atomicAdd(&bar[XB_TMO], 1u); break; } }
    }
    nloc = mine > 0u ? mine : 1u; nx = cnt > 0u ? cnt : 1u;
}
__device__ __forceinline__ void xcd_barrier(const XcdBarrier& b) {
    asm volatile("s_waitcnt vmcnt(0)" ::: "memory");
    __syncthreads();
    if (threadIdx.x == 0) {
        unsigned* bar = b.bar;
        __builtin_amdgcn_s_waitcnt(0);
        unsigned nloc = b.st[0], nx = b.st[1];
        if (nloc == 0u) { xcd_barrier_complete(bar, b.x, nloc, nx); b.st[0] = nloc; b.st[1] = nx; }
        const unsigned old = xb_add(&bar[XB_XSUB(b.x)], 1u);
        const unsigned gen = old / nloc;
        if (old + 1u == (gen + 1u) * nloc) {
            __builtin_amdgcn_fence(__ATOMIC_RELEASE, "agent");
            asm volatile("s_waitcnt vmcnt(0)" ::: "memory");
            const unsigned og = xb_add(&bar[XB_TOP], 1u);
            const unsigned tg = og / nx;
            if (og + 1u == (tg + 1u) * nx) xb_add(&bar[XB_TOPGEN], 1u);
            else XB_SPIN(xb_ld(&bar[XB_TOPGEN]) == tg, bar);
            __builtin_amdgcn_fence(__ATOMIC_ACQUIRE, "agent");
            xb_add(&bar[XB_XGEN(b.x)], 1u);
            asm volatile("s_waitcnt vmcnt(0)" ::: "memory");
        } else {
            XB_SPIN(xb_ld(&bar[XB_XGEN(b.x)]) == gen, bar);
            __builtin_amdgcn_fence(__ATOMIC_ACQUIRE, "agent");
            asm volatile("s_waitcnt vmcnt(0)" ::: "memory");
        }
    }
    __syncthreads();
}

constexpr int NWAVES = 8;
constexpr int RING_OFF = 0, RING_BYTES = 131072;
constexpr int LDSCTL_OFF = RING_BYTES, MISC_OFF = LDSCTL_OFF + 320;
constexpr int LDS_BYTES = 147456;
constexpr int CW_BAR = 4096;
constexpr int MAX_LAUNCHES = 24;
static_assert((CW_BAR + MAX_LAUNCHES * XCD_BAR_WORDS) * 4 <= (int)CTL_ZERO_BYTES, "barrier regions inside the memset region");
constexpr int PH_PER_LAYER = 8, PH_TOTAL = 1 + NL * PH_PER_LAYER;
enum { PH_A = 0, PH_M1 = 1, PH_M2 = 2, PH_M3 = 3, PH_G = 4, PH_C = 5, PH_D = 6, PH_T = 7 };

struct Args { const float* in[19]; float* out; unsigned char* ws; int ph_lo, ph_hi, li, pad; };

__device__ __forceinline__ float wave_sum(float v) {
#pragma unroll
    for (int o = 1; o < 64; o <<= 1) v += __shfl_xor(v, o);
    return v;
}
__device__ __forceinline__ unsigned pk2(float lo, float hi) { return (unsigned)f2bf(lo) | ((unsigned)f2bf(hi) << 16); }
typedef float f32x4_t __attribute__((ext_vector_type(4)));
typedef unsigned u32x4_t __attribute__((ext_vector_type(4)));

__device__ __forceinline__ void transpose_item(const float* W_, int K, int N, bf16_t* WT_, LAS float* scr, int item, int lane) {
    const GAS float* W = (const GAS float*)W_; GAS bf16_t* WT = (GAS bf16_t*)WT_;
    const int nblk = N / 32, kb = item / nblk, nb = item % nblk, k0 = 64 * kb, n0 = 32 * nb;
#pragma unroll 8
    for (int i = 0; i < 32; ++i) { const int kk = 2 * i + (lane >> 5); scr[kk * 33 + (lane & 31)] = W[(size_t)(k0 + kk) * N + n0 + (lane & 31)]; }
    asm volatile("s_waitcnt lgkmcnt(0)" ::: "memory");
    const int c = lane & 7;
#pragma unroll
    for (int j = 0; j < 4; ++j) { const int n = (lane >> 3) + 8 * j; const LAS float* s = scr + (8 * c) * 33 + n;
        u32x4_t o; o.x = pk2(s[0 * 33], s[1 * 33]); o.y = pk2(s[2 * 33], s[3 * 33]); o.z = pk2(s[4 * 33], s[5 * 33]); o.w = pk2(s[6 * 33], s[7 * 33]);
        *(GAS u32x4_t*)(WT + (size_t)(n0 + n) * K + k0 + 8 * c) = o; }
    asm volatile("s_waitcnt lgkmcnt(0)" ::: "memory");
}
__device__ __forceinline__ void convert_weights(unsigned char* ws, const float* w_in_all, const float* w_gate_all, const float* w_branch_all, const float* w_out_all, int l, int mask, LAS unsigned char* lds, int gw, int NGW, int wave, int lane) {
    LAS float* scr = (LAS float*)(lds + RING_OFF + wave * 16384);
    const float* w_in = w_in_all + (size_t)l * ND * NU; const float* w_gate = w_gate_all + (size_t)l * 5 * ND * ND;
    const float* w_branch = w_branch_all + (size_t)l * 5 * NW * ND; const float* w_out = w_out_all + (size_t)l * ND * ND;
    constexpr int I_IN = (ND / 64) * (NU / 32), I_G = (ND / 64) * (ND / 32), I_B = (NW / 64) * (ND / 32), I_O = I_G;
    if (mask & 1) for (int it = gw; it < I_IN; it += NGW) transpose_item(w_in, ND, NU, (bf16_t*)(ws + WS_WIN), scr, it, lane);
    if (mask & 2) for (int it = gw; it < 5 * I_G + 5 * I_B + I_O; it += NGW) {
        int r = it;
        if (r < 5 * I_G) { const int n = r / I_G; transpose_item(w_gate + (size_t)n * ND * ND, ND, ND, (bf16_t*)(ws + WS_WG) + (size_t)n * ND * ND, scr, r - n * I_G, lane); continue; } r -= 5 * I_G;
        if (r < 5 * I_B) { const int n = r / I_B; transpose_item(w_branch + (size_t)n * NW * ND, NW, ND, (bf16_t*)(ws + WS_WB) + (size_t)n * ND * NW, scr, r - n * I_B, lane); continue; } r -= 5 * I_B;
        transpose_item(w_out, ND, ND, (bf16_t*)(ws + WS_WO), scr, r, lane);
    }
}
__device__ __forceinline__ void rms_row_to_bf16(const float* xrow, const float* g, bf16_t* orow, int lane) {
    const GAS f32x4_t* xr = (const GAS f32x4_t*)xrow + lane; const GAS f32x4_t* gr = (const GAS f32x4_t*)g + lane;
    f32x4_t v[4]; float s = 0.f;
#pragma unroll
    for (int j = 0; j < 4; ++j) { v[j] = xr[64 * j]; s += (v[j].x * v[j].x + v[j].y * v[j].y) + (v[j].z * v[j].z + v[j].w * v[j].w); }
    const float r = rsqrtf(wave_sum(s) * (1.f / ND) + EPSF);
    GAS unsigned long long* o8 = (GAS unsigned long long*)orow + lane;
#pragma unroll
    for (int j = 0; j < 4; ++j) { const f32x4_t gg = gr[64 * j];
        o8[64 * j] = (unsigned long long)pk2(v[j].x * r * gg.x, v[j].y * r * gg.y) | ((unsigned long long)pk2(v[j].z * r * gg.z, v[j].w * r * gg.w) << 32); }
}
__device__ __forceinline__ void post_row(const float* xrow, const bf16_t* orow, const float* g_post, const float* g_next, float* xout, bf16_t* hrow, bool has_next, int lane) {
    const GAS f32x4_t* xr = (const GAS f32x4_t*)xrow + lane; const GAS unsigned long long* o8 = (const GAS unsigned long long*)orow + lane;
    f32x4_t v[4]; float s = 0.f;
#pragma unroll
    for (int j = 0; j < 4; ++j) { const unsigned long long w = o8[64 * j]; const unsigned lo = (unsigned)w, hi = (unsigned)(w >> 32);
        v[j].x = __uint_as_float(lo << 16); v[j].y = __uint_as_float(lo & 0xffff0000u); v[j].z = __uint_as_float(hi << 16); v[j].w = __uint_as_float(hi & 0xffff0000u);
        s += (v[j].x * v[j].x + v[j].y * v[j].y) + (v[j].z * v[j].z + v[j].w * v[j].w); }
    const float r = rsqrtf(wave_sum(s) * (1.f / ND) + EPSF);
    float s2 = 0.f;
#pragma unroll
    for (int j = 0; j < 4; ++j) { const f32x4_t gg = ((const GAS f32x4_t*)g_post + lane)[64 * j]; const f32x4_t xx = xr[64 * j];
        v[j].x = xx.x + v[j].x * r * gg.x; v[j].y = xx.y + v[j].y * r * gg.y; v[j].z = xx.z + v[j].z * r * gg.z; v[j].w = xx.w + v[j].w * r * gg.w;
        s2 += (v[j].x * v[j].x + v[j].y * v[j].y) + (v[j].z * v[j].z + v[j].w * v[j].w);
        ((GAS f32x4_t*)xout + lane)[64 * j] = v[j]; }
    if (has_next) {
        const float r2 = rsqrtf(wave_sum(s2) * (1.f / ND) + EPSF);
        GAS unsigned long long* h8 = (GAS unsigned long long*)hrow + lane;
#pragma unroll
        for (int j = 0; j < 4; ++j) { const f32x4_t gg = ((const GAS f32x4_t*)g_next + lane)[64 * j];
            h8[64 * j] = (unsigned long long)pk2(v[j].x * r2 * gg.x, v[j].y * r2 * gg.y) | ((unsigned long long)pk2(v[j].z * r2 * gg.z, v[j].w * r2 * gg.w) << 32); }
    }
}


__device__ __forceinline__ void post_rows(const float* xin_, const bf16_t* outraw_, const float* g_post_, const float* g_next_, float* xout_, bf16_t* H_, bool has_next, int gw, int NGW, int lane) {
    const GAS f32x4_t* xin = (const GAS f32x4_t*)xin_ + lane; const GAS unsigned long long* orw = (const GAS unsigned long long*)outraw_ + lane;
    GAS f32x4_t* xout = (GAS f32x4_t*)xout_ + lane; GAS unsigned long long* H8 = (GAS unsigned long long*)H_ + lane;
    f32x4_t gp[4], gn[4];
#pragma unroll
    for (int j = 0; j < 4; ++j) { gp[j] = ((const GAS f32x4_t*)g_post_ + lane)[64 * j]; gn[j] = ((const GAS f32x4_t*)g_next_ + lane)[64 * j]; }
    f32x4_t xn[4]; unsigned long long on[4];
    int m = gw;
    if (m < NM) {
#pragma unroll
        for (int j = 0; j < 4; ++j) { xn[j] = xin[(size_t)m * 256 + 64 * j]; on[j] = orw[(size_t)m * 256 + 64 * j]; }
    }
    for (; m < NM; m += NGW) {
        f32x4_t v[4], xc[4]; float s = 0.f;
#pragma unroll
        for (int j = 0; j < 4; ++j) { xc[j] = xn[j]; const unsigned lo = (unsigned)on[j], hi = (unsigned)(on[j] >> 32);
            v[j].x = __uint_as_float(lo << 16); v[j].y = __uint_as_float(lo & 0xffff0000u); v[j].z = __uint_as_float(hi << 16); v[j].w = __uint_as_float(hi & 0xffff0000u);
            s += (v[j].x * v[j].x + v[j].y * v[j].y) + (v[j].z * v[j].z + v[j].w * v[j].w); }
        const int m2 = m + NGW;
        if (m2 < NM) {
#pragma unroll
            for (int j = 0; j < 4; ++j) { xn[j] = xin[(size_t)m2 * 256 + 64 * j]; on[j] = orw[(size_t)m2 * 256 + 64 * j]; }
        }
        asm volatile("" ::: "memory");
        const float r = rsqrtf(wave_sum(s) * (1.f / ND) + EPSF);
        float s2 = 0.f;
#pragma unroll
        for (int j = 0; j < 4; ++j) { v[j] = xc[j] + v[j] * r * gp[j]; s2 += (v[j].x * v[j].x + v[j].y * v[j].y) + (v[j].z * v[j].z + v[j].w * v[j].w); xout[(size_t)m * 256 + 64 * j] = v[j]; }
        if (has_next) {
            const float r2 = rsqrtf(wave_sum(s2) * (1.f / ND) + EPSF);
#pragma unroll
            for (int j = 0; j < 4; ++j) { const f32x4_t o = v[j] * r2 * gn[j];
                H8[(size_t)m * 256 + 64 * j] = (unsigned long long)pk2(o.x, o.y) | ((unsigned long long)pk2(o.z, o.w) << 32); }
        }
    }
}

__device__ __forceinline__ void rms_rows(const float* x_, const float* g_, int gdiv, bf16_t* out_, int nrows, int gw, int NGW, int lane) {
    const GAS f32x4_t* xin = (const GAS f32x4_t*)x_ + lane; GAS unsigned long long* o8 = (GAS unsigned long long*)out_ + lane;
    f32x4_t xn[4];
    int m = gw;
    if (m < nrows) {
#pragma unroll
        for (int j = 0; j < 4; ++j) xn[j] = xin[(size_t)(gdiv ? m % gdiv : m) * 256 + 64 * j];
    }
    for (; m < nrows; m += NGW) {
        f32x4_t v[4]; float s = 0.f;
#pragma unroll
        for (int j = 0; j < 4; ++j) { v[j] = xn[j]; s += (v[j].x * v[j].x + v[j].y * v[j].y) + (v[j].z * v[j].z + v[j].w * v[j].w); }
        const int m2 = m + NGW;
        if (m2 < nrows) {
#pragma unroll
            for (int j = 0; j < 4; ++j) xn[j] = xin[(size_t)(gdiv ? m2 % gdiv : m2) * 256 + 64 * j];
        }
        const GAS f32x4_t* gr = (const GAS f32x4_t*)(g_ + (gdiv ? (size_t)(m / gdiv) * ND : 0)) + lane;
        f32x4_t gg[4];
#pragma unroll
        for (int j = 0; j < 4; ++j) gg[j] = gr[64 * j];
        asm volatile("" ::: "memory");
        const float r = rsqrtf(wave_sum(s) * (1.f / ND) + EPSF);
#pragma unroll
        for (int j = 0; j < 4; ++j) o8[(size_t)m * 256 + 64 * j] = (unsigned long long)pk2(v[j].x * r * gg[j].x, v[j].y * r * gg[j].y) | ((unsigned long long)pk2(v[j].z * r * gg[j].z, v[j].w * r * gg[j].w) << 32);
    }
}

typedef short bf16x8_t __attribute__((ext_vector_type(8)));
typedef float f32x16_t __attribute__((ext_vector_type(16)));
#define MIX_LAS __attribute__((address_space(3)))
typedef float f32x4m __attribute__((ext_vector_type(4)));
typedef unsigned u32x4m __attribute__((ext_vector_type(4)));
__device__ __forceinline__ float wsum_(float v) {
#pragma unroll
    for (int o = 1; o < 64; o <<= 1) v += __shfl_xor(v, o);
    return v;
}
constexpr int KROW = 144;
__device__ __forceinline__ int crow_(int r, int hi) { return (r & 3) + 8 * (r >> 2) + 4 * hi; }
typedef float f32x2m __attribute__((ext_vector_type(2))); typedef __bf16 bf16x2m __attribute__((ext_vector_type(2)));
__device__ __forceinline__ unsigned pkbf(float lo, float hi) { f32x2m v = {lo, hi}; bf16x2m b = __builtin_convertvector(v, bf16x2m); return __builtin_bit_cast(unsigned, b); }

template <bool WIN>
__device__ __forceinline__ void attn_core(const MIX_LAS unsigned char* Kl, const MIX_LAS unsigned char* VTl, int vt_stride, const MIX_LAS float* biasl,
                                          const bf16x8_t (&qf)[4], int t_lo, int t_hi, int t_int_lo, int t_int_hi, int qi_band, float m0, float l0,
                                          const GAS bf16_t* zrow, GAS bf16_t* yrow, int lane) {
    constexpr float C2 = 0.125f * 1.4426950408889634f;
    const int r32 = lane & 31, hi = lane >> 5;
    f32x16_t O0, O1;
#pragma unroll
    for (int r = 0; r < 16; ++r) { O0[r] = 0.f; O1[r] = 0.f; }
    float m = m0, l = l0;
    typedef unsigned u32x4v __attribute__((ext_vector_type(4)));
    for (int t = t_lo; t < t_hi; t += 2) {
        f32x16_t s0, s1;
#pragma unroll
        for (int r = 0; r < 16; ++r) { s0[r] = 0.f; s1[r] = 0.f; }
        const MIX_LAS unsigned char* kp = Kl + (t * 32 + r32) * KROW + hi * 16;
#pragma unroll
        for (int ds = 0; ds < 4; ++ds) { const bf16x8_t a0 = *(const MIX_LAS bf16x8_t*)(kp + ds * 32), a1 = *(const MIX_LAS bf16x8_t*)(kp + 32 * KROW + ds * 32);
            s0 = __builtin_amdgcn_mfma_f32_32x32x16_bf16(a0, qf[ds], s0, 0, 0, 0); s1 = __builtin_amdgcn_mfma_f32_32x32x16_bf16(a1, qf[ds], s1, 0, 0, 0); }
        if (WIN) {
            const int rel0 = t * 32 + 4 * hi - qi_band;
            const MIX_LAS float* bp = biasl + (rel0 + 128);
#pragma unroll
            for (int r = 0; r < 16; ++r) { s0[r] = s0[r] * C2 + bp[(r & 3) + 8 * (r >> 2)]; s1[r] = s1[r] * C2 + bp[32 + (r & 3) + 8 * (r >> 2)]; }
            if (t < t_int_lo || t >= t_int_hi) {
#pragma unroll
                for (int r = 0; r < 16; ++r) { const int rel = rel0 + (r & 3) + 8 * (r >> 2); s0[r] = (rel >= -128 && rel <= 128) ? s0[r] : -INFINITY; }
            }
            if (t + 1 < t_int_lo || t + 1 >= t_int_hi) {
#pragma unroll
                for (int r = 0; r < 16; ++r) { const int rel = rel0 + 32 + (r & 3) + 8 * (r >> 2); s1[r] = (rel >= -128 && rel <= 128) ? s1[r] : -INFINITY; }
            }
        } else {
#pragma unroll
            for (int r = 0; r < 16; ++r) { s0[r] *= C2; s1[r] *= C2; }
        }
        float mx = fmaxf(s0[0], s1[0]);
#pragma unroll
        for (int r = 1; r < 16; ++r) mx = fmaxf(mx, fmaxf(s0[r], s1[r]));
        mx = fmaxf(mx, __shfl_xor(mx, 32));
        if (__any(mx > m)) {
            const float mn = fmaxf(m, mx), sc = __builtin_amdgcn_exp2f(m - mn); m = mn; l *= sc;
#pragma unroll
            for (int r = 0; r < 16; ++r) { O0[r] *= sc; O1[r] *= sc; }
        }
        float ps = 0.f;
#pragma unroll
        for (int r = 0; r < 16; ++r) { const float p0 = __builtin_amdgcn_exp2f(s0[r] - m), p1 = __builtin_amdgcn_exp2f(s1[r] - m); s0[r] = p0; s1[r] = p1; ps += p0 + p1; }
        l += ps;
        u32x4v a0, a1, b0, b1;
        a0.x = pkbf(s0[0], s0[1]); a0.y = pkbf(s0[2], s0[3]); a0.z = pkbf(s0[4], s0[5]); a0.w = pkbf(s0[6], s0[7]);
        a1.x = pkbf(s0[8], s0[9]); a1.y = pkbf(s0[10], s0[11]); a1.z = pkbf(s0[12], s0[13]); a1.w = pkbf(s0[14], s0[15]);
        b0.x = pkbf(s1[0], s1[1]); b0.y = pkbf(s1[2], s1[3]); b0.z = pkbf(s1[4], s1[5]); b0.w = pkbf(s1[6], s1[7]);
        b1.x = pkbf(s1[8], s1[9]); b1.y = pkbf(s1[10], s1[11]); b1.z = pkbf(s1[12], s1[13]); b1.w = pkbf(s1[14], s1[15]);
        const bf16x8_t pf0 = __builtin_bit_cast(bf16x8_t, a0), pf1 = __builtin_bit_cast(bf16x8_t, a1), pf2 = __builtin_bit_cast(bf16x8_t, b0), pf3 = __builtin_bit_cast(bf16x8_t, b1);
        const MIX_LAS unsigned char* vp = VTl + r32 * vt_stride + (t * 32 + 8 * hi) * 2;
        const MIX_LAS unsigned char* vq = vp + 32 * vt_stride;
        { const bf16x8_t x0 = *(const MIX_LAS bf16x8_t*)(vp), y0 = *(const MIX_LAS bf16x8_t*)(vq);
          O0 = __builtin_amdgcn_mfma_f32_32x32x16_bf16(x0, pf0, O0, 0, 0, 0); O1 = __builtin_amdgcn_mfma_f32_32x32x16_bf16(y0, pf0, O1, 0, 0, 0); }
        { const bf16x8_t x0 = *(const MIX_LAS bf16x8_t*)(vp + 32), y0 = *(const MIX_LAS bf16x8_t*)(vq + 32);
          O0 = __builtin_amdgcn_mfma_f32_32x32x16_bf16(x0, pf1, O0, 0, 0, 0); O1 = __builtin_amdgcn_mfma_f32_32x32x16_bf16(y0, pf1, O1, 0, 0, 0); }
        { const bf16x8_t x0 = *(const MIX_LAS bf16x8_t*)(vp + 64), y0 = *(const MIX_LAS bf16x8_t*)(vq + 64);
          O0 = __builtin_amdgcn_mfma_f32_32x32x16_bf16(x0, pf2, O0, 0, 0, 0); O1 = __builtin_amdgcn_mfma_f32_32x32x16_bf16(y0, pf2, O1, 0, 0, 0); }
        { const bf16x8_t x0 = *(const MIX_LAS bf16x8_t*)(vp + 96), y0 = *(const MIX_LAS bf16x8_t*)(vq + 96);
          O0 = __builtin_amdgcn_mfma_f32_32x32x16_bf16(x0, pf3, O0, 0, 0, 0); O1 = __builtin_amdgcn_mfma_f32_32x32x16_bf16(y0, pf3, O1, 0, 0, 0); }
    }
    l += __shfl_xor(l, 32);
    const float inv = __builtin_amdgcn_rcpf(l);
#pragma unroll
    for (int dt = 0; dt < 2; ++dt)
#pragma unroll
        for (int g4 = 0; g4 < 4; ++g4) {
            const int d0 = dt * 32 + 8 * g4 + 4 * hi;
            const gu32x2 zw = *(const GAS gu32x2*)(zrow + d0);
            const float z0 = __uint_as_float(zw.x << 16), z1 = __uint_as_float(zw.x & 0xffff0000u), z2 = __uint_as_float(zw.y << 16), z3 = __uint_as_float(zw.y & 0xffff0000u);
            float o0, o1, o2, o3;
            if (dt == 0) { o0 = O0[4 * g4]; o1 = O0[4 * g4 + 1]; o2 = O0[4 * g4 + 2]; o3 = O0[4 * g4 + 3]; }
            else { o0 = O1[4 * g4]; o1 = O1[4 * g4 + 1]; o2 = O1[4 * g4 + 2]; o3 = O1[4 * g4 + 3]; }
            gu32x2 w; w.x = pkbf(o0 * inv * siluf_(z0), o1 * inv * siluf_(z1)); w.y = pkbf(o2 * inv * siluf_(z2), o3 * inv * siluf_(z3));
            *(GAS gu32x2*)(yrow + d0) = w;
        }
}
template <int NK, class KP, class VP>
__device__ __forceinline__ void attn_stage(MIX_LAS unsigned char* Kl, MIX_LAS unsigned char* VTl, int vt_stride, const KP& krow, const VP& vrow, int tid) {
    constexpr int NIT = NK * 8 / 512;
    {
        u32x4m kv[NIT];
#pragma unroll
        for (int it = 0; it < NIT; ++it) { const int idx = tid + it * 512, row = idx >> 3, ch = idx & 7; const GAS bf16_t* p = krow(row);
            kv[it] = (u32x4m){0u, 0u, 0u, 0u}; if (p) kv[it] = *(const GAS u32x4m*)(p + ch * 8); }
        asm volatile("" ::: "memory");
#pragma unroll
        for (int it = 0; it < NIT; ++it) { const int idx = tid + it * 512, row = idx >> 3, ch = idx & 7; *(MIX_LAS u32x4m*)(Kl + row * KROW + ch * 16) = kv[it]; }
    }
    {
        u32x4m vv[NIT];
#pragma unroll
        for (int it = 0; it < NIT; ++it) { const int idx = tid + it * 512, ch = idx / NK, row = idx - ch * NK; const GAS bf16_t* p = vrow(row);
            vv[it] = (u32x4m){0u, 0u, 0u, 0u}; if (p) vv[it] = *(const GAS u32x4m*)(p + ch * 8); }
        asm volatile("" ::: "memory");
#pragma unroll
        for (int it = 0; it < NIT; ++it) { const int idx = tid + it * 512, ch = idx / NK, row = idx - ch * NK;
            const int w = row & 31, wp = (w & 0x13) | ((w & 4) << 1) | ((w & 8) >> 1), pos = (row & ~31) + wp;
            MIX_LAS unsigned short* dst = (MIX_LAS unsigned short*)(VTl + (ch * 8) * vt_stride + pos * 2);
            const unsigned ww[4] = {vv[it].x, vv[it].y, vv[it].z, vv[it].w};
#pragma unroll
            for (int e = 0; e < 4; ++e) { dst[(2 * e) * (vt_stride / 2)] = (unsigned short)(ww[e] & 0xffffu); dst[(2 * e + 1) * (vt_stride / 2)] = (unsigned short)(ww[e] >> 16); } }
    }
}

__device__ __forceinline__ void winattn_item(int item, const GAS bf16_t* U, const GAS float* BIAS, const GAS float* sink, GAS bf16_t* Y, MIX_LAS unsigned char* lds, int tid, bool do_core = true) {
    constexpr int NK = 384, VTS = NK * 2 + 16;
    const int qb = item & 31, kvh = (item >> 5) & 1, b = item >> 6;
    MIX_LAS unsigned char* Kl = lds; MIX_LAS unsigned char* VTl = lds + NK * KROW; MIX_LAS float* biasl = (MIX_LAS float*)(lds + NK * KROW + 64 * VTS);
    const int kpos0 = qb * 128 - 128; const size_t rowb = (size_t)b * NS;
    auto krow = [&](int i) -> const GAS bf16_t* { const int p = kpos0 + i; return (p >= 0 && p < NS) ? U + (rowb + p) * NU + C_AK + kvh * 64 : (const GAS bf16_t*)nullptr; };
    auto vrow = [&](int i) -> const GAS bf16_t* { const int p = kpos0 + i; return (p >= 0 && p < NS) ? U + (rowb + p) * NU + C_AV + kvh * 64 : (const GAS bf16_t*)nullptr; };
    attn_stage<NK>(Kl, VTl, VTS, krow, vrow, tid);
    for (int i = tid; i < 2 * 321; i += 512) { const int g_ = i / 321, j = i - g_ * 321 - 32; biasl[i] = (j >= 0 && j < 257) ? BIAS[(kvh * 2 + g_) * 257 + j] * 1.4426950408889634f : 0.f; }
    const int lane = tid & 63, wave = __builtin_amdgcn_readfirstlane(tid >> 6), g = wave >> 2, wq = wave & 3, r32 = lane & 31, hi = lane >> 5, h = kvh * 2 + g;
    const size_t mq = rowb + qb * 128 + wq * 32 + r32;
    bf16x8_t qf[4];
#pragma unroll
    for (int ds = 0; ds < 4; ++ds) qf[ds] = *(const GAS bf16x8_t*)(U + mq * NU + C_AQ + h * 64 + ds * 16 + hi * 8);
    __syncthreads();
    const int tmin = (qb == 0) ? 4 : 0, tmax = (qb == 31) ? 8 : 12;
    int t_lo = wq > tmin ? wq : tmin, t_hi = (wq + 9) < tmax ? (wq + 9) : tmax;
    if ((t_hi - t_lo) & 1) { if (t_hi < tmax) ++t_hi; else --t_lo; }
    if (do_core) attn_core<true>(Kl, VTl, VTS, biasl + g * 321 + 32, qf, t_lo, t_hi, wq + 1, wq + 8, 128 + wq * 32 + r32, sink[h] * 1.4426950408889634f, 1.f, U + mq * NU + C_AZ + h * 64, Y + mq * NY + 3 * NW + h * 64, lane);
    __syncthreads();
}
__device__ __forceinline__ void memattn_item(int item, const GAS bf16_t* U, const GAS bf16_t* MKV, GAS bf16_t* Y, MIX_LAS unsigned char* lds, int tid) {
    constexpr int NK = 256, VTS = NK * 2 + 16;
    const int qblk = item & 7, h = (item >> 3) & 3, b = item >> 5;
    MIX_LAS unsigned char* Kl = lds; MIX_LAS unsigned char* VTl = lds + NK * KROW;
    auto krow = [&](int i) -> const GAS bf16_t* { return MKV + (size_t)(b * MEML + i) * 512 + h * 64; };
    auto vrow = [&](int i) -> const GAS bf16_t* { return MKV + (size_t)(b * MEML + i) * 512 + 256 + h * 64; };
    attn_stage<NK>(Kl, VTl, VTS, krow, vrow, tid);
    const int lane = tid & 63, wave = __builtin_amdgcn_readfirstlane(tid >> 6), r32 = lane & 31, hi = lane >> 5;
    __syncthreads();
#pragma nounroll
    for (int ps = 0; ps < 2; ++ps) { const size_t mq = (size_t)b * NS + qblk * 512 + ps * 256 + wave * 32 + r32;
        bf16x8_t qf[4];
#pragma unroll
        for (int ds = 0; ds < 4; ++ds) qf[ds] = *(const GAS bf16x8_t*)(U + mq * NU + C_MQ + h * 64 + ds * 16 + hi * 8);
        attn_core<false>(Kl, VTl, VTS, (const MIX_LAS float*)lds, qf, 0, 8, 0, 8, 0, -1e30f, 0.f, U + mq * NU + C_MZ + h * 64, Y + mq * NY + 4 * NW + h * 64, lane); }
    __syncthreads();
}
__device__ __forceinline__ void conformer_item(int item, const GAS bf16_t* U, const GAS float* dw_w, const GAS float* dw_b, const GAS float* ln_g, const GAS float* ln_b, GAS bf16_t* Y, MIX_LAS unsigned char* lds, int tid) {
    MIX_LAS unsigned short* ul = (MIX_LAS unsigned short*)lds; MIX_LAS float* cv = (MIX_LAS float*)(lds + 94 * 512);
    const int tt = item & 63, b = item >> 6; const size_t rowb = (size_t)b * NS; const int t0 = tt * 64;
    {
        u32x4m av[6], bv[6];
#pragma unroll
        for (int it = 0; it < 6; ++it) { const int idx = tid + it * 512, row = idx >> 5, ch = idx & 31, t = t0 - 15 + row;
            av[it] = (u32x4m){0u, 0u, 0u, 0u}; bv[it] = av[it];
            if (idx < 94 * 32 && t >= 0 && t < NS) { const GAS bf16_t* p = U + (rowb + t) * NU; av[it] = *(const GAS u32x4m*)(p + C_CA + ch * 8); bv[it] = *(const GAS u32x4m*)(p + C_CB + ch * 8); } }
        asm volatile("" ::: "memory");
#pragma unroll
        for (int it = 0; it < 6; ++it) { const int idx = tid + it * 512, row = idx >> 5, ch = idx & 31;
            const unsigned aw[4] = {av[it].x, av[it].y, av[it].z, av[it].w}, bw[4] = {bv[it].x, bv[it].y, bv[it].z, bv[it].w}; unsigned ow[4];
#pragma unroll
            for (int e = 0; e < 4; ++e) ow[e] = pkbf(__uint_as_float(aw[e] << 16) * sigmoidf_(__uint_as_float(bw[e] << 16)), __uint_as_float(aw[e] & 0xffff0000u) * sigmoidf_(__uint_as_float(bw[e] & 0xffff0000u)));
            if (idx < 94 * 32) *(MIX_LAS u32x4m*)(ul + row * 256 + ch * 8) = (u32x4m){ow[0], ow[1], ow[2], ow[3]}; }
    }
    __syncthreads();
    {
        const int c = tid & 255, half = tid >> 8;
        float w[31], u[62];
#pragma unroll
        for (int j = 0; j < 31; ++j) w[j] = dw_w[j * 256 + c];
#pragma unroll
        for (int j = 0; j < 62; ++j) u[j] = __uint_as_float((unsigned)ul[(half * 32 + j) * 256 + c] << 16);
        const float bias = dw_b[c];
#pragma unroll
        for (int i = 0; i < 32; ++i) { float a = bias;
#pragma unroll
            for (int j = 0; j < 31; ++j) a += w[j] * u[i + j];
            cv[(half * 32 + i) * 256 + c] = a; }
    }
    __syncthreads();
    {
        const int lane = tid & 63, wave = tid >> 6;
        const f32x4m g4 = ((const GAS f32x4m*)ln_g)[lane], b4 = ((const GAS f32x4m*)ln_b)[lane];
#pragma unroll
        for (int i = 0; i < 8; ++i) { const int t = wave * 8 + i;
            const f32x4m v = *(const MIX_LAS f32x4m*)(cv + t * 256 + lane * 4);
            float s1 = (v.x + v.y) + (v.z + v.w), s2 = (v.x * v.x + v.y * v.y) + (v.z * v.z + v.w * v.w);
#pragma unroll
            for (int o_ = 1; o_ < 64; o_ <<= 1) { s1 += __shfl_xor(s1, o_); s2 += __shfl_xor(s2, o_); }
            const float mu = s1 * (1.f / 256.f);
            const f32x4m d = v - mu;
            const float var = fmaxf(s2 * (1.f / 256.f) - mu * mu, 0.f);
            const float rs = rsqrtf(var + EPSF);
            const size_t m = rowb + t0 + t;
            const gu32x2 zw = *(const GAS gu32x2*)(U + m * NU + C_CZ + lane * 4);
            const float n0 = d.x * rs * g4.x + b4.x, n1 = d.y * rs * g4.y + b4.y, n2 = d.z * rs * g4.z + b4.z, n3 = d.w * rs * g4.w + b4.w;
            gu32x2 o; o.x = pkbf(siluf_(n0) * siluf_(__uint_as_float(zw.x << 16)), siluf_(n1) * siluf_(__uint_as_float(zw.x & 0xffff0000u)));
            o.y = pkbf(siluf_(n2) * siluf_(__uint_as_float(zw.y << 16)), siluf_(n3) * siluf_(__uint_as_float(zw.y & 0xffff0000u)));
            *(GAS gu32x2*)(Y + m * NY + 1 * NW + lane * 4) = o; }
    }
    __syncthreads();
}
__device__ __forceinline__ void shortconv_item(int item, const GAS bf16_t* U, const GAS float* w, GAS bf16_t* Y, int tid) {
    const int tt = item & 63, b = item >> 6; const size_t rowb = (size_t)b * NS;
    const int ch = tid & 31, tl = tid >> 5, t0 = tt * 64 + tl * 4;
    u32x4m cr[6], vr[6], br[4], zr[4];
#pragma unroll
    for (int r = 0; r < 6; ++r) { const int t = t0 - 1 + r; cr[r] = (u32x4m){0u, 0u, 0u, 0u}; vr[r] = cr[r];
        if (t >= 0 && t < NS) { const GAS bf16_t* p = U + (rowb + t) * NU; cr[r] = *(const GAS u32x4m*)(p + C_SC + ch * 8); vr[r] = *(const GAS u32x4m*)(p + C_SV + ch * 8); } }
#pragma unroll
    for (int i = 0; i < 4; ++i) { const GAS bf16_t* p = U + (rowb + t0 + i) * NU; br[i] = *(const GAS u32x4m*)(p + C_SB + ch * 8); zr[i] = *(const GAS u32x4m*)(p + C_SZ + ch * 8); }
    float w0[8], w1[8], w2[8];
#pragma unroll
    for (int e = 0; e < 8; ++e) { w0[e] = w[ch * 8 + e]; w1[e] = w[256 + ch * 8 + e]; w2[e] = w[512 + ch * 8 + e]; }
    asm volatile("" ::: "memory");
    float cv[6][8];
#pragma unroll
    for (int r = 0; r < 6; ++r) { const unsigned aw[4] = {cr[r].x, cr[r].y, cr[r].z, cr[r].w}, vw[4] = {vr[r].x, vr[r].y, vr[r].z, vr[r].w};
#pragma unroll
        for (int e = 0; e < 4; ++e) { cv[r][2 * e] = __uint_as_float(aw[e] << 16) * __uint_as_float(vw[e] << 16); cv[r][2 * e + 1] = __uint_as_float(aw[e] & 0xffff0000u) * __uint_as_float(vw[e] & 0xffff0000u); } }
#pragma unroll
    for (int i = 0; i < 4; ++i) {
        const unsigned bw[4] = {br[i].x, br[i].y, br[i].z, br[i].w}, zw[4] = {zr[i].x, zr[i].y, zr[i].z, zr[i].w}; unsigned ow[4];
#pragma unroll
        for (int e = 0; e < 4; ++e) {
            const float c0 = w0[2 * e] * cv[i][2 * e] + w1[2 * e] * cv[i + 1][2 * e] + w2[2 * e] * cv[i + 2][2 * e];
            const float c1 = w0[2 * e + 1] * cv[i][2 * e + 1] + w1[2 * e + 1] * cv[i + 1][2 * e + 1] + w2[2 * e + 1] * cv[i + 2][2 * e + 1];
            ow[e] = pkbf(__uint_as_float(bw[e] << 16) * c0 * siluf_(__uint_as_float(zw[e] << 16)), __uint_as_float(bw[e] & 0xffff0000u) * c1 * siluf_(__uint_as_float(zw[e] & 0xffff0000u))); }
        *(GAS u32x4m*)(Y + (rowb + t0 + i) * NY + 2 * NW + ch * 8) = (u32x4m){ow[0], ow[1], ow[2], ow[3]};
    }
}

constexpr size_t HG_ST_BYTES = (size_t)NB * 4 * 2 * 64 * 8192;
constexpr int H1_WLDS = 10240, H3_WLDS = 14848;
__device__ __forceinline__ void wave_lds_sync() { asm volatile("s_waitcnt lgkmcnt(0)" ::: "memory"); __builtin_amdgcn_wave_barrier(); asm volatile("" ::: "memory"); }
__device__ __forceinline__ void hgrn_gate(float fl, float lb, float& f, float& g) { const float s = __builtin_amdgcn_rcpf(1.f + __expf(-fl)); f = lb + (1.f - lb) * s; g = __builtin_amdgcn_logf(f) * 0.69314718056f; }
typedef unsigned u32x4h __attribute__((ext_vector_type(4)));

__device__ __forceinline__ void hgrn_h1_item(int item, const GAS bf16_t* U, const GAS float* LBl, GAS unsigned char* ST, GAS float* DC, MIX_LAS unsigned char* wl, int lane) {
    const int j = item & 63, dir = (item >> 6) & 1, h = (item >> 7) & 3, b = item >> 9;
    const int c = dir ? 63 - j : j;
    const size_t row0 = (size_t)b * NS + (size_t)c * 64;
    const int fcol = (dir ? C_HFB : C_HFF) + h * 64 + lane, vcol = C_HI + h * 64 + lane;
    const float lb = LBl[dir * 256 + h * 64 + lane];
    const int r32 = lane & 31, hi = lane >> 5;
    MIX_LAS unsigned char* KT = wl; MIX_LAS unsigned char* VT = wl + 5120;
    f32x16_t acc[2][2];
#pragma unroll
    for (int a = 0; a < 2; ++a)
#pragma unroll
        for (int bb = 0; bb < 2; ++bb)
#pragma unroll
            for (int r = 0; r < 16; ++r) acc[a][bb][r] = 0.f;
    float rsum = 0.f;
#pragma unroll
    for (int half = 0; half < 2; ++half) {
        unsigned kw[16], vw[16], fr[32], vr[32];
#pragma unroll
        for (int i = 0; i < 32; ++i) {
            const int tau = 63 - 32 * half - i, u = dir ? 63 - tau : tau;
            const GAS bf16_t* p = U + (row0 + u) * NU; fr[i] = p[fcol]; vr[i] = p[vcol];
        }
        asm volatile("" ::: "memory");
#pragma unroll
        for (int pr = 0; pr < 16; ++pr) {
            float f, g;
            hgrn_gate(__uint_as_float(fr[2 * pr] << 16), lb, f, g); const float k_hi = (1.f - f) * __expf(rsum); rsum += g;
            hgrn_gate(__uint_as_float(fr[2 * pr + 1] << 16), lb, f, g); const float k_lo = (1.f - f) * __expf(rsum); rsum += g;
            kw[15 - pr] = pkbf(k_lo, k_hi);
            vw[15 - pr] = vr[2 * pr + 1] | (vr[2 * pr] << 16);
        }
#pragma unroll
        for (int g8 = 0; g8 < 4; ++g8) {
            *(MIX_LAS u32x4h*)(KT + lane * 80 + g8 * 16) = (u32x4h){kw[4 * g8], kw[4 * g8 + 1], kw[4 * g8 + 2], kw[4 * g8 + 3]};
            *(MIX_LAS u32x4h*)(VT + lane * 80 + g8 * 16) = (u32x4h){vw[4 * g8], vw[4 * g8 + 1], vw[4 * g8 + 2], vw[4 * g8 + 3]};
        }
        wave_lds_sync();
#pragma unroll
        for (int s = 0; s < 2; ++s) {
            bf16x8_t af[2], bfr[2];
#pragma unroll
            for (int x = 0; x < 2; ++x) { af[x] = *(const MIX_LAS bf16x8_t*)(KT + (r32 + 32 * x) * 80 + (16 * s + 8 * hi) * 2); bfr[x] = *(const MIX_LAS bf16x8_t*)(VT + (r32 + 32 * x) * 80 + (16 * s + 8 * hi) * 2); }
#pragma unroll
            for (int kt = 0; kt < 2; ++kt)
#pragma unroll
                for (int vt = 0; vt < 2; ++vt) acc[kt][vt] = __builtin_amdgcn_mfma_f32_32x32x16_bf16(af[kt], bfr[vt], acc[kt][vt], 0, 0, 0);
        }
        wave_lds_sync();
    }
    DC[(size_t)item * 64 + lane] = __expf(rsum);
    GAS unsigned char* out = ST + (size_t)item * 8192;
#pragma unroll
    for (int kt = 0; kt < 2; ++kt)
#pragma unroll
        for (int vt = 0; vt < 2; ++vt)
#pragma unroll
            for (int g4 = 0; g4 < 4; ++g4) { const int k0 = 32 * kt + 8 * g4 + 4 * hi, v = 32 * vt + r32;
                gu32x2 w; w.x = pkbf(acc[kt][vt][4 * g4], acc[kt][vt][4 * g4 + 1]); w.y = pkbf(acc[kt][vt][4 * g4 + 2], acc[kt][vt][4 * g4 + 3]);
                *(GAS gu32x2*)(out + (v * 64 + k0) * 2) = w; }
}

__device__ __forceinline__ void hgrn_h2_item(int item, GAS unsigned char* ST, const GAS float* DC, int tid) {
    const int seq = item >> 2, e = (item & 3) * 512 + tid, kp = e & 31;
    GAS unsigned char* base = ST + (size_t)seq * 64 * 8192 + (size_t)e * 4;
    const GAS float* dcb = DC + (size_t)seq * 64 * 64 + kp * 2;
    float s0 = 0.f, s1 = 0.f;
    for (int j0 = 0; j0 < 64; j0 += 16) {
        unsigned hc[16]; gf32x2 dc[16];
#pragma unroll
        for (int jj = 0; jj < 16; ++jj) { hc[jj] = *(const GAS unsigned*)(base + (size_t)(j0 + jj) * 8192); dc[jj] = *(const GAS gf32x2*)(dcb + (j0 + jj) * 64); }
#pragma unroll
        for (int jj = 0; jj < 16; ++jj) {
            *(GAS unsigned*)(base + (size_t)(j0 + jj) * 8192) = pkbf(s0, s1);
            s0 = dc[jj].x * s0 + __uint_as_float(hc[jj] << 16); s1 = dc[jj].y * s1 + __uint_as_float(hc[jj] & 0xffff0000u);
        }
    }
}

template <int DIR>
__device__ __forceinline__ void hgrn_h3_dir(f32x16_t (&O)[2][2], const GAS bf16_t* U_, size_t row0, int h, float lb, const GAS unsigned char* Sp, MIX_LAS unsigned char* wl, int lane) {
    const GAS bf16_t* U = U_; asm volatile("" : "+s"(U));
    const int r32 = lane & 31, hi = lane >> 5;
    MIX_LAS unsigned char* Ql = wl; MIX_LAS unsigned char* Kl = wl + 4608; MIX_LAS unsigned char* VTl = wl + 9216; MIX_LAS float* decl = (MIX_LAS float*)(wl + 14336);
    const int fcol = (DIR ? C_HFB : C_HFF) + h * 64 + lane, qcol = C_HQ + h * 64 + lane, vcol = C_HI + h * 64 + lane;
    bf16x8_t kfA[4], vfA[2][2];
#pragma unroll
    for (int sub = 0; sub < 2; ++sub) {
        constexpr int dummy = 0; (void)dummy;
        const int tile = DIR ? 1 - sub : sub;
        float a = 0.f; unsigned vw[16];
#pragma unroll
        for (int bt = 0; bt < 2; ++bt) {
            unsigned fr[16], qr[16], vr[16];
#pragma unroll
            for (int x = 0; x < 16; ++x) { const int i = 16 * bt + x, ul = DIR ? 31 - i : i;
                const GAS bf16_t* p = U + (row0 + 32 * tile + ul) * NU; fr[x] = p[fcol]; qr[x] = p[qcol]; vr[x] = p[vcol]; }
            asm volatile("" ::: "memory");
#pragma unroll
            for (int pp = 0; pp < 8; ++pp) {
                const int pr = 8 * bt + pp;
#pragma unroll
                for (int x = 0; x < 2; ++x) {
                    const int i = 2 * pr + x, ul = DIR ? 31 - i : i;
                    float f, g; hgrn_gate(__uint_as_float(fr[2 * pp + x] << 16), lb, f, g); a += g;
                    const float qa = __uint_as_float(qr[2 * pp + x] << 16) * __expf(a), ka = (1.f - f) * __expf(fminf(-a, 80.f));
                    *(MIX_LAS unsigned short*)(Ql + ul * 144 + lane * 2) = (unsigned short)(pkbf(qa, 0.f) & 0xffffu);
                    *(MIX_LAS unsigned short*)(Kl + ul * 144 + lane * 2) = (unsigned short)(pkbf(ka, 0.f) & 0xffffu);
                }
                const int ul_even = DIR ? 30 - 2 * pr : 2 * pr;
                const int pe = (ul_even & 0x13) | ((ul_even & 4) << 1) | ((ul_even & 8) >> 1);
                vw[pe >> 1] = DIR ? (vr[2 * pp + 1] | (vr[2 * pp] << 16)) : (vr[2 * pp] | (vr[2 * pp + 1] << 16));
            }
        }
        decl[sub * 64 + lane] = __expf(a);
#pragma unroll
        for (int g8 = 0; g8 < 4; ++g8) *(MIX_LAS u32x4h*)(VTl + lane * 80 + g8 * 16) = (u32x4h){vw[4 * g8], vw[4 * g8 + 1], vw[4 * g8 + 2], vw[4 * g8 + 3]};
        wave_lds_sync();
        bf16x8_t qf[4], kf[4], vf[2][2];
#pragma unroll
        for (int ds = 0; ds < 4; ++ds) { qf[ds] = *(const MIX_LAS bf16x8_t*)(Ql + r32 * 144 + ds * 32 + hi * 16); kf[ds] = *(const MIX_LAS bf16x8_t*)(Kl + r32 * 144 + ds * 32 + hi * 16); }
#pragma unroll
        for (int vt = 0; vt < 2; ++vt)
#pragma unroll
            for (int s = 0; s < 2; ++s) vf[vt][s] = *(const MIX_LAS bf16x8_t*)(VTl + (r32 + 32 * vt) * 80 + (16 * s + 8 * hi) * 2);
        f32x16_t P;
#pragma unroll
        for (int r = 0; r < 16; ++r) P[r] = 0.f;
#pragma unroll
        for (int ds = 0; ds < 4; ++ds) P = __builtin_amdgcn_mfma_f32_32x32x16_bf16(kf[ds], qf[ds], P, 0, 0, 0);
#pragma unroll
        for (int r = 0; r < 16; ++r) { const int s_ = crow_(r, hi); const bool keep = DIR ? (s_ >= r32) : (s_ <= r32); P[r] = keep ? P[r] : 0.f; }
        {
            u32x4h p0, p1;
            p0.x = pkbf(P[0], P[1]); p0.y = pkbf(P[2], P[3]); p0.z = pkbf(P[4], P[5]); p0.w = pkbf(P[6], P[7]);
            p1.x = pkbf(P[8], P[9]); p1.y = pkbf(P[10], P[11]); p1.z = pkbf(P[12], P[13]); p1.w = pkbf(P[14], P[15]);
            const bf16x8_t pf0 = __builtin_bit_cast(bf16x8_t, p0), pf1 = __builtin_bit_cast(bf16x8_t, p1);
#pragma unroll
            for (int vt = 0; vt < 2; ++vt) { O[vt][tile] = __builtin_amdgcn_mfma_f32_32x32x16_bf16(vf[vt][0], pf0, O[vt][tile], 0, 0, 0); O[vt][tile] = __builtin_amdgcn_mfma_f32_32x32x16_bf16(vf[vt][1], pf1, O[vt][tile], 0, 0, 0); }
        }
        if (sub == 0) {
#pragma unroll
            for (int vt = 0; vt < 2; ++vt)
#pragma unroll
                for (int ks = 0; ks < 4; ++ks) { const bf16x8_t sf = *(const GAS bf16x8_t*)(Sp + ((r32 + 32 * vt) * 64 + 16 * ks + 8 * hi) * 2);
                    O[vt][tile] = __builtin_amdgcn_mfma_f32_32x32x16_bf16(sf, qf[ks], O[vt][tile], 0, 0, 0); }
#pragma unroll
            for (int ds = 0; ds < 4; ++ds) kfA[ds] = kf[ds];
#pragma unroll
            for (int vt = 0; vt < 2; ++vt) { vfA[vt][0] = vf[vt][0]; vfA[vt][1] = vf[vt][1]; }
        } else {
            bf16x8_t qd[4];
#pragma unroll
            for (int ds = 0; ds < 4; ++ds) {
                const f32x4m d0 = *(const MIX_LAS f32x4m*)(decl + 16 * ds + 8 * hi), d1 = *(const MIX_LAS f32x4m*)(decl + 16 * ds + 8 * hi + 4);
                const u32x4h qw = __builtin_bit_cast(u32x4h, qf[ds]); u32x4h o;
                o.x = pkbf(__uint_as_float(qw.x << 16) * d0.x, __uint_as_float(qw.x & 0xffff0000u) * d0.y); o.y = pkbf(__uint_as_float(qw.y << 16) * d0.z, __uint_as_float(qw.y & 0xffff0000u) * d0.w);
                o.z = pkbf(__uint_as_float(qw.z << 16) * d1.x, __uint_as_float(qw.z & 0xffff0000u) * d1.y); o.w = pkbf(__uint_as_float(qw.w << 16) * d1.z, __uint_as_float(qw.w & 0xffff0000u) * d1.w);
                qd[ds] = __builtin_bit_cast(bf16x8_t, o);
            }
            f32x16_t P2;
#pragma unroll
            for (int r = 0; r < 16; ++r) P2[r] = 0.f;
#pragma unroll
            for (int ds = 0; ds < 4; ++ds) P2 = __builtin_amdgcn_mfma_f32_32x32x16_bf16(kfA[ds], qd[ds], P2, 0, 0, 0);
            u32x4h p0, p1;
            p0.x = pkbf(P2[0], P2[1]); p0.y = pkbf(P2[2], P2[3]); p0.z = pkbf(P2[4], P2[5]); p0.w = pkbf(P2[6], P2[7]);
            p1.x = pkbf(P2[8], P2[9]); p1.y = pkbf(P2[10], P2[11]); p1.z = pkbf(P2[12], P2[13]); p1.w = pkbf(P2[14], P2[15]);
            const bf16x8_t pf0 = __builtin_bit_cast(bf16x8_t, p0), pf1 = __builtin_bit_cast(bf16x8_t, p1);
#pragma unroll
            for (int vt = 0; vt < 2; ++vt) { O[vt][tile] = __builtin_amdgcn_mfma_f32_32x32x16_bf16(vfA[vt][0], pf0, O[vt][tile], 0, 0, 0); O[vt][tile] = __builtin_amdgcn_mfma_f32_32x32x16_bf16(vfA[vt][1], pf1, O[vt][tile], 0, 0, 0); }
#pragma unroll
            for (int vt = 0; vt < 2; ++vt)
#pragma unroll
                for (int ks = 0; ks < 4; ++ks) { const bf16x8_t sf = *(const GAS bf16x8_t*)(Sp + ((r32 + 32 * vt) * 64 + 16 * ks + 8 * hi) * 2);
                    O[vt][tile] = __builtin_amdgcn_mfma_f32_32x32x16_bf16(sf, qd[ks], O[vt][tile], 0, 0, 0); }
        }
        wave_lds_sync();
    }
}
__device__ __forceinline__ void hgrn_h3_item(int item, const GAS bf16_t* U, const GAS float* LBl, const GAS float* onorm, const GAS unsigned char* ST, GAS bf16_t* Y, MIX_LAS unsigned char* wl, int lane) {
    const int c = item & 63, h = (item >> 6) & 3, b = item >> 8;
    const int r32 = lane & 31, hi = lane >> 5;
    const size_t row0 = (size_t)b * NS + (size_t)c * 64;
    f32x16_t O[2][2];
#pragma unroll
    for (int a = 0; a < 2; ++a)
#pragma unroll
        for (int bb = 0; bb < 2; ++bb)
#pragma unroll
            for (int r = 0; r < 16; ++r) O[a][bb][r] = 0.f;
    const size_t s_f = ((size_t)((b * 4 + h) * 2 + 0) * 64 + c), s_b = ((size_t)((b * 4 + h) * 2 + 1) * 64 + (63 - c));
    hgrn_h3_dir<0>(O, U, row0, h, LBl[0 * 256 + h * 64 + lane], ST + s_f * 8192, wl, lane);
    hgrn_h3_dir<1>(O, U, row0, h, LBl[1 * 256 + h * 64 + lane], ST + s_b * 8192, wl, lane);
#pragma unroll
    for (int tile = 0; tile < 2; ++tile) {
        float ss = 0.f;
#pragma unroll
        for (int vt = 0; vt < 2; ++vt)
#pragma unroll
            for (int r = 0; r < 16; ++r) ss += O[vt][tile][r] * O[vt][tile][r];
        ss += __shfl_xor(ss, 32);
        const float rs = rsqrtf(ss * (1.f / 64.f) + EPSF);
        const size_t m = row0 + 32 * tile + r32;
#pragma unroll
        for (int vt = 0; vt < 2; ++vt)
#pragma unroll
            for (int g4 = 0; g4 < 4; ++g4) { const int v0 = 32 * vt + 8 * g4 + 4 * hi;
                const gu32x2 zw = *(const GAS gu32x2*)(U + m * NU + C_HZ + h * 64 + v0);
                const f32x4m on = *(const GAS f32x4m*)(onorm + v0);
                gu32x2 w;
                w.x = pkbf(O[vt][tile][4 * g4] * rs * on.x * siluf_(__uint_as_float(zw.x << 16)), O[vt][tile][4 * g4 + 1] * rs * on.y * siluf_(__uint_as_float(zw.x & 0xffff0000u)));
                w.y = pkbf(O[vt][tile][4 * g4 + 2] * rs * on.z * siluf_(__uint_as_float(zw.y << 16)), O[vt][tile][4 * g4 + 3] * rs * on.w * siluf_(__uint_as_float(zw.y & 0xffff0000u)));
                *(GAS gu32x2*)(Y + m * NY + h * 64 + v0) = w; }
    }
}
__global__ void __launch_bounds__(NWAVES * 64, 2) mk_fwd(Args a) {
    extern __shared__ __attribute__((aligned(16))) unsigned char lds_raw[];
    LAS unsigned char* lds = (LAS unsigned char*)lds_raw;
    volatile LAS unsigned* MISC = (volatile LAS unsigned*)(lds + MISC_OFF);
    const int tid = threadIdx.x, lane = tid & 63, wave = __builtin_amdgcn_readfirstlane(tid >> 6);
    const int G = gridDim.x; const int bx = blockIdx.x; const int vcu = (G % 8 == 0) ? (bx % 8) * (G / 8) + bx / 8 : bx;
    const int gw = vcu * NWAVES + wave, NGW = G * NWAVES;
    unsigned char* ws = a.ws;
    for (int u = tid; u < (LDS_BYTES - LDSCTL_OFF) / 4; u += NWAVES * 64) ((LAS unsigned*)(lds + LDSCTL_OFF))[u] = 0u;
    __syncthreads();
    XcdBarrier bar = xcd_barrier_post((unsigned*)(ws + WS_CTL) + CW_BAR + a.li * XCD_BAR_WORDS, MISC + 8);
    const int lo = a.ph_lo, hi = a.ph_hi;
#ifndef PROBE_DUP
#define PROBE_DUP -1
#endif
#ifndef PROBE_SUB
#define PROBE_SUB -1
#endif
#define REPS(k) ((PROBE_DUP == (k)) ? 2 : 1)
#define IN(k) (lo <= (k) && (k) < hi)
#define SEAM(k) do { if (IN(k) && IN((k) + 1)) { xcd_barrier(bar); if (PROBE_DUP == 200) xcd_barrier(bar); } } while (0)

#define DEFBUFS(wsp) bf16_t* const H = (bf16_t*)((wsp) + WS_H); bf16_t* const MG = (bf16_t*)((wsp) + WS_U + 160 * MiB); \
    bf16_t* const U = (bf16_t*)((wsp) + WS_U); bf16_t* const GB = (bf16_t*)((wsp) + WS_U); bf16_t* const OUTRAW = (bf16_t*)((wsp) + WS_U); \
    bf16_t* const Y = (bf16_t*)((wsp) + WS_Y); (void)H; (void)MG; (void)U; (void)GB; (void)OUTRAW; (void)Y;
    float* const X = a.out;

    if (IN(0)) for (int rep0 = 0; rep0 < (PROBE_DUP == 100 ? 2 : 1); ++rep0) {
        if (rep0) xcd_barrier(bar);
        DEFBUFS(ws)
        if (bx == 0) {
            float* LB = (float*)(ws + WS_LB); float* BIAS = (float*)(ws + WS_BIAS); const float* lb_logits = a.in[5]; const float* rel_bias = a.in[13];
            { float v[NL], mx = -1e30f, s = 0.f;
#pragma unroll
                for (int l = 0; l < NL; ++l) { v[l] = lb_logits[l * 512 + tid]; mx = fmaxf(mx, v[l]); }
#pragma unroll
                for (int l = 0; l < NL; ++l) { v[l] = __expf(v[l] - mx); s += v[l]; }
                float c = 0.f;
#pragma unroll
                for (int l = 0; l < NL; ++l) { if (l > 0) c += v[l] / s; LB[l * 512 + tid] = c; } }
            for (int i = tid; i < 4 * 257; i += NWAVES * 64) {
                const int h = i / 257, rel = i % 257 - 128; int n = -rel; const int ret = (n < 0) ? 16 : 0; n = n < 0 ? -n : n;
                int bucket;
                if (n < 8) bucket = n; else if (n < 12) bucket = 8; else if (n < 16) bucket = 9; else if (n < 23) bucket = 10; else if (n < 32) bucket = 11;
                else if (n < 46) bucket = 12; else if (n < 64) bucket = 13; else if (n < 91) bucket = 14; else bucket = 15;
                BIAS[i] = rel_bias[(ret + bucket) * 4 + h]; }
        }
        convert_weights(ws, a.in[4], a.in[16], a.in[17], a.in[18], 0, 3, lds, gw, NGW, wave, lane);
        {
            bf16_t* MEMN = (bf16_t*)(ws + WS_Y); bf16_t* WKV = (bf16_t*)(ws + WS_Y + 16 * MiB);
            for (int r = gw; r < NL * NB * MEML; r += NGW) { const int l = r / (NB * MEML), row = r - l * (NB * MEML);
                rms_row_to_bf16(a.in[1] + (size_t)row * ND, a.in[14] + l * ND, MEMN + (size_t)r * ND, lane); }
            LAS float* scr = (LAS float*)(lds + RING_OFF + wave * 16384);
            for (int it = gw; it < NL * 256; it += NGW) { const int l = it >> 8; transpose_item(a.in[15] + (size_t)l * ND * 512, ND, 512, WKV + (size_t)l * 512 * ND, scr, it & 255, lane); }
        }
        for (int m = gw; m < NM; m += NGW) rms_row_to_bf16(a.in[0] + (size_t)m * ND, a.in[2], H + (size_t)m * ND, lane);
        SEAM(0);
    }
    for (int l = 0; l < NL; ++l) {
        const int base = 1 + l * PH_PER_LAYER;
        unsigned char* wsl = ws; asm volatile("" : "+s"(wsl));
        DEFBUFS(wsl)
        if (IN(base + PH_A)) {
            pg8::Gemm g{H, (const bf16_t*)(wsl + WS_WIN), ND, ND, ND, 0u, 0u};
            pg8::TileOrder<1> S; S.init(NM, NU, G, bx);
            pg8::EpiStore E{(GAS bf16_t*)U, NU};
            for (int rep = 0; rep < REPS(PH_A); ++rep) { pg8::gemm_phase<pg8::EpiStore, pg8::TileOrder<1>, true>(lds + RING_OFF, g, S, E); if (rep + 1 < REPS(PH_A)) xcd_barrier(bar); }
            if (l == 0) {
                const int u = bx - 128;
                pg8::OneUnit S2; S2.valid = (u >= 0 && u < 64); S2.u.pz = (u >> 4) & 3; S2.u.pm = (u >> 1) & 7; S2.u.pn = u & 1;
                pg8::Gemm g2{(const bf16_t*)(wsl + WS_Y), (const bf16_t*)(wsl + WS_Y + 16 * MiB), ND, ND, ND, (unsigned)(NB * MEML * ND * 2), (unsigned)(512 * ND * 2)};
                pg8::EpiStoreZ E2{(GAS bf16_t*)(wsl + WS_MEMKV), 512, (size_t)NB * MEML * 512};
                pg8::gemm_phase<pg8::EpiStoreZ, pg8::OneUnit, true>(lds + RING_OFF, g2, S2, E2);
            }
            SEAM(base + PH_A);
        }
        if (IN(base + PH_M1)) {
            int tl = threadIdx.x; asm volatile("" : "+v"(tl));
            const float* cw = a.in[7]; const float* cb = a.in[8]; const float* cg = a.in[9]; const float* cbb = a.in[10]; const float* scw = a.in[11]; const float* snk = a.in[12];
            asm volatile("" : "+s"(cw), "+s"(cb), "+s"(cg), "+s"(cbb), "+s"(scw), "+s"(snk));
            const bf16_t* MKV = (const bf16_t*)(wsl + WS_MEMKV) + (size_t)l * NB * MEML * 512;
            const float* BIASp = (const float*)(wsl + WS_BIAS);
#define M1_WA for (int it = bx; it < 512; it += G) winattn_item(it, (const GAS bf16_t*)U, (const GAS float*)BIASp, (const GAS float*)(snk + l * 4), (GAS bf16_t*)Y, lds + RING_OFF, tl);
#define M1_MA for (int it = bx; it < 256; it += G) memattn_item(it, (const GAS bf16_t*)U, (const GAS bf16_t*)MKV, (GAS bf16_t*)Y, lds + RING_OFF, tl);
#define M1_CF for (int it = bx; it < 512; it += G) conformer_item(it, (const GAS bf16_t*)U, (const GAS float*)(cw + l * 31 * 256), (const GAS float*)(cb + l * 256), (const GAS float*)(cg + l * 256), (const GAS float*)(cbb + l * 256), (GAS bf16_t*)Y, lds + RING_OFF, tl);
#define M1_SC for (int it = bx; it < 512; it += G) shortconv_item(it, (const GAS bf16_t*)U, (const GAS float*)(scw + l * 3 * 256), (GAS bf16_t*)Y, tl);
#define M1_H1 { const float* LBl = (const float*)(wsl + WS_LB) + l * 512; unsigned char* ST = wsl + WS_ST; float* DC = (float*)(wsl + WS_ST + HG_ST_BYTES); \
                const int lane = tl & 63, wave = __builtin_amdgcn_readfirstlane(tl >> 6); \
                for (int it = bx * 8 + wave; it < 4096; it += G * 8) hgrn_h1_item(it, (const GAS bf16_t*)U, (const GAS float*)LBl, (GAS unsigned char*)ST, (GAS float*)DC, lds + RING_OFF + wave * H1_WLDS, lane); }
#if PROBE_DUP == 1 && PROBE_SUB == 10
            for (int it = bx; it < 512; it += G) winattn_item(it, (const GAS bf16_t*)U, (const GAS float*)BIASp, (const GAS float*)(snk + l * 4), (GAS bf16_t*)Y, lds + RING_OFF, tl, false);
#endif
            M1_WA
#if PROBE_DUP == 1 && PROBE_SUB == 0
            M1_WA
#endif
            M1_MA
#if PROBE_DUP == 1 && PROBE_SUB == 1
            M1_MA
#endif
            M1_CF
#if PROBE_DUP == 1 && PROBE_SUB == 2
            M1_CF
#endif
            M1_SC
#if PROBE_DUP == 1 && PROBE_SUB == 3
            M1_SC
#endif
            M1_H1
#if PROBE_DUP == 1 && PROBE_SUB == 4
            __syncthreads();
            M1_H1
#endif
            SEAM(base + PH_M1);
        }
        if (IN(base + PH_M2)) {
            int tl = threadIdx.x; asm volatile("" : "+v"(tl));
            unsigned char* ST = wsl + WS_ST; const float* DC = (const float*)(wsl + WS_ST + HG_ST_BYTES);
            for (int it = bx; it < 256; it += G) hgrn_h2_item(it, (GAS unsigned char*)ST, (const GAS float*)DC, tl);
            if (PROBE_DUP == PH_M2) {
                xcd_barrier(bar);
                const float* LBl = (const float*)(wsl + WS_LB) + l * 512; const int lane = tl & 63, wave = __builtin_amdgcn_readfirstlane(tl >> 6);
                for (int it = bx * 8 + wave; it < 4096; it += G * 8) hgrn_h1_item(it, (const GAS bf16_t*)U, (const GAS float*)LBl, (GAS unsigned char*)ST, (GAS float*)DC, lds + RING_OFF + wave * H1_WLDS, lane);
                xcd_barrier(bar);
                for (int it = bx; it < 256; it += G) hgrn_h2_item(it, (GAS unsigned char*)ST, (const GAS float*)DC, tl);
            }
            SEAM(base + PH_M2);
        }
        if (IN(base + PH_M3)) {
            int tl = threadIdx.x; asm volatile("" : "+v"(tl));
            const float* onp = a.in[6]; asm volatile("" : "+s"(onp));
            const float* LBl = (const float*)(wsl + WS_LB) + l * 512; const unsigned char* ST = wsl + WS_ST;
            const int lane = tl & 63, wave = __builtin_amdgcn_readfirstlane(tl >> 6);
            for (int rep = 0; rep < REPS(PH_M3); ++rep)
            for (int it = bx * 8 + wave; it < 2048; it += G * 8) hgrn_h3_item(it, (const GAS bf16_t*)U, (const GAS float*)LBl, (const GAS float*)(onp + l * 64), (const GAS unsigned char*)ST, (GAS bf16_t*)Y, lds + RING_OFF + wave * H3_WLDS, lane);
            SEAM(base + PH_M3);
        }
        if (IN(base + PH_G)) {
            for (int ti = 0; ti * G + bx < (NM / 256) * (ND / 256); ++ti) {
                unsigned char* wst = wsl; asm volatile("" : "+s"(wst));
                const bf16_t* H = (const bf16_t*)(wst + WS_H); const bf16_t* Y = (const bf16_t*)(wst + WS_Y); bf16_t* MG = (bf16_t*)(wst + WS_U + 160 * MiB);
                GAS bf16_t* GS = (GAS bf16_t*)(wst + WS_U) + (size_t)bx * (5 * pg8::GS_SLOT);
                { pg8::Gemm g{H, (const bf16_t*)(wst + WS_WG), ND, ND, ND, 0u, (unsigned)(ND * ND * 2)};
                  pg8::TileRound<5> S; S.T.init(NM, ND, G, bx); S.ti = ti;
                  pg8::EpiGate E{GS};
                  pg8::gemm_phase<pg8::EpiGate, pg8::TileRound<5>, true>(lds + RING_OFF, g, S, E); }
                { pg8::Gemm g{Y, (const bf16_t*)(wst + WS_WB), NY, NW, NW, (unsigned)(NW * 2), (unsigned)(ND * NW * 2)};
                  pg8::TileRound<5> S; S.T.init(NM, ND, G, bx); S.ti = ti;
                  pg8::EpiMerge E{GS, (GAS bf16_t*)MG};
                  pg8::gemm_phase<pg8::EpiMerge, pg8::TileRound<5>, true>(lds + RING_OFF, g, S, E); }
            }
        }
        if (IN(base + PH_C)) { SEAM(base + PH_C); }
        if (IN(base + PH_D)) {
            pg8::Gemm g{MG, (const bf16_t*)(wsl + WS_WO), ND, ND, ND, 0u, 0u};
            pg8::TileOrder<1> S; S.init(NM, ND, G, bx);
            pg8::EpiStore E{(GAS bf16_t*)OUTRAW, ND};
            for (int rep = 0; rep < REPS(PH_D); ++rep) { pg8::gemm_phase<pg8::EpiStore, pg8::TileOrder<1>, true>(lds + RING_OFF, g, S, E); if (rep + 1 < REPS(PH_D)) xcd_barrier(bar); }
            SEAM(base + PH_D);
        }
        if (IN(base + PH_T)) {
            int tl = threadIdx.x; asm volatile("" : "+v"(tl)); const int lane = tl & 63, wave = __builtin_amdgcn_readfirstlane(tl >> 6), gw = vcu * NWAVES + wave;
            const float* x0 = a.in[0]; const float* npre = a.in[2]; const float* npost = a.in[3]; float* Xl = X;
            const float* wi = a.in[4]; const float* wgt = a.in[16]; const float* wbr = a.in[17]; const float* wou = a.in[18];
            asm volatile("" : "+s"(x0), "+s"(npre), "+s"(npost), "+s"(Xl), "+s"(wi), "+s"(wgt), "+s"(wbr), "+s"(wou));
            const float* xin = (l == 0) ? x0 : Xl;
            const bool has_next = (l + 1 < NL);
            for (int rep = 0; rep < ((PROBE_DUP == PH_T && l == 0) ? 9 : 1); ++rep)
                post_rows(xin, OUTRAW, npost + l * ND, npre + (has_next ? l + 1 : l) * ND, Xl, H, has_next, gw, NGW, lane);
            if (has_next) { convert_weights(wsl, wi, wgt, wbr, wou, l + 1, 3, lds, gw, NGW, wave, lane); SEAM(base + PH_T); }
        }
    }
#undef IN
#undef SEAM
}

extern "C" void kernel_launch(void* const* d_in, const int* in_sizes, int n_in, void* d_out, int out_size, void* d_ws, size_t ws_size, hipStream_t stream) {
    static int grid = 0;
    if (grid == 0) {
        if (n_in != 19 || in_sizes[0] != NM * ND || out_size != NM * ND || ws_size < WS_END) {
            fprintf(stderr, "kernel_launch: unexpected shapes/workspace (n_in %d, in0 %d, out %d, ws %zu, need %zu)\n", n_in, n_in > 0 ? in_sizes[0] : -1, out_size, ws_size, (size_t)WS_END);
            grid = -1; return;
        }
        int dev = 0, cus = 0, per_cu = 0;
        if (hipGetDevice(&dev) != hipSuccess || hipDeviceGetAttribute(&cus, hipDeviceAttributeMultiprocessorCount, dev) != hipSuccess) { grid = -1; return; }
        if (hipFuncSetAttribute((const void*)mk_fwd, hipFuncAttributeMaxDynamicSharedMemorySize, LDS_BYTES) != hipSuccess) { fprintf(stderr, "kernel_launch: hipFuncSetAttribute failed\n"); grid = -1; return; }
        if (hipOccupancyMaxActiveBlocksPerMultiprocessor(&per_cu, (const void*)mk_fwd, NWAVES * 64, LDS_BYTES) != hipSuccess || per_cu < 1)
            fprintf(stderr, "kernel_launch: occupancy query reports %d workgroups per CU\n", per_cu);
        (void)hipGetLastError();
        grid = cus;
    }
    if (grid < 0) return;
    const float* x = (const float*)d_in[0]; const float* mem = (const float*)d_in[1];
    const float* lb_logits = (const float*)d_in[5]; const float* hg_onorm = (const float*)d_in[6];
    const float* conf_dw_w = (const float*)d_in[7]; const float* conf_dw_b = (const float*)d_in[8]; const float* conf_ln_g = (const float*)d_in[9]; const float* conf_ln_b = (const float*)d_in[10];
    const float* sc_w = (const float*)d_in[11]; const float* attn_sink = (const float*)d_in[12]; const float* rel_bias = (const float*)d_in[13];
    const float* mem_norm = (const float*)d_in[14]; const float* w_mem_kv = (const float*)d_in[15];
    unsigned char* ws = (unsigned char*)d_ws;
    float* LB = (float*)(ws + WS_LB); float* BIAS = (float*)(ws + WS_BIAS);
    bf16_t* MEMKV = (bf16_t*)(ws + WS_MEMKV); bf16_t* U = (bf16_t*)(ws + WS_U);
    bf16_t* Y = (bf16_t*)(ws + WS_Y); bf16_t* OHG = (bf16_t*)(ws + WS_ST);
    (void)x; (void)mem; (void)lb_logits; (void)rel_bias; (void)mem_norm; (void)w_mem_kv; (void)LB; (void)BIAS; (void)MEMKV; (void)hg_onorm; (void)U; (void)Y; (void)OHG; (void)conf_dw_w; (void)conf_dw_b; (void)conf_ln_g; (void)conf_ln_b; (void)sc_w; (void)attn_sink;

    if (hipMemsetAsync(ws + WS_CTL, 0, CTL_ZERO_BYTES, stream) != hipSuccess) return;
    Args a{};
    for (int i = 0; i < 19; ++i) a.in[i] = (const float*)d_in[i];
    a.out = (float*)d_out; a.ws = ws;
    int li = 0;
    auto launch = [&](int lo, int hi) {
        a.ph_lo = lo; a.ph_hi = hi; a.li = li++; a.pad = 0;
        hipLaunchKernelGGL(mk_fwd, dim3(grid), dim3(NWAVES * 64), LDS_BYTES, stream, a);
    };
    launch(0, PH_TOTAL);
}
```

```cpp
#include <hip/hip_runtime.h>
#include <cstdio>
#include <cstdint>
#include <cmath>

typedef unsigned short bf16_t;
#define GAS __attribute__((address_space(1)))
typedef unsigned gu32x4 __attribute__((ext_vector_type(4)));
typedef unsigned gu32x2 __attribute__((ext_vector_type(2)));
typedef float gf32x4 __attribute__((ext_vector_type(4)));
typedef float gf32x2 __attribute__((ext_vector_type(2)));

constexpr int NB = 8, NS = 4096, ND = 1024, NL = 4, NM = NB * NS, NW = 256, NU = 4352, NY = 1280;
constexpr int MEML = 256;
constexpr float EPSF = 1e-6f;
constexpr int C_HQ = 0, C_HFF = 256, C_HFB = 512, C_HI = 768, C_HZ = 1024, C_CA = 1280, C_CB = 1536, C_CZ = 1792,
              C_SB = 2048, C_SC = 2304, C_SV = 2560, C_SZ = 2816, C_AQ = 3072, C_AK = 3328, C_AV = 3456, C_AZ = 3584,
              C_MQ = 3840, C_MZ = 4096;

constexpr size_t MiB = 1u << 20;
constexpr size_t WS_CTL = 0;
constexpr size_t CTL_ZERO_BYTES = 512 * 1024;
constexpr size_t WS_LB = 640 * 1024;
constexpr size_t WS_BIAS = 704 * 1024;
constexpr size_t WS_MEMKV = 1 * MiB;
constexpr size_t WS_WIN = 9 * MiB;
constexpr size_t WS_WG = WS_WIN + 4352u * 1024 * 2;
constexpr size_t WS_WB = WS_WG + 5120u * 1024 * 2;
constexpr size_t WS_WO = WS_WB + 5120u * 256 * 2;
constexpr size_t WS_H = 33 * MiB;
constexpr size_t WS_U = 97 * MiB;
constexpr size_t WS_ST = 369 * MiB;
constexpr size_t WS_Y = 417 * MiB;
constexpr size_t WS_END = 497 * MiB;
static_assert(WS_WO + 1024u * 1024 * 2 <= WS_H, "weights fit");

__device__ __forceinline__ float bf2f(bf16_t v) { return __uint_as_float((unsigned)v << 16); }
__device__ __forceinline__ bf16_t f2bf(float f) { unsigned u = __float_as_uint(f); return (bf16_t)((u + 0x7fffu + ((u >> 16) & 1u)) >> 16); }
__device__ __forceinline__ float sigmoidf_(float x) { return __builtin_amdgcn_rcpf(1.f + __expf(-x)); }
__device__ __forceinline__ float siluf_(float x) { return x * __builtin_amdgcn_rcpf(1.f + __expf(-x)); }

__global__ void n_prep(const float* lb_logits, const float* rel_bias, float* LB, float* BIAS) {
    const int tid = threadIdx.x;
    {
        float v[NL], mx = -1e30f, s = 0.f;
        for (int l = 0; l < NL; ++l) { v[l] = lb_logits[l * 512 + tid]; mx = fmaxf(mx, v[l]); }
        for (int l = 0; l < NL; ++l) { v[l] = __expf(v[l] - mx); s += v[l]; }
        float c = 0.f;
        for (int l = 0; l < NL; ++l) { if (l > 0) c += v[l] / s; LB[l * 512 + tid] = c; }
    }
    for (int i = tid; i < 4 * 257; i += blockDim.x) {
        const int h = i / 257, rel = i % 257 - 128;
        int n = -rel; int ret = (n < 0) ? 16 : 0; n = n < 0 ? -n : n;
        int bucket;
        if (n < 8) bucket = n;
        else {
            int large;
            if (n < 12) large = 8; else if (n < 16) large = 9; else if (n < 23) large = 10; else if (n < 32) large = 11;
            else if (n < 46) large = 12; else if (n < 64) large = 13; else if (n < 91) large = 14; else large = 15;
            bucket = large;
        }
        BIAS[i] = rel_bias[(ret + bucket) * 4 + h];
    }
}

__global__ void n_rmsnorm_rows(const float* x, const float* g, bf16_t* out, int rows) {
    const int wave = (blockIdx.x * blockDim.x + threadIdx.x) >> 6, lane = threadIdx.x & 63;
    if (wave >= rows) return;
    const float* xr = x + (size_t)wave * ND;
    float v[16], s = 0.f;
#pragma unroll
    for (int j = 0; j < 16; ++j) { v[j] = xr[lane + 64 * j]; s += v[j] * v[j]; }
#pragma unroll
    for (int o = 1; o < 64; o <<= 1) s += __shfl_xor(s, o);
    const float r = rsqrtf(s * (1.f / ND) + EPSF);
#pragma unroll
    for (int j = 0; j < 16; ++j) out[(size_t)wave * ND + lane + 64 * j] = f2bf(v[j] * r * g[lane + 64 * j]);
}

__global__ void n_memkv(const float* mem, const float* mem_norm, const float* w, bf16_t* out) {
    __shared__ float row[ND]; __shared__ float red[8];
    const int r = blockIdx.x, l = blockIdx.y, tid = threadIdx.x;
    float s = 0.f;
    for (int i = tid; i < ND; i += 512) { float v = mem[(size_t)r * ND + i]; row[i] = v; s += v * v; }
#pragma unroll
    for (int o = 1; o < 64; o <<= 1) s += __shfl_xor(s, o);
    if ((tid & 63) == 0) red[tid >> 6] = s;
    __syncthreads();
    float tot = 0.f; for (int i = 0; i < 8; ++i) tot += red[i];
    const float rs = rsqrtf(tot * (1.f / ND) + EPSF);
    const float* g = mem_norm + l * ND; const float* wl = w + (size_t)l * ND * 512;
    float acc = 0.f;
    for (int k = 0; k < ND; ++k) acc += row[k] * g[k] * wl[(size_t)k * 512 + tid];
    out[((size_t)l * (NB * MEML) + r) * 512 + tid] = f2bf(acc * rs);
}

__global__ __launch_bounds__(256) void n_gemm(const bf16_t* A, int lda, const float* Wt, int ldw, bf16_t* C, int ldc, int K) {
    __shared__ float As[16][132]; __shared__ float Bs[16][132];
    const int tid = threadIdx.x, tx = tid & 15, ty = tid >> 4;
    const int row0 = blockIdx.y * 128, col0 = blockIdx.x * 128;
    float acc[8][8];
#pragma unroll
    for (int i = 0; i < 8; ++i)
#pragma unroll
        for (int j = 0; j < 8; ++j) acc[i][j] = 0.f;
    for (int k0 = 0; k0 < K; k0 += 16) {
#pragma unroll
        for (int it = 0; it < 8; ++it) { const int i = tid + it * 256, r = i >> 4, k = i & 15; As[k][r] = bf2f(A[(size_t)(row0 + r) * lda + k0 + k]); }
#pragma unroll
        for (int it = 0; it < 8; ++it) { const int i = tid + it * 256, k = i >> 7, c = i & 127; Bs[k][c] = Wt[(size_t)(k0 + k) * ldw + col0 + c]; }
        __syncthreads();
#pragma unroll
        for (int k = 0; k < 16; ++k) {
            float a[8], b[8];
#pragma unroll
            for (int i = 0; i < 8; ++i) { a[i] = As[k][ty * 8 + i]; b[i] = Bs[k][tx * 8 + i]; }
#pragma unroll
            for (int i = 0; i < 8; ++i)
#pragma unroll
                for (int j = 0; j < 8; ++j) acc[i][j] += a[i] * b[j];
        }
        __syncthreads();
    }
#pragma unroll
    for (int i = 0; i < 8; ++i)
#pragma unroll
        for (int j = 0; j < 8; ++j) C[(size_t)(row0 + ty * 8 + i) * ldc + col0 + tx * 8 + j] = f2bf(acc[i][j]);
}

__global__ __launch_bounds__(256) void n_merge(const bf16_t* H, const bf16_t* Y, const float* Wg, const float* Wb, bf16_t* MG) {
    __shared__ float As[16][68]; __shared__ float Bs[16][68];
    const int tid = threadIdx.x, tx = tid & 15, ty = tid >> 4;
    const int row0 = blockIdx.y * 64, col0 = blockIdx.x * 64;
    float mg[4][4];
#pragma unroll
    for (int i = 0; i < 4; ++i)
#pragma unroll
        for (int j = 0; j < 4; ++j) mg[i][j] = 0.f;
    for (int n = 0; n < 5; ++n) {
        float ag[4][4], ab[4][4];
#pragma unroll
        for (int i = 0; i < 4; ++i)
#pragma unroll
            for (int j = 0; j < 4; ++j) { ag[i][j] = 0.f; ab[i][j] = 0.f; }
        const float* wg = Wg + (size_t)n * ND * ND;
        for (int k0 = 0; k0 < ND; k0 += 16) {
#pragma unroll
            for (int it = 0; it < 4; ++it) { const int i = tid + it * 256, r = i >> 4, k = i & 15; As[k][r] = bf2f(H[(size_t)(row0 + r) * ND + k0 + k]); }
#pragma unroll
            for (int it = 0; it < 4; ++it) { const int i = tid + it * 256, k = i >> 6, c = i & 63; Bs[k][c] = wg[(size_t)(k0 + k) * ND + col0 + c]; }
            __syncthreads();
#pragma unroll
            for (int k = 0; k < 16; ++k) {
                float a[4], b[4];
#pragma unroll
                for (int i = 0; i < 4; ++i) { a[i] = As[k][ty * 4 + i]; b[i] = Bs[k][tx * 4 + i]; }
#pragma unroll
                for (int i = 0; i < 4; ++i)
#pragma unroll
                    for (int j = 0; j < 4; ++j) ag[i][j] += a[i] * b[j];
            }
            __syncthreads();
        }
        const float* wb = Wb + (size_t)n * NW * ND;
        for (int k0 = 0; k0 < NW; k0 += 16) {
#pragma unroll
            for (int it = 0; it < 4; ++it) { const int i = tid + it * 256, r = i >> 4, k = i & 15; As[k][r] = bf2f(Y[(size_t)(row0 + r) * NY + n * NW + k0 + k]); }
#pragma unroll
            for (int it = 0; it < 4; ++it) { const int i = tid + it * 256, k = i >> 6, c = i & 63; Bs[k][c] = wb[(size_t)(k0 + k) * ND + col0 + c]; }
            __syncthreads();
#pragma unroll
            for (int k = 0; k < 16; ++k) {
                float a[4], b[4];
#pragma unroll
                for (int i = 0; i < 4; ++i) { a[i] = As[k][ty * 4 + i]; b[i] = Bs[k][tx * 4 + i]; }
#pragma unroll
                for (int i = 0; i < 4; ++i)
#pragma unroll
                    for (int j = 0; j < 4; ++j) ab[i][j] += a[i] * b[j];
            }
            __syncthreads();
        }
#pragma unroll
        for (int i = 0; i < 4; ++i)
#pragma unroll
            for (int j = 0; j < 4; ++j) mg[i][j] += sigmoidf_(ag[i][j]) * ab[i][j];
    }
#pragma unroll
    for (int i = 0; i < 4; ++i)
#pragma unroll
        for (int j = 0; j < 4; ++j) MG[(size_t)(row0 + ty * 4 + i) * ND + col0 + tx * 4 + j] = f2bf(mg[i][j]);
}

__global__ void n_shortconv(const bf16_t* U, const float* w  , bf16_t* Y) {
    const size_t idx = (size_t)blockIdx.x * blockDim.x + threadIdx.x;
    const int c = idx & 255; const int m = (int)(idx >> 8); const int t = m & (NS - 1);
    float conv = 0.f;
#pragma unroll
    for (int j = 0; j < 3; ++j) { const int tt = t + j - 1; if (tt >= 0 && tt < NS) { const size_t r = (size_t)(m + j - 1) * NU; conv += w[j * 256 + c] * bf2f(U[r + C_SC + c]) * bf2f(U[r + C_SV + c]); } }
    const size_t r = (size_t)m * NU;
    Y[(size_t)m * NY + 2 * NW + c] = f2bf(bf2f(U[r + C_SB + c]) * conv * siluf_(bf2f(U[r + C_SZ + c])));
}

__global__ void n_conformer(const bf16_t* U, const float* dw_w  , const float* dw_b, const float* ln_g, const float* ln_b, bf16_t* Y) {
    __shared__ float red[4];
    const int m = blockIdx.x, c = threadIdx.x, t = m & (NS - 1);
    float conv = dw_b[c];
    for (int j = 0; j < 31; ++j) { const int tt = t + j - 15; if (tt >= 0 && tt < NS) { const size_t r = (size_t)(m + j - 15) * NU; conv += dw_w[j * 256 + c] * bf2f(U[r + C_CA + c]) * sigmoidf_(bf2f(U[r + C_CB + c])); } }
    float s = conv;
#pragma unroll
    for (int o = 1; o < 64; o <<= 1) s += __shfl_xor(s, o);
    if ((c & 63) == 0) red[c >> 6] = s;
    __syncthreads();
    const float mu = (red[0] + red[1] + red[2] + red[3]) * (1.f / 256.f);
    __syncthreads();
    const float d = conv - mu; float q = d * d;
#pragma unroll
    for (int o = 1; o < 64; o <<= 1) q += __shfl_xor(q, o);
    if ((c & 63) == 0) red[c >> 6] = q;
    __syncthreads();
    const float var = (red[0] + red[1] + red[2] + red[3]) * (1.f / 256.f);
    const float n = d * rsqrtf(var + EPSF) * ln_g[c] + ln_b[c];
    Y[(size_t)m * NY + 1 * NW + c] = f2bf(siluf_(n) * siluf_(bf2f(U[(size_t)m * NU + C_CZ + c])));
}


__device__ __forceinline__ float dot64(const float (&q)[64], const bf16_t* kp) {
    float s = 0.f;
#pragma unroll
    for (int c = 0; c < 8; ++c) { const uint4 w = *(const uint4*)(kp + 8 * c); const unsigned ww[4] = {w.x, w.y, w.z, w.w};
#pragma unroll
        for (int e = 0; e < 4; ++e) { s += q[8 * c + 2 * e] * __uint_as_float(ww[e] << 16); s += q[8 * c + 2 * e + 1] * __uint_as_float(ww[e] & 0xffff0000u); } }
    return s;
}
__device__ __forceinline__ void axpy64(float (&acc)[64], float sc, float p, const bf16_t* vp) {
#pragma unroll
    for (int c = 0; c < 8; ++c) { const uint4 w = *(const uint4*)(vp + 8 * c); const unsigned ww[4] = {w.x, w.y, w.z, w.w};
#pragma unroll
        for (int e = 0; e < 4; ++e) { acc[8 * c + 2 * e] = acc[8 * c + 2 * e] * sc + p * __uint_as_float(ww[e] << 16); acc[8 * c + 2 * e + 1] = acc[8 * c + 2 * e + 1] * sc + p * __uint_as_float(ww[e] & 0xffff0000u); } }
}
__global__ __launch_bounds__(64) void n_winattn(const bf16_t* U, const float* BIAS, const float* sink, bf16_t* Y) {
    const int idx = blockIdx.x * blockDim.x + threadIdx.x;
    const int m = idx, h = blockIdx.y, t = m & (NS - 1), kvh = h >> 1;
    float q[64], acc[64];
    const bf16_t* qp = U + (size_t)m * NU + C_AQ + h * 64;
#pragma unroll
    for (int d = 0; d < 64; ++d) { q[d] = bf2f(qp[d]) * 0.125f; acc[d] = 0.f; }
    float mx = sink[h], l = 1.f;
    const int j0 = (t - 128 < 0) ? 0 : t - 128, j1 = (t + 128 > NS - 1) ? NS - 1 : t + 128;
    const float* bias = BIAS + h * 257;
    for (int j = j0; j <= j1; ++j) {
        const bf16_t* kp = U + (size_t)(m - t + j) * NU + C_AK + kvh * 64;
        const bf16_t* vp = U + (size_t)(m - t + j) * NU + C_AV + kvh * 64;
        float s = dot64(q, kp);
        s += bias[j - t + 128];
        const float nm = fmaxf(mx, s), sc = __expf(mx - nm), p = __expf(s - nm);
        l = l * sc + p; mx = nm;
        axpy64(acc, sc, p, vp);
    }
    const float inv = 1.f / l;
    const bf16_t* zp = U + (size_t)m * NU + C_AZ + h * 64;
    bf16_t* yp = Y + (size_t)m * NY + 3 * NW + h * 64;
#pragma unroll
    for (int d = 0; d < 64; ++d) yp[d] = f2bf(acc[d] * inv * siluf_(bf2f(zp[d])));
}

__global__ __launch_bounds__(64) void n_memattn(const bf16_t* U, const bf16_t* MKV  , bf16_t* Y) {
    const int m = blockIdx.x * blockDim.x + threadIdx.x, h = blockIdx.y, b = m / NS;
    float q[64], acc[64];
    const bf16_t* qp = U + (size_t)m * NU + C_MQ + h * 64;
#pragma unroll
    for (int d = 0; d < 64; ++d) { q[d] = bf2f(qp[d]) * 0.125f; acc[d] = 0.f; }
    float mx = -1e30f, l = 0.f;
    for (int j = 0; j < MEML; ++j) {
        const bf16_t* kp = MKV + (size_t)(b * MEML + j) * 512 + h * 64;
        const bf16_t* vp = kp + 256;
        const float s = dot64(q, kp);
        const float nm = fmaxf(mx, s), sc = __expf(mx - nm), p = __expf(s - nm);
        l = l * sc + p; mx = nm;
        axpy64(acc, sc, p, vp);
    }
    const float inv = 1.f / l;
    const bf16_t* zp = U + (size_t)m * NU + C_MZ + h * 64;
    bf16_t* yp = Y + (size_t)m * NY + 4 * NW + h * 64;
#pragma unroll
    for (int d = 0; d < 64; ++d) yp[d] = f2bf(acc[d] * inv * siluf_(bf2f(zp[d])));
}

__global__ __launch_bounds__(1024) void n_hgrn_scan(const bf16_t* U, const float* LBl  , bf16_t* OHG  ) {
    __shared__ float sq[64], sf[64], sk[64], sv[64]; __shared__ float red[16][64];
    const int b = blockIdx.x >> 3, h = (blockIdx.x >> 1) & 3, dir = blockIdx.x & 1;
    const int tid = threadIdx.x, v = tid & 63, kg = tid >> 6;
    float S[4] = {0.f, 0.f, 0.f, 0.f};
    const float lb = (tid < 64) ? LBl[dir * 256 + h * 64 + tid] : 0.f;
    for (int step = 0; step < NS; ++step) {
        const int t = dir ? (NS - 1 - step) : step;
        const size_t r = ((size_t)b * NS + t) * NU;
        if (tid < 64) {
            const float fl = bf2f(U[r + (dir ? C_HFB : C_HFF) + h * 64 + tid]);
            const float f = lb + (1.f - lb) * sigmoidf_(fl);
            sf[tid] = f; sk[tid] = 1.f - f;
            sq[tid] = bf2f(U[r + C_HQ + h * 64 + tid]);
            sv[tid] = bf2f(U[r + C_HI + h * 64 + tid]);
        }
        __syncthreads();
        const float vv = sv[v]; float part = 0.f;
#pragma unroll
        for (int j = 0; j < 4; ++j) { const int k = kg * 4 + j; S[j] = sf[k] * S[j] + sk[k] * vv; part += sq[k] * S[j]; }
        red[kg][v] = part;
        __syncthreads();
        if (tid < 64) { float o = 0.f;
#pragma unroll
            for (int g = 0; g < 16; ++g) o += red[g][tid];
            OHG[((size_t)dir * NM + (size_t)b * NS + t) * 256 + h * 64 + tid] = f2bf(o); }
    }
}
__global__ void n_hgrn_out(const bf16_t* OHG, const bf16_t* U, const float* onorm  , bf16_t* Y) {
    const int wave = (blockIdx.x * blockDim.x + threadIdx.x) >> 6, lane = threadIdx.x & 63;
    const int m = wave >> 2, h = wave & 3;
    const float o = bf2f(OHG[(size_t)m * 256 + h * 64 + lane]) + bf2f(OHG[((size_t)NM + m) * 256 + h * 64 + lane]);
    float s = o * o;
#pragma unroll
    for (int k = 1; k < 64; k <<= 1) s += __shfl_xor(s, k);
    const float y = o * rsqrtf(s * (1.f / 64.f) + EPSF) * onorm[lane];
    Y[(size_t)m * NY + h * 64 + lane] = f2bf(y * siluf_(bf2f(U[(size_t)m * NU + C_HZ + h * 64 + lane])));
}

__global__ void n_post(const float* xin, const bf16_t* outraw, const float* g_post, const float* g_next, float* xout, bf16_t* H, int has_next) {
    const int wave = (blockIdx.x * blockDim.x + threadIdx.x) >> 6, lane = threadIdx.x & 63;
    const size_t base = (size_t)wave * ND;
    float o[16], s = 0.f;
#pragma unroll
    for (int j = 0; j < 16; ++j) { o[j] = bf2f(outraw[base + lane + 64 * j]); s += o[j] * o[j]; }
#pragma unroll
    for (int k = 1; k < 64; k <<= 1) s += __shfl_xor(s, k);
    const float r = rsqrtf(s * (1.f / ND) + EPSF);
    float s2 = 0.f;
#pragma unroll
    for (int j = 0; j < 16; ++j) { o[j] = xin[base + lane + 64 * j] + o[j] * r * g_post[lane + 64 * j]; s2 += o[j] * o[j]; xout[base + lane + 64 * j] = o[j]; }
    if (has_next) {
#pragma unroll
        for (int k = 1; k < 64; k <<= 1) s2 += __shfl_xor(s2, k);
        const float r2 = rsqrtf(s2 * (1.f / ND) + EPSF);
#pragma unroll
        for (int j = 0; j < 16; ++j) H[base + lane + 64 * j] = f2bf(o[j] * r2 * g_next[lane + 64 * j]);
    }
}


namespace pg8 {
#define PG8_LAS __attribute__((address_space(3)))
typedef short bf16x8 __attribute__((ext_vector_type(8)));
typedef float f32x4 __attribute__((ext_vector_type(4)));
typedef unsigned u32x4 __attribute__((ext_vector_type(4)));
constexpr int BM = 256, BK = 64, HALF = 128, HTB = HALF * BK * 2  , STAGE_BYTES = 8 * HTB, NXCD = 8, WGM = 8;

__host__ __device__ __forceinline__ int lds_byte(int r, int c) { const int st = (r >> 4) * 2 + (c >> 5), rr = r & 15, cc = c & 31, ob = rr * 64 + cc * 2; return st * 1024 + (ob ^ (((ob >> 9) & 1) << 5)); }
__host__ __device__ __forceinline__ void stage_rc(int b, int& R, int& C) { const int st = b / 1024, sb = b % 1024, swz = sb ^ (((sb >> 9) & 1) << 5); R = (st >> 1) * 16 + swz / 64; C = (st & 1) * 32 + (swz % 64) / 2; }
__host__ __device__ __forceinline__ int perm32(int rho) { const int n = rho >> 4, i = rho & 15; return 8 * (i >> 2) + 4 * n + (i & 3); }

struct Unit { int pm, pn, pz; };
struct Gemm { const bf16_t* A; const bf16_t* Bt; int lda, ldb, K; unsigned zA, zB; };

template <int NZ> struct TileOrder {
    int nM, nN, nwg, G, c;
    __device__ void init(int M, int N, int G_, int c_) { nM = M / BM; nN = N / BM; nwg = nM * nN; G = G_; c = c_; }
    __device__ bool next(int i, Unit& u) const {
        const int ti = i / NZ; u.pz = i - ti * NZ;
        const long L = (long)ti * G + c; if (L >= nwg) return false;
        int wgid = (int)L; { const int q = nwg / NXCD, r = nwg % NXCD, xcd = wgid % NXCD, off = wgid / NXCD; wgid = (xcd < r ? xcd * (q + 1) : r * (q + 1) + (xcd - r) * q) + off; }
        const int nig = WGM * nN, gid = wgid / nig, fm = gid * WGM, gsz = (nM - fm) < WGM ? (nM - fm) : WGM;
        u.pm = fm + ((wgid % nig) % gsz); u.pn = (wgid % nig) / gsz; return true;
    }
};

template <int NZ> struct TileRound {
    TileOrder<NZ> T; int ti;
    __device__ bool next(int i, Unit& u) const { if (i >= NZ) return false; return T.next(ti * NZ + i, u); }
};
__device__ __forceinline__ unsigned cvt_pk_bf16(float lo, float hi) { unsigned r; asm volatile("v_cvt_pk_bf16_f32 %0, %1, %2" : "=v"(r) : "v"(lo), "v"(hi)); return r; }
__device__ __forceinline__ float bflo(unsigned w) { return __uint_as_float(w << 16); }
__device__ __forceinline__ float bfhi(unsigned w) { return __uint_as_float(w & 0xffff0000u); }

struct EpiStore {
    static constexpr bool PERM = true, CHAINED = false;
    GAS bf16_t* O; int ldc;
    __device__ __forceinline__ void operator()(f32x4 (&acc)[2][2][4][2], const Unit& u, int wr, int wc, int fr, int fq) const {
        const int row0 = u.pm * BM + wr * 64 + fr, col0 = u.pn * BM + wc * 32 + 8 * fq;
#pragma unroll
        for (int ai = 0; ai < 2; ++ai)
#pragma unroll
            for (int m = 0; m < 4; ++m) { GAS bf16_t* rowp = O + (size_t)(row0 + ai * HALF + m * 16) * ldc + col0;
#pragma unroll
                for (int bj = 0; bj < 2; ++bj) { const f32x4 v0 = acc[ai][bj][m][0], v1 = acc[ai][bj][m][1];
                    u32x4 w; w.x = cvt_pk_bf16(v0[0], v0[1]); w.y = cvt_pk_bf16(v0[2], v0[3]); w.z = cvt_pk_bf16(v1[0], v1[1]); w.w = cvt_pk_bf16(v1[2], v1[3]);
                    *(GAS u32x4*)(rowp + bj * HALF) = w; } }
    }
};
constexpr int GS_LD = 256, GS_SLOT = 256 * 256;
struct EpiGate {
    static constexpr bool PERM = true, CHAINED = false;
    GAS bf16_t* GS;
    __device__ __forceinline__ void operator()(f32x4 (&acc)[2][2][4][2], const Unit& u, int wr, int wc, int fr, int fq) const {
        const int n = u.pz;
        GAS bf16_t* base = GS + (size_t)(wr * 64 + fr) * GS_LD + wc * 32 + 8 * fq;
        u32x4 pw[2][4][2];
        if (n > 0) {
#pragma unroll
            for (int ai = 0; ai < 2; ++ai)
#pragma unroll
                for (int m = 0; m < 4; ++m)
#pragma unroll
                    for (int bj = 0; bj < 2; ++bj) pw[ai][m][bj] = *(const GAS u32x4*)(base + (ai * HALF + m * 16) * GS_LD + bj * HALF);
            asm volatile("" ::: "memory");
        }
#pragma unroll
        for (int ai = 0; ai < 2; ++ai)
#pragma unroll
            for (int m = 0; m < 4; ++m) {
#pragma unroll
                for (int bj = 0; bj < 2; ++bj) {
                    float e[8];
#pragma unroll
                    for (int j = 0; j < 4; ++j) { e[j] = 1.f + __expf(-__builtin_amdgcn_fmed3f(acc[ai][bj][m][0][j], -30.f, 30.f)); e[4 + j] = 1.f + __expf(-__builtin_amdgcn_fmed3f(acc[ai][bj][m][1][j], -30.f, 30.f)); }
                    GAS bf16_t* p0 = base + (ai * HALF + m * 16) * GS_LD + bj * HALF;
                    if (n > 0) {
                        const u32x4 q = pw[ai][m][bj];
                        u32x4 w; w.x = cvt_pk_bf16(bflo(q.x) * e[0], bfhi(q.x) * e[1]); w.y = cvt_pk_bf16(bflo(q.y) * e[2], bfhi(q.y) * e[3]);
                        w.z = cvt_pk_bf16(bflo(q.z) * e[4], bfhi(q.z) * e[5]); w.w = cvt_pk_bf16(bflo(q.w) * e[6], bfhi(q.w) * e[7]);
                        *(GAS u32x4*)(p0 + n * GS_SLOT) = w;
                    }
#pragma unroll
                    for (int j = 0; j < 8; ++j) e[j] = __builtin_amdgcn_rcpf(e[j]);
                    u32x4 w; w.x = cvt_pk_bf16(e[0], e[1]); w.y = cvt_pk_bf16(e[2], e[3]); w.z = cvt_pk_bf16(e[4], e[5]); w.w = cvt_pk_bf16(e[6], e[7]);
                    *(GAS u32x4*)p0 = w;
                } }
    }
};
struct EpiMerge {
    static constexpr bool PERM = true, CHAINED = true;
    const GAS bf16_t* GS; GAS bf16_t* MG;
    __device__ __forceinline__ void operator()(f32x4 (&acc)[2][2][4][2], const Unit& u, int wr, int wc, int fr, int fq) const {
        const int row0 = u.pm * BM + wr * 64 + fr, col0 = u.pn * BM + wc * 32 + 8 * fq, n = u.pz;
        const int slot = (n < 4) ? (n + 1) : 0;
        const GAS bf16_t* base = GS + (size_t)slot * GS_SLOT + (size_t)(wr * 64 + fr) * GS_LD + wc * 32 + 8 * fq;
        u32x4 pw[2][4][2];
#pragma unroll
        for (int ai = 0; ai < 2; ++ai)
#pragma unroll
            for (int m = 0; m < 4; ++m)
#pragma unroll
                for (int bj = 0; bj < 2; ++bj) pw[ai][m][bj] = *(const GAS u32x4*)(base + (ai * HALF + m * 16) * GS_LD + bj * HALF);
        asm volatile("" ::: "memory");
#pragma unroll
        for (int ai = 0; ai < 2; ++ai)
#pragma unroll
            for (int m = 0; m < 4; ++m) { const size_t row = (size_t)(row0 + ai * HALF + m * 16);
#pragma unroll
                for (int bj = 0; bj < 2; ++bj) {
                    const u32x4 q = pw[ai][m][bj];
                    f32x4 v0 = acc[ai][bj][m][0], v1 = acc[ai][bj][m][1];
                    v0[0] *= bflo(q.x); v0[1] *= bfhi(q.x); v0[2] *= bflo(q.y); v0[3] *= bfhi(q.y);
                    v1[0] *= bflo(q.z); v1[1] *= bfhi(q.z); v1[2] *= bflo(q.w); v1[3] *= bfhi(q.w);
                    acc[ai][bj][m][0] = v0; acc[ai][bj][m][1] = v1;
                    if (n == 4) { u32x4 w; w.x = cvt_pk_bf16(v0[0], v0[1]); w.y = cvt_pk_bf16(v0[2], v0[3]); w.z = cvt_pk_bf16(v1[0], v1[1]); w.w = cvt_pk_bf16(v1[2], v1[3]);
                        *(GAS u32x4*)(MG + row * 1024 + col0 + bj * HALF) = w; }
                } }
    }
};
struct EpiStoreZ {
    static constexpr bool PERM = true, CHAINED = false;
    GAS bf16_t* O; int ldc; size_t zO;
    __device__ __forceinline__ void operator()(f32x4 (&acc)[2][2][4][2], const Unit& u, int wr, int wc, int fr, int fq) const {
        const int row0 = u.pm * BM + wr * 64 + fr, col0 = u.pn * BM + wc * 32 + 8 * fq; GAS bf16_t* Ob = O + (size_t)u.pz * zO;
#pragma unroll
        for (int ai = 0; ai < 2; ++ai)
#pragma unroll
            for (int m = 0; m < 4; ++m) { GAS bf16_t* rowp = Ob + (size_t)(row0 + ai * HALF + m * 16) * ldc + col0;
#pragma unroll
                for (int bj = 0; bj < 2; ++bj) { const f32x4 v0 = acc[ai][bj][m][0], v1 = acc[ai][bj][m][1];
                    u32x4 w; w.x = cvt_pk_bf16(v0[0], v0[1]); w.y = cvt_pk_bf16(v0[2], v0[3]); w.z = cvt_pk_bf16(v1[0], v1[1]); w.w = cvt_pk_bf16(v1[2], v1[3]);
                    *(GAS u32x4*)(rowp + bj * HALF) = w; } }
    }
};
struct OneUnit { Unit u; bool valid; __device__ bool next(int i, Unit& o) const { if (i == 0 && valid) { o = u; return true; } return false; } };

template <class Epi, class Sched, bool ALIGN_EPI>
__device__ __forceinline__ void gemm_phase(PG8_LAS unsigned char* lds, const Gemm g, const Sched& S, const Epi& E) {
    int tid_ = threadIdx.x; asm volatile("" : "+v"(tid_));
    const int tid = tid_, wid = __builtin_amdgcn_readfirstlane(tid >> 6), lane = tid & 63, wr = wid >> 2, wc = wid & 3, fr = lane & 15, fq = lane >> 4;
    const int nt = g.K / BK;
    unsigned voffA[2], voffB[2];
#pragma unroll
    for (int i = 0; i < 2; ++i) { int R, C; stage_rc(tid * 16 + i * 8192, R, C); const int Rb = Epi::PERM ? ((R & ~31) + perm32(R & 31)) : R;
        voffA[i] = (unsigned)(R * g.lda + C) * 2u; voffB[i] = (unsigned)(Rb * g.ldb + C) * 2u; }
    const size_t kstep = (size_t)(BK * 2);
    const size_t hstepA = (size_t)HALF * g.lda * 2, tstepA = 2 * hstepA, hstepB = (size_t)HALF * g.ldb * 2, tstepB = 2 * hstepB;
    const unsigned ldsw = (unsigned)wid * 1024u;
    const int aoff = lds_byte(wr * 64 + fr, fq * 8), boff = lds_byte(wc * 32 + fr, fq * 8);
#define PG8_SA(b, h) (((b) * 2 + (h)) * HTB)
#define PG8_SB(b, h) ((4 + (b) * 2 + (h)) * HTB)
#define PG8_STAGE(bufoff, gbase, voff) do { _Pragma("unroll") for (int _i = 0; _i < 2; ++_i) \
        __builtin_amdgcn_global_load_lds((const unsigned*)((const char*)(gbase) + (voff)[_i]), (PG8_LAS unsigned*)(lds + (bufoff) + ldsw + _i * 8192), 16, 0, 0); } while (0)
#define PG8_LDA(dst, b, h) do { _Pragma("unroll") for (int m = 0; m < 4; ++m) _Pragma("unroll") for (int k = 0; k < 2; ++k) dst[m][k] = *(const PG8_LAS bf16x8*)(lds + PG8_SA(b, h) + aoff + m * 2048 + k * 1024); } while (0)
#define PG8_LDB(dst, b, h) do { _Pragma("unroll") for (int n = 0; n < 2; ++n) _Pragma("unroll") for (int k = 0; k < 2; ++k) dst[n][k] = *(const PG8_LAS bf16x8*)(lds + PG8_SB(b, h) + boff + n * 2048 + k * 1024); } while (0)
#define PG8_MMA(ai, bj, At, Bt) do { __builtin_amdgcn_s_setprio(1); _Pragma("unroll") for (int m = 0; m < 4; ++m) _Pragma("unroll") for (int n = 0; n < 2; ++n) _Pragma("unroll") for (int k = 0; k < 2; ++k) \
        acc[ai][bj][m][n] = __builtin_amdgcn_mfma_f32_16x16x32_bf16(Bt[n][k], At[m][k], acc[ai][bj][m][n], 0, 0, 0); __builtin_amdgcn_s_setprio(0); } while (0)
#define PG8_WAIT_V(n) asm volatile("s_waitcnt vmcnt(" #n ")" ::: "memory")
#define PG8_WAIT_L(n) asm volatile("s_waitcnt lgkmcnt(" #n ")" ::: "memory")
#define PG8_BAR __builtin_amdgcn_s_barrier()
#define PG8_SCHED __builtin_amdgcn_sched_barrier(0)
    Unit cur, nxt; int ui = 0;
    if (!S.next(0, cur)) return;
    f32x4 acc[2][2][4][2];
#pragma unroll
    for (int a = 0; a < 2; ++a)
#pragma unroll
        for (int b = 0; b < 2; ++b)
#pragma unroll
            for (int m = 0; m < 4; ++m)
#pragma unroll
                for (int n = 0; n < 2; ++n) acc[a][b][m][n] = (f32x4){0.f, 0.f, 0.f, 0.f};
    bf16x8 At[4][2], B0[2][2], B1[2][2];
    const char* cA = (const char*)g.A + (size_t)cur.pm * tstepA + (size_t)cur.pz * g.zA; const char* cB = (const char*)g.Bt + (size_t)cur.pn * tstepB + (size_t)cur.pz * g.zB;
    PG8_STAGE(PG8_SB(0, 0), cB, voffB); PG8_STAGE(PG8_SB(0, 1), cB + hstepB, voffB); PG8_STAGE(PG8_SA(0, 0), cA, voffA); PG8_STAGE(PG8_SA(0, 1), cA + hstepA, voffA);
    if (wr == 1) PG8_BAR;
    PG8_WAIT_V(2); PG8_BAR;
    PG8_STAGE(PG8_SB(1, 0), cB + kstep, voffB); PG8_STAGE(PG8_SA(1, 0), cA + kstep, voffA); PG8_STAGE(PG8_SB(1, 1), cB + hstepB + kstep, voffB);
    PG8_WAIT_V(6); PG8_BAR;
    for (;;) {
        const bool has_next = S.next(ui + 1, nxt);
        const char* nA = has_next ? (const char*)g.A + (size_t)nxt.pm * tstepA + (size_t)nxt.pz * g.zA : cA; const char* nB = has_next ? (const char*)g.Bt + (size_t)nxt.pn * tstepB + (size_t)nxt.pz * g.zB : cB;
        for (int t = 0; t < nt; t += 2) {
            const bool last = (t == nt - 2);
            const char* a1 = cA + (size_t)(t + 1) * kstep;
            const char* a2 = last ? nA : cA + (size_t)(t + 2) * kstep; const char* b2 = last ? nB : cB + (size_t)(t + 2) * kstep;
            const char* a3 = a2 + kstep; const char* b3 = b2 + kstep;
            PG8_LDB(B0, 0, 0); PG8_LDB(B1, 0, 1); PG8_SCHED; PG8_LDA(At, 0, 0); PG8_STAGE(PG8_SA(1, 1), a1 + hstepA, voffA);
            PG8_WAIT_V(8); PG8_WAIT_L(0); PG8_BAR; PG8_MMA(0, 0, At, B0); PG8_MMA(0, 1, At, B1); PG8_BAR; PG8_SCHED;
            PG8_LDA(At, 0, 1); PG8_STAGE(PG8_SB(0, 0), b2, voffB); PG8_STAGE(PG8_SB(0, 1), b2 + hstepB, voffB); PG8_STAGE(PG8_SA(0, 0), a2, voffA);
            PG8_WAIT_V(8); PG8_WAIT_L(0); PG8_BAR; PG8_MMA(1, 0, At, B0); PG8_MMA(1, 1, At, B1); PG8_BAR; PG8_SCHED;
            PG8_LDB(B0, 1, 0); PG8_LDB(B1, 1, 1); PG8_SCHED; PG8_LDA(At, 1, 0); PG8_STAGE(PG8_SA(0, 1), a2 + hstepA, voffA);
            PG8_WAIT_V(8); PG8_WAIT_L(0); PG8_BAR; PG8_MMA(0, 0, At, B0); PG8_MMA(0, 1, At, B1); PG8_BAR; PG8_SCHED;
            PG8_LDA(At, 1, 1); PG8_STAGE(PG8_SB(1, 0), b3, voffB); PG8_STAGE(PG8_SB(1, 1), b3 + hstepB, voffB); PG8_STAGE(PG8_SA(1, 0), a3, voffA);
            PG8_WAIT_V(8); PG8_WAIT_L(0); PG8_BAR; PG8_MMA(1, 0, At, B0); PG8_MMA(1, 1, At, B1); PG8_BAR; PG8_SCHED;
        }
        if constexpr (ALIGN_EPI) { if (wr == 0) PG8_BAR; }
        E(acc, cur, wr, wc, fr, fq);
        if (!has_next) break;
        if (!Epi::CHAINED || nxt.pz == 0) {
#pragma unroll
            for (int a = 0; a < 2; ++a)
#pragma unroll
                for (int b = 0; b < 2; ++b)
#pragma unroll
                    for (int m = 0; m < 4; ++m)
#pragma unroll
                        for (int n = 0; n < 2; ++n) acc[a][b][m][n] = (f32x4){0.f, 0.f, 0.f, 0.f};
        }
        cur = nxt; cA = nA; cB = nB; ++ui;
        if constexpr (ALIGN_EPI) { if (wr == 1) PG8_BAR; }
    }
    PG8_WAIT_V(0);
    if constexpr (!ALIGN_EPI) { if (wr == 0) PG8_BAR; }
    PG8_BAR;
#undef PG8_SA
#undef PG8_SB
#undef PG8_STAGE
#undef PG8_LDA
#undef PG8_LDB
#undef PG8_MMA
#undef PG8_WAIT_V
#undef PG8_WAIT_L
#undef PG8_BAR
#undef PG8_SCHED
}
}

#define LAS __attribute__((address_space(3)))
#define XB_TMO      128
#define XB_XCNT(j)  (256  + 64 * (j))
#define XB_XSUB(j)  (1280 + 64 * (j))
#define XB_XGEN(j)  (2304 + 64 * (j))
#define XB_TOP      3328
#define XB_TOPGEN   3392
#define XCD_BAR_WORDS 3456
#define XB_SPIN_CAP (1u << 18)
__device__ __forceinline__ unsigned xb_ld(unsigned* p)              { return __hip_atomic_load(p, __ATOMIC_RELAXED, __HIP_MEMORY_SCOPE_AGENT); }
__device__ __forceinline__ unsigned xb_add(unsigned* p, unsigned v) { return __hip_atomic_fetch_add(p, v, __ATOMIC_RELAXED, __HIP_MEMORY_SCOPE_AGENT); }
__device__ __forceinline__ unsigned xb_xcc_id() { return (unsigned)__builtin_amdgcn_s_getreg((3 << 11) | 20) & 0xFu; }
#define XB_SPIN(cond, bar) do { unsigned _sp = 0; while (cond) { __builtin_amdgcn_s_sleep(1); \
    if ((++_sp & 255u) == 0u) { if (xb_ld(&(bar)[XB_TMO])) break; if (_sp > XB_SPIN_CAP) { atomicAdd(&(bar)[XB_TMO], 1u); break; } } } } while (0)
struct XcdBarrier { unsigned* bar; unsigned x; volatile LAS unsigned* st; };
__device__ __forceinline__ XcdBarrier xcd_barrier_post(unsigned* bar, volatile LAS unsigned* st) {
    XcdBarrier b; b.bar = bar; b.x = xb_xcc_id(); b.st = st;
    if (threadIdx.x == 0) (void)xb_add(&bar[XB_XCNT(b.x)], 1u);
    return b;
}
__device__ __forceinline__ void xcd_barrier_complete(unsigned* bar, unsigned x, unsigned& nloc, unsigned& nx) {
    const unsigned G = gridDim.x * gridDim.y * gridDim.z;
    unsigned sum, cnt, mine, sp = 0u;
    for (;;) {
        sum = 0u; cnt = 0u; mine = 0u;
#pragma unroll
        for (unsigned j = 0; j < 16; ++j) { const unsigned c = xb_ld(&bar[XB_XCNT(j)]); sum += c; cnt += (c > 0u) ? 1u : 0u; mine = (j == x) ? c : mine; }
        if (sum == G) break;
        __builtin_amdgcn_s_sleep(1);
        if ((++sp & 255u) == 0u) { if (xb_ld(&bar[XB_TMO])) break; if (sp > XB_SPIN_CAP) { atomicAdd(&bar[XB_TMO], 1u); break; } }
    }
    nloc = mine > 0u ? mine : 1u; nx = cnt > 0u ? cnt : 1u;
}
__device__ __forceinline__ void xcd_barrier(const XcdBarrier& b) {
    asm volatile("s_waitcnt vmcnt(0)" ::: "memory");
    __syncthreads();
    if (threadIdx.x == 0) {
        unsigned* bar = b.bar;
        __builtin_amdgcn_s_waitcnt(0);
        unsigned nloc = b.st[0], nx = b.st[1];
        if (nloc == 0u) { xcd_barrier_complete(bar, b.x, nloc, nx); b.st[0] = nloc; b.st[1] = nx; }
        const unsigned old = xb_add(&bar[XB_XSUB(b.x)], 1u);
        const unsigned gen = old / nloc;
        if (old + 1u == (gen + 1u) * nloc) {
            __builtin_amdgcn_fence(__ATOMIC_RELEASE, "agent");
            asm volatile("s_waitcnt vmcnt(0)" ::: "memory");
            const unsigned og = xb_add(&bar[XB_TOP], 1u);
            const unsigned tg = og / nx;
            if (og + 1u == (tg + 1u) * nx) xb_add(&bar[XB_TOPGEN], 1u);
            else XB_SPIN(xb_ld(&bar[XB_TOPGEN]) == tg, bar);
            __builtin_amdgcn_fence(__ATOMIC_ACQUIRE, "agent");
            xb_add(&bar[XB_XGEN(b.x)], 1u);
            asm volatile("s_waitcnt vmcnt(0)" ::: "memory");
        } else {
            XB_SPIN(xb_ld(&bar[XB_XGEN(b.x)]) == gen, bar);
            __builtin_amdgcn_fence(__ATOMIC_ACQUIRE, "agent");
            asm volatile("s_waitcnt vmcnt(0)" ::: "memory");
        }
    }
    __syncthreads();
}

constexpr int NWAVES = 8;
constexpr int RING_OFF = 0, RING_BYTES = 131072;
constexpr int LDSCTL_OFF = RING_BYTES, MISC_OFF = LDSCTL_OFF + 320;
constexpr int LDS_BYTES = 147456;
constexpr int CW_BAR = 4096;
constexpr int MAX_LAUNCHES = 24;
static_assert((CW_BAR + MAX_LAUNCHES * XCD_BAR_WORDS) * 4 <= (int)CTL_ZERO_BYTES, "barrier regions inside the memset region");
constexpr int PH_PER_LAYER = 8, PH_TOTAL = 1 + NL * PH_PER_LAYER;
enum { PH_A = 0, PH_M1 = 1, PH_M2 = 2, PH_M3 = 3, PH_G = 4, PH_C = 5, PH_D = 6, PH_T = 7 };

struct Args { const float* in[19]; float* out; unsigned char* ws; int ph_lo, ph_hi, li, pad; };

__device__ __forceinline__ float wave_sum(float v) {
#pragma unroll
    for (int o = 1; o < 64; o <<= 1) v += __shfl_xor(v, o);
    return v;
}
__device__ __forceinline__ unsigned pk2(float lo, float hi) { return (unsigned)f2bf(lo) | ((unsigned)f2bf(hi) << 16); }
typedef float f32x4_t __attribute__((ext_vector_type(4)));
typedef unsigned u32x4_t __attribute__((ext_vector_type(4)));

__device__ __forceinline__ void transpose_item(const float* W_, int K, int N, bf16_t* WT_, LAS float* scr, int item, int lane) {
    const GAS float* W = (const GAS float*)W_; GAS bf16_t* WT = (GAS bf16_t*)WT_;
    const int nblk = N / 32, kb = item / nblk, nb = item % nblk, k0 = 64 * kb, n0 = 32 * nb;
#pragma unroll 8
    for (int i = 0; i < 32; ++i) { const int kk = 2 * i + (lane >> 5); scr[kk * 33 + (lane & 31)] = W[(size_t)(k0 + kk) * N + n0 + (lane & 31)]; }
    asm volatile("s_waitcnt lgkmcnt(0)" ::: "memory");
    const int c = lane & 7;
#pragma unroll
    for (int j = 0; j < 4; ++j) { const int n = (lane >> 3) + 8 * j; const LAS float* s = scr + (8 * c) * 33 + n;
        u32x4_t o; o.x = pk2(s[0 * 33], s[1 * 33]); o.y = pk2(s[2 * 33], s[3 * 33]); o.z = pk2(s[4 * 33], s[5 * 33]); o.w = pk2(s[6 * 33], s[7 * 33]);
        *(GAS u32x4_t*)(WT + (size_t)(n0 + n) * K + k0 + 8 * c) = o; }
    asm volatile("s_waitcnt lgkmcnt(0)" ::: "memory");
}
__device__ __forceinline__ void convert_weights(unsigned char* ws, const float* w_in_all, const float* w_gate_all, const float* w_branch_all, const float* w_out_all, int l, int mask, LAS unsigned char* lds, int gw, int NGW, int wave, int lane) {
    LAS float* scr = (LAS float*)(lds + RING_OFF + wave * 16384);
    const float* w_in = w_in_all + (size_t)l * ND * NU; const float* w_gate = w_gate_all + (size_t)l * 5 * ND * ND;
    const float* w_branch = w_branch_all + (size_t)l * 5 * NW * ND; const float* w_out = w_out_all + (size_t)l * ND * ND;
    constexpr int I_IN = (ND / 64) * (NU / 32), I_G = (ND / 64) * (ND / 32), I_B = (NW / 64) * (ND / 32), I_O = I_G;
    if (mask & 1) for (int it = gw; it < I_IN; it += NGW) transpose_item(w_in, ND, NU, (bf16_t*)(ws + WS_WIN), scr, it, lane);
    if (mask & 2) for (int it = gw; it < 5 * I_G + 5 * I_B + I_O; it += NGW) {
        int r = it;
        if (r < 5 * I_G) { const int n = r / I_G; transpose_item(w_gate + (size_t)n * ND * ND, ND, ND, (bf16_t*)(ws + WS_WG) + (size_t)n * ND * ND, scr, r - n * I_G, lane); continue; } r -= 5 * I_G;
        if (r < 5 * I_B) { const int n = r / I_B; transpose_item(w_branch + (size_t)n * NW * ND, NW, ND, (bf16_t*)(ws + WS_WB) + (size_t)n * ND * NW, scr, r - n * I_B, lane); continue; } r -= 5 * I_B;
        transpose_item(w_out, ND, ND, (bf16_t*)(ws + WS_WO), scr, r, lane);
    }
}
__device__ __forceinline__ void rms_row_to_bf16(const float* xrow, const float* g, bf16_t* orow, int lane) {
    const GAS f32x4_t* xr = (const GAS f32x4_t*)xrow + lane; const GAS f32x4_t* gr = (const GAS f32x4_t*)g + lane;
    f32x4_t v[4]; float s = 0.f;
#pragma unroll
    for (int j = 0; j < 4; ++j) { v[j] = xr[64 * j]; s += (v[j].x * v[j].x + v[j].y * v[j].y) + (v[j].z * v[j].z + v[j].w * v[j].w); }
    const float r = rsqrtf(wave_sum(s) * (1.f / ND) + EPSF);
    GAS unsigned long long* o8 = (GAS unsigned long long*)orow + lane;
#pragma unroll
    for (int j = 0; j < 4; ++j) { const f32x4_t gg = gr[64 * j];
        o8[64 * j] = (unsigned long long)pk2(v[j].x * r * gg.x, v[j].y * r * gg.y) | ((unsigned long long)pk2(v[j].z * r * gg.z, v[j].w * r * gg.w) << 32); }
}
__device__ __forceinline__ void post_row(const float* xrow, const bf16_t* orow, const float* g_post, const float* g_next, float* xout, bf16_t* hrow, bool has_next, int lane) {
    const GAS f32x4_t* xr = (const GAS f32x4_t*)xrow + lane; const GAS unsigned long long* o8 = (const GAS unsigned long long*)orow + lane;
    f32x4_t v[4]; float s = 0.f;
#pragma unroll
    for (int j = 0; j < 4; ++j) { const unsigned long long w = o8[64 * j]; const unsigned lo = (unsigned)w, hi = (unsigned)(w >> 32);
        v[j].x = __uint_as_float(lo << 16); v[j].y = __uint_as_float(lo & 0xffff0000u); v[j].z = __uint_as_float(hi << 16); v[j].w = __uint_as_float(hi & 0xffff0000u);
        s += (v[j].x * v[j].x + v[j].y * v[j].y) + (v[j].z * v[j].z + v[j].w * v[j].w); }
    const float r = rsqrtf(wave_sum(s) * (1.f / ND) + EPSF);
    float s2 = 0.f;
#pragma unroll
    for (int j = 0; j < 4; ++j) { const f32x4_t gg = ((const GAS f32x4_t*)g_post + lane)[64 * j]; const f32x4_t xx = xr[64 * j];
        v[j].x = xx.x + v[j].x * r * gg.x; v[j].y = xx.y + v[j].y * r * gg.y; v[j].z = xx.z + v[j].z * r * gg.z; v[j].w = xx.w + v[j].w * r * gg.w;
        s2 += (v[j].x * v[j].x + v[j].y * v[j].y) + (v[j].z * v[j].z + v[j].w * v[j].w);
        ((GAS f32x4_t*)xout + lane)[64 * j] = v[j]; }
    if (has_next) {
        const float r2 = rsqrtf(wave_sum(s2) * (1.f / ND) + EPSF);
        GAS unsigned long long* h8 = (GAS unsigned long long*)hrow + lane;
#pragma unroll
        for (int j = 0; j < 4; ++j) { const f32x4_t gg = ((const GAS f32x4_t*)g_next + lane)[64 * j];
            h8[64 * j] = (unsigned long long)pk2(v[j].x * r2 * gg.x, v[j].y * r2 * gg.y) | ((unsigned long long)pk2(v[j].z * r2 * gg.z, v[j].w * r2 * gg.w) << 32); }
    }
}


__device__ __forceinline__ void post_rows(const float* xin_, const bf16_t* outraw_, const float* g_post_, const float* g_next_, float* xout_, bf16_t* H_, bool has_next, int gw, int NGW, int lane) {
    const GAS f32x4_t* xin = (const GAS f32x4_t*)xin_ + lane; const GAS unsigned long long* orw = (const GAS unsigned long long*)outraw_ + lane;
    GAS f32x4_t* xout = (GAS f32x4_t*)xout_ + lane; GAS unsigned long long* H8 = (GAS unsigned long long*)H_ + lane;
    f32x4_t gp[4], gn[4];
#pragma unroll
    for (int j = 0; j < 4; ++j) { gp[j] = ((const GAS f32x4_t*)g_post_ + lane)[64 * j]; gn[j] = ((const GAS f32x4_t*)g_next_ + lane)[64 * j]; }
    f32x4_t xn[4]; unsigned long long on[4];
    int m = gw;
    if (m < NM) {
#pragma unroll
        for (int j = 0; j < 4; ++j) { xn[j] = xin[(size_t)m * 256 + 64 * j]; on[j] = orw[(size_t)m * 256 + 64 * j]; }
    }
    for (; m < NM; m += NGW) {
        f32x4_t v[4], xc[4]; float s = 0.f;
#pragma unroll
        for (int j = 0; j < 4; ++j) { xc[j] = xn[j]; const unsigned lo = (unsigned)on[j], hi = (unsigned)(on[j] >> 32);
            v[j].x = __uint_as_float(lo << 16); v[j].y = __uint_as_float(lo & 0xffff0000u); v[j].z = __uint_as_float(hi << 16); v[j].w = __uint_as_float(hi & 0xffff0000u);
            s += (v[j].x * v[j].x + v[j].y * v[j].y) + (v[j].z * v[j].z + v[j].w * v[j].w); }
        const int m2 = m + NGW;
        if (m2 < NM) {
#pragma unroll
            for (int j = 0; j < 4; ++j) { xn[j] = xin[(size_t)m2 * 256 + 64 * j]; on[j] = orw[(size_t)m2 * 256 + 64 * j]; }
        }
        asm volatile("" ::: "memory");
        const float r = rsqrtf(wave_sum(s) * (1.f / ND) + EPSF);
        float s2 = 0.f;
#pragma unroll
        for (int j = 0; j < 4; ++j) { v[j] = xc[j] + v[j] * r * gp[j]; s2 += (v[j].x * v[j].x + v[j].y * v[j].y) + (v[j].z * v[j].z + v[j].w * v[j].w); xout[(size_t)m * 256 + 64 * j] = v[j]; }
        if (has_next) {
            const float r2 = rsqrtf(wave_sum(s2) * (1.f / ND) + EPSF);
#pragma unroll
            for (int j = 0; j < 4; ++j) { const f32x4_t o = v[j] * r2 * gn[j];
                H8[(size_t)m * 256 + 64 * j] = (unsigned long long)pk2(o.x, o.y) | ((unsigned long long)pk2(o.z, o.w) << 32); }
        }
    }
}

__device__ __forceinline__ void rms_rows(const float* x_, const float* g_, int gdiv, bf16_t* out_, int nrows, int gw, int NGW, int lane) {
    const GAS f32x4_t* xin = (const GAS f32x4_t*)x_ + lane; GAS unsigned long long* o8 = (GAS unsigned long long*)out_ + lane;
    f32x4_t xn[4];
    int m = gw;
    if (m < nrows) {
#pragma unroll
        for (int j = 0; j < 4; ++j) xn[j] = xin[(size_t)(gdiv ? m % gdiv : m) * 256 + 64 * j];
    }
    for (; m < nrows; m += NGW) {
        f32x4_t v[4]; float s = 0.f;
#pragma unroll
        for (int j = 0; j < 4; ++j) { v[j] = xn[j]; s += (v[j].x * v[j].x + v[j].y * v[j].y) + (v[j].z * v[j].z + v[j].w * v[j].w); }
        const int m2 = m + NGW;
        if (m2 < nrows) {
#pragma unroll
            for (int j = 0; j < 4; ++j) xn[j] = xin[(size_t)(gdiv ? m2 % gdiv : m2) * 256 + 64 * j];
        }
        const GAS f32x4_t* gr = (const GAS f32x4_t*)(g_ + (gdiv ? (size_t)(m / gdiv) * ND : 0)) + lane;
        f32x4_t gg[4];
#pragma unroll
        for (int j = 0; j < 4; ++j) gg[j] = gr[64 * j];
        asm volatile("" ::: "memory");
        const float r = rsqrtf(wave_sum(s) * (1.f / ND) + EPSF);
#pragma unroll
        for (int j = 0; j < 4; ++j) o8[(size_t)m * 256 + 64 * j] = (unsigned long long)pk2(v[j].x * r * gg[j].x, v[j].y * r * gg[j].y) | ((unsigned long long)pk2(v[j].z * r * gg[j].z, v[j].w * r * gg[j].w) << 32);
    }
}

typedef short bf16x8_t __attribute__((ext_vector_type(8)));
typedef float f32x16_t __attribute__((ext_vector_type(16)));
#define MIX_LAS __attribute__((address_space(3)))
typedef float f32x4m __attribute__((ext_vector_type(4)));
typedef unsigned u32x4m __attribute__((ext_vector_type(4)));
__device__ __forceinline__ float wsum_(float v) {
#pragma unroll
    for (int o = 1; o < 64; o <<= 1) v += __shfl_xor(v, o);
    return v;
}
constexpr int KROW = 144;
__device__ __forceinline__ int crow_(int r, int hi) { return (r & 3) + 8 * (r >> 2) + 4 * hi; }
typedef float f32x2m __attribute__((ext_vector_type(2))); typedef __bf16 bf16x2m __attribute__((ext_vector_type(2)));
__device__ __forceinline__ unsigned pkbf(float lo, float hi) { f32x2m v = {lo, hi}; bf16x2m b = __builtin_convertvector(v, bf16x2m); return __builtin_bit_cast(unsigned, b); }

template <bool WIN>
__device__ __forceinline__ void attn_core(const MIX_LAS unsigned char* Kl, const MIX_LAS unsigned char* VTl, int vt_stride, const MIX_LAS float* biasl,
                                          const bf16x8_t (&qf)[4], int t_lo, int t_hi, int t_int_lo, int t_int_hi, int qi_band, float m0, float l0,
                                          const GAS bf16_t* zrow, GAS bf16_t* yrow, int lane) {
    constexpr float C2 = 0.125f * 1.4426950408889634f;
    const int r32 = lane & 31, hi = lane >> 5;
    f32x16_t O0, O1;
#pragma unroll
    for (int r = 0; r < 16; ++r) { O0[r] = 0.f; O1[r] = 0.f; }
    float m = m0, l = l0;
    typedef unsigned u32x4v __attribute__((ext_vector_type(4)));
    for (int t = t_lo; t < t_hi; t += 2) {
        f32x16_t s0, s1;
#pragma unroll
        for (int r = 0; r < 16; ++r) { s0[r] = 0.f; s1[r] = 0.f; }
        const MIX_LAS unsigned char* kp = Kl + (t * 32 + r32) * KROW + hi * 16;
#pragma unroll
        for (int ds = 0; ds < 4; ++ds) { const bf16x8_t a0 = *(const MIX_LAS bf16x8_t*)(kp + ds * 32), a1 = *(const MIX_LAS bf16x8_t*)(kp + 32 * KROW + ds * 32);
            s0 = __builtin_amdgcn_mfma_f32_32x32x16_bf16(a0, qf[ds], s0, 0, 0, 0); s1 = __builtin_amdgcn_mfma_f32_32x32x16_bf16(a1, qf[ds], s1, 0, 0, 0); }
        if (WIN) {
            const int rel0 = t * 32 + 4 * hi - qi_band;
            const MIX_LAS float* bp = biasl + (rel0 + 128);
#pragma unroll
            for (int r = 0; r < 16; ++r) { s0[r] = s0[r] * C2 + bp[(r & 3) + 8 * (r >> 2)]; s1[r] = s1[r] * C2 + bp[32 + (r & 3) + 8 * (r >> 2)]; }
            if (t < t_int_lo || t >= t_int_hi) {
#pragma unroll
                for (int r = 0; r < 16; ++r) { const int rel = rel0 + (r & 3) + 8 * (r >> 2); s0[r] = (rel >= -128 && rel <= 128) ? s0[r] : -INFINITY; }
            }
            if (t + 1 < t_int_lo || t + 1 >= t_int_hi) {
#pragma unroll
                for (int r = 0; r < 16; ++r) { const int rel = rel0 + 32 + (r & 3) + 8 * (r >> 2); s1[r] = (rel >= -128 && rel <= 128) ? s1[r] : -INFINITY; }
            }
        } else {
#pragma unroll
            for (int r = 0; r < 16; ++r) { s0[r] *= C2; s1[r] *= C2; }
        }
        float mx = fmaxf(s0[0], s1[0]);
#pragma unroll
        for (int r = 1; r < 16; ++r) mx = fmaxf(mx, fmaxf(s0[r], s1[r]));
        mx = fmaxf(mx, __shfl_xor(mx, 32));
        if (__any(mx > m)) {
            const float mn = fmaxf(m, mx), sc = __builtin_amdgcn_exp2f(m - mn); m = mn; l *= sc;
#pragma unroll
            for (int r = 0; r < 16; ++r) { O0[r] *= sc; O1[r] *= sc; }
        }
        float ps = 0.f;
#pragma unroll
        for (int r = 0; r < 16; ++r) { const float p0 = __builtin_amdgcn_exp2f(s0[r] - m), p1 = __builtin_amdgcn_exp2f(s1[r] - m); s0[r] = p0; s1[r] = p1; ps += p0 + p1; }
        l += ps;
        u32x4v a0, a1, b0, b1;
        a0.x = pkbf(s0[0], s0[1]); a0.y = pkbf(s0[2], s0[3]); a0.z = pkbf(s0[4], s0[5]); a0.w = pkbf(s0[6], s0[7]);
        a1.x = pkbf(s0[8], s0[9]); a1.y = pkbf(s0[10], s0[11]); a1.z = pkbf(s0[12], s0[13]); a1.w = pkbf(s0[14], s0[15]);
        b0.x = pkbf(s1[0], s1[1]); b0.y = pkbf(s1[2], s1[3]); b0.z = pkbf(s1[4], s1[5]); b0.w = pkbf(s1[6], s1[7]);
        b1.x = pkbf(s1[8], s1[9]); b1.y = pkbf(s1[10], s1[11]); b1.z = pkbf(s1[12], s1[13]); b1.w = pkbf(s1[14], s1[15]);
        const bf16x8_t pf0 = __builtin_bit_cast(bf16x8_t, a0), pf1 = __builtin_bit_cast(bf16x8_t, a1), pf2 = __builtin_bit_cast(bf16x8_t, b0), pf3 = __builtin_bit_cast(bf16x8_t, b1);
        const MIX_LAS unsigned char* vp = VTl + r32 * vt_stride + (t * 32 + 8 * hi) * 2;
        const MIX_LAS unsigned char* vq = vp + 32 * vt_stride;
        { const bf16x8_t x0 = *(const MIX_LAS bf16x8_t*)(vp), y0 = *(const MIX_LAS bf16x8_t*)(vq);
          O0 = __builtin_amdgcn_mfma_f32_32x32x16_bf16(x0, pf0, O0, 0, 0, 0); O1 = __builtin_amdgcn_mfma_f32_32x32x16_bf16(y0, pf0, O1, 0, 0, 0); }
        { const bf16x8_t x0 = *(const MIX_LAS bf16x8_t*)(vp + 32), y0 = *(const MIX_LAS bf16x8_t*)(vq + 32);
          O0 = __builtin_amdgcn_mfma_f32_32x32x16_bf16(x0, pf1, O0, 0, 0, 0); O1 = __builtin_amdgcn_mfma_f32_32x32x16_bf16(y0, pf1, O1, 0, 0, 0); }
        { const bf16x8_t x0 = *(const MIX_LAS bf16x8_t*)(vp + 64), y0 = *(const MIX_LAS bf16x8_t*)(vq + 64);
          O0 = __builtin_amdgcn_mfma_f32_32x32x16_bf16(x0, pf2, O0, 0, 0, 0); O1 = __builtin_amdgcn_mfma_f32_32x32x16_bf16(y0, pf2, O1, 0, 0, 0); }
        { const bf16x8_t x0 = *(const MIX_LAS bf16x8_t*)(vp + 96), y0 = *(const MIX_LAS bf16x8_t*)(vq + 96);
          O0 = __builtin_amdgcn_mfma_f32_32x32x16_bf16(x0, pf3, O0, 0, 0, 0); O1 = __builtin_amdgcn_mfma_f32_32x32x16_bf16(y0, pf3, O1, 0, 0, 0); }
    }
    l += __shfl_xor(l, 32);
    const float inv = __builtin_amdgcn_rcpf(l);
#pragma unroll
    for (int dt = 0; dt < 2; ++dt)
#pragma unroll
        for (int g4 = 0; g4 < 4; ++g4) {
            const int d0 = dt * 32 + 8 * g4 + 4 * hi;
            const gu32x2 zw = *(const GAS gu32x2*)(zrow + d0);
            const float z0 = __uint_as_float(zw.x << 16), z1 = __uint_as_float(zw.x & 0xffff0000u), z2 = __uint_as_float(zw.y << 16), z3 = __uint_as_float(zw.y & 0xffff0000u);
            float o0, o1, o2, o3;
            if (dt == 0) { o0 = O0[4 * g4]; o1 = O0[4 * g4 + 1]; o2 = O0[4 * g4 + 2]; o3 = O0[4 * g4 + 3]; }
            else { o0 = O1[4 * g4]; o1 = O1[4 * g4 + 1]; o2 = O1[4 * g4 + 2]; o3 = O1[4 * g4 + 3]; }
            gu32x2 w; w.x = pkbf(o0 * inv * siluf_(z0), o1 * inv * siluf_(z1)); w.y = pkbf(o2 * inv * siluf_(z2), o3 * inv * siluf_(z3));
            *(GAS gu32x2*)(yrow + d0) = w;
        }
}
template <int NK, class KP, class VP>
__device__ __forceinline__ void attn_stage(MIX_LAS unsigned char* Kl, MIX_LAS unsigned char* VTl, int vt_stride, const KP& krow, const VP& vrow, int tid) {
    constexpr int NIT = NK * 8 / 512;
    {
        u32x4m kv[NIT];
#pragma unroll
        for (int it = 0; it < NIT; ++it) { const int idx = tid + it * 512, row = idx >> 3, ch = idx & 7; const GAS bf16_t* p = krow(row);
            kv[it] = (u32x4m){0u, 0u, 0u, 0u}; if (p) kv[it] = *(const GAS u32x4m*)(p + ch * 8); }
        asm volatile("" ::: "memory");
#pragma unroll
        for (int it = 0; it < NIT; ++it) { const int idx = tid + it * 512, row = idx >> 3, ch = idx & 7; *(MIX_LAS u32x4m*)(Kl + row * KROW + ch * 16) = kv[it]; }
    }
    {
        u32x4m vv[NIT];
#pragma unroll
        for (int it = 0; it < NIT; ++it) { const int idx = tid + it * 512, ch = idx / NK, row = idx - ch * NK; const GAS bf16_t* p = vrow(row);
            vv[it] = (u32x4m){0u, 0u, 0u, 0u}; if (p) vv[it] = *(const GAS u32x4m*)(p + ch * 8); }
        asm volatile("" ::: "memory");
#pragma unroll
        for (int it = 0; it < NIT; ++it) { const int idx = tid + it * 512, ch = idx / NK, row = idx - ch * NK;
            const int w = row & 31, wp = (w & 0x13) | ((w & 4) << 1) | ((w & 8) >> 1), pos = (row & ~31) + wp;
            MIX_LAS unsigned short* dst = (MIX_LAS unsigned short*)(VTl + (ch * 8) * vt_stride + pos * 2);
            const unsigned ww[4] = {vv[it].x, vv[it].y, vv[it].z, vv[it].w};
#pragma unroll
            for (int e = 0; e < 4; ++e) { dst[(2 * e) * (vt_stride / 2)] = (unsigned short)(ww[e] & 0xffffu); dst[(2 * e + 1) * (vt_stride / 2)] = (unsigned short)(ww[e] >> 16); } }
    }
}

__device__ __forceinline__ void winattn_item(int item, const GAS bf16_t* U, const GAS float* BIAS, const GAS float* sink, GAS bf16_t* Y, MIX_LAS unsigned char* lds, int tid, bool do_core = true) {
    constexpr int NK = 384, VTS = NK * 2 + 16;
    const int qb = item & 31, kvh = (item >> 5) & 1, b = item >> 6;
    MIX_LAS unsigned char* Kl = lds; MIX_LAS unsigned char* VTl = lds + NK * KROW; MIX_LAS float* biasl = (MIX_LAS float*)(lds + NK * KROW + 64 * VTS);
    const int kpos0 = qb * 128 - 128; const size_t rowb = (size_t)b * NS;
    auto krow = [&](int i) -> const GAS bf16_t* { const int p = kpos0 + i; return (p >= 0 && p < NS) ? U + (rowb + p) * NU + C_AK + kvh * 64 : (const GAS bf16_t*)nullptr; };
    auto vrow = [&](int i) -> const GAS bf16_t* { const int p = kpos0 + i; return (p >= 0 && p < NS) ? U + (rowb + p) * NU + C_AV + kvh * 64 : (const GAS bf16_t*)nullptr; };
    attn_stage<NK>(Kl, VTl, VTS, krow, vrow, tid);
    for (int i = tid; i < 2 * 321; i += 512) { const int g_ = i / 321, j = i - g_ * 321 - 32; biasl[i] = (j >= 0 && j < 257) ? BIAS[(kvh * 2 + g_) * 257 + j] * 1.4426950408889634f : 0.f; }
    const int lane = tid & 63, wave = __builtin_amdgcn_readfirstlane(tid >> 6), g = wave >> 2, wq = wave & 3, r32 = lane & 31, hi = lane >> 5, h = kvh * 2 + g;
    const size_t mq = rowb + qb * 128 + wq * 32 + r32;
    bf16x8_t qf[4];
#pragma unroll
    for (int ds = 0; ds < 4; ++ds) qf[ds] = *(const GAS bf16x8_t*)(U + mq * NU + C_AQ + h * 64 + ds * 16 + hi * 8);
    __syncthreads();
    const int tmin = (qb == 0) ? 4 : 0, tmax = (qb == 31) ? 8 : 12;
    int t_lo = wq > tmin ? wq : tmin, t_hi = (wq + 9) < tmax ? (wq + 9) : tmax;
    if ((t_hi - t_lo) & 1) { if (t_hi < tmax) ++t_hi; else --t_lo; }
    if (do_core) attn_core<true>(Kl, VTl, VTS, biasl + g * 321 + 32, qf, t_lo, t_hi, wq + 1, wq + 8, 128 + wq * 32 + r32, sink[h] * 1.4426950408889634f, 1.f, U + mq * NU + C_AZ + h * 64, Y + mq * NY + 3 * NW + h * 64, lane);
    __syncthreads();
}
__device__ __forceinline__ void memattn_item(int item, const GAS bf16_t* U, const GAS bf16_t* MKV, GAS bf16_t* Y, MIX_LAS unsigned char* lds, int tid) {
    constexpr int NK = 256, VTS = NK * 2 + 16;
    const int qblk = item & 15, h = (item >> 4) & 3, b = item >> 6;
    MIX_LAS unsigned char* Kl = lds; MIX_LAS unsigned char* VTl = lds + NK * KROW;
    auto krow = [&](int i) -> const GAS bf16_t* { return MKV + (size_t)(b * MEML + i) * 512 + h * 64; };
    auto vrow = [&](int i) -> const GAS bf16_t* { return MKV + (size_t)(b * MEML + i) * 512 + 256 + h * 64; };
    attn_stage<NK>(Kl, VTl, VTS, krow, vrow, tid);
    const int lane = tid & 63, wave = __builtin_amdgcn_readfirstlane(tid >> 6), r32 = lane & 31, hi = lane >> 5;
    const size_t mq = (size_t)b * NS + qblk * 256 + wave * 32 + r32;
    bf16x8_t qf[4];
#pragma unroll
    for (int ds = 0; ds < 4; ++ds) qf[ds] = *(const GAS bf16x8_t*)(U + mq * NU + C_MQ + h * 64 + ds * 16 + hi * 8);
    __syncthreads();
    attn_core<false>(Kl, VTl, VTS, (const MIX_LAS float*)lds, qf, 0, 8, 0, 8, 0, -1e30f, 0.f, U + mq * NU + C_MZ + h * 64, Y + mq * NY + 4 * NW + h * 64, lane);
    __syncthreads();
}
__device__ __forceinline__ void conformer_item(int item, const GAS bf16_t* U, const GAS float* dw_w, const GAS float* dw_b, const GAS float* ln_g, const GAS float* ln_b, GAS bf16_t* Y, MIX_LAS unsigned char* lds, int tid) {
    MIX_LAS unsigned short* ul = (MIX_LAS unsigned short*)lds; MIX_LAS float* cv = (MIX_LAS float*)(lds + 94 * 512);
    const int tt = item & 63, b = item >> 6; const size_t rowb = (size_t)b * NS; const int t0 = tt * 64;
    {
        u32x4m av[6], bv[6];
#pragma unroll
        for (int it = 0; it < 6; ++it) { const int idx = tid + it * 512, row = idx >> 5, ch = idx & 31, t = t0 - 15 + row;
            av[it] = (u32x4m){0u, 0u, 0u, 0u}; bv[it] = av[it];
            if (idx < 94 * 32 && t >= 0 && t < NS) { const GAS bf16_t* p = U + (rowb + t) * NU; av[it] = *(const GAS u32x4m*)(p + C_CA + ch * 8); bv[it] = *(const GAS u32x4m*)(p + C_CB + ch * 8); } }
        asm volatile("" ::: "memory");
#pragma unroll
        for (int it = 0; it < 6; ++it) { const int idx = tid + it * 512, row = idx >> 5, ch = idx & 31;
            const unsigned aw[4] = {av[it].x, av[it].y, av[it].z, av[it].w}, bw[4] = {bv[it].x, bv[it].y, bv[it].z, bv[it].w}; unsigned ow[4];
#pragma unroll
            for (int e = 0; e < 4; ++e) ow[e] = pkbf(__uint_as_float(aw[e] << 16) * sigmoidf_(__uint_as_float(bw[e] << 16)), __uint_as_float(aw[e] & 0xffff0000u) * sigmoidf_(__uint_as_float(bw[e] & 0xffff0000u)));
            if (idx < 94 * 32) *(MIX_LAS u32x4m*)(ul + row * 256 + ch * 8) = (u32x4m){ow[0], ow[1], ow[2], ow[3]}; }
    }
    __syncthreads();
    {
        const int c = tid & 255, half = tid >> 8;
        float w[31], u[62];
#pragma unroll
        for (int j = 0; j < 31; ++j) w[j] = dw_w[j * 256 + c];
#pragma unroll
        for (int j = 0; j < 62; ++j) u[j] = __uint_as_float((unsigned)ul[(half * 32 + j) * 256 + c] << 16);
        const float bias = dw_b[c];
#pragma unroll
        for (int i = 0; i < 32; ++i) { float a = bias;
#pragma unroll
            for (int j = 0; j < 31; ++j) a += w[j] * u[i + j];
            cv[(half * 32 + i) * 256 + c] = a; }
    }
    __syncthreads();
    {
        const int lane = tid & 63, wave = tid >> 6;
        const f32x4m g4 = ((const GAS f32x4m*)ln_g)[lane], b4 = ((const GAS f32x4m*)ln_b)[lane];
#pragma unroll
        for (int i = 0; i < 8; ++i) { const int t = wave * 8 + i;
            const f32x4m v = *(const MIX_LAS f32x4m*)(cv + t * 256 + lane * 4);
            float s1 = (v.x + v.y) + (v.z + v.w), s2 = (v.x * v.x + v.y * v.y) + (v.z * v.z + v.w * v.w);
#pragma unroll
            for (int o_ = 1; o_ < 64; o_ <<= 1) { s1 += __shfl_xor(s1, o_); s2 += __shfl_xor(s2, o_); }
            const float mu = s1 * (1.f / 256.f);
            const f32x4m d = v - mu;
            const float var = fmaxf(s2 * (1.f / 256.f) - mu * mu, 0.f);
            const float rs = rsqrtf(var + EPSF);
            const size_t m = rowb + t0 + t;
            const gu32x2 zw = *(const GAS gu32x2*)(U + m * NU + C_CZ + lane * 4);
            const float n0 = d.x * rs * g4.x + b4.x, n1 = d.y * rs * g4.y + b4.y, n2 = d.z * rs * g4.z + b4.z, n3 = d.w * rs * g4.w + b4.w;
            gu32x2 o; o.x = pkbf(siluf_(n0) * siluf_(__uint_as_float(zw.x << 16)), siluf_(n1) * siluf_(__uint_as_float(zw.x & 0xffff0000u)));
            o.y = pkbf(siluf_(n2) * siluf_(__uint_as_float(zw.y << 16)), siluf_(n3) * siluf_(__uint_as_float(zw.y & 0xffff0000u)));
            *(GAS gu32x2*)(Y + m * NY + 1 * NW + lane * 4) = o; }
    }
    __syncthreads();
}
__device__ __forceinline__ void shortconv_item(int item, const GAS bf16_t* U, const GAS float* w, GAS bf16_t* Y, int tid) {
    const int tt = item & 63, b = item >> 6; const size_t rowb = (size_t)b * NS;
    const int ch = tid & 31, tl = tid >> 5, t0 = tt * 64 + tl * 4;
    u32x4m cr[6], vr[6], br[4], zr[4];
#pragma unroll
    for (int r = 0; r < 6; ++r) { const int t = t0 - 1 + r; cr[r] = (u32x4m){0u, 0u, 0u, 0u}; vr[r] = cr[r];
        if (t >= 0 && t < NS) { const GAS bf16_t* p = U + (rowb + t) * NU; cr[r] = *(const GAS u32x4m*)(p + C_SC + ch * 8); vr[r] = *(const GAS u32x4m*)(p + C_SV + ch * 8); } }
#pragma unroll
    for (int i = 0; i < 4; ++i) { const GAS bf16_t* p = U + (rowb + t0 + i) * NU; br[i] = *(const GAS u32x4m*)(p + C_SB + ch * 8); zr[i] = *(const GAS u32x4m*)(p + C_SZ + ch * 8); }
    float w0[8], w1[8], w2[8];
#pragma unroll
    for (int e = 0; e < 8; ++e) { w0[e] = w[ch * 8 + e]; w1[e] = w[256 + ch * 8 + e]; w2[e] = w[512 + ch * 8 + e]; }
    asm volatile("" ::: "memory");
    float cv[6][8];
#pragma unroll
    for (int r = 0; r < 6; ++r) { const unsigned aw[4] = {cr[r].x, cr[r].y, cr[r].z, cr[r].w}, vw[4] = {vr[r].x, vr[r].y, vr[r].z, vr[r].w};
#pragma unroll
        for (int e = 0; e < 4; ++e) { cv[r][2 * e] = __uint_as_float(aw[e] << 16) * __uint_as_float(vw[e] << 16); cv[r][2 * e + 1] = __uint_as_float(aw[e] & 0xffff0000u) * __uint_as_float(vw[e] & 0xffff0000u); } }
#pragma unroll
    for (int i = 0; i < 4; ++i) {
        const unsigned bw[4] = {br[i].x, br[i].y, br[i].z, br[i].w}, zw[4] = {zr[i].x, zr[i].y, zr[i].z, zr[i].w}; unsigned ow[4];
#pragma unroll
        for (int e = 0; e < 4; ++e) {
            const float c0 = w0[2 * e] * cv[i][2 * e] + w1[2 * e] * cv[i + 1][2 * e] + w2[2 * e] * cv[i + 2][2 * e];
            const float c1 = w0[2 * e + 1] * cv[i][2 * e + 1] + w1[2 * e + 1] * cv[i + 1][2 * e + 1] + w2[2 * e + 1] * cv[i + 2][2 * e + 1];
            ow[e] = pkbf(__uint_as_float(bw[e] << 16) * c0 * siluf_(__uint_as_float(zw[e] << 16)), __uint_as_float(bw[e] & 0xffff0000u) * c1 * siluf_(__uint_as_float(zw[e] & 0xffff0000u))); }
        *(GAS u32x4m*)(Y + (rowb + t0 + i) * NY + 2 * NW + ch * 8) = (u32x4m){ow[0], ow[1], ow[2], ow[3]};
    }
}

constexpr size_t HG_ST_BYTES = (size_t)NB * 4 * 2 * 64 * 8192;
constexpr int H1_WLDS = 10240, H3_WLDS = 14848;
__device__ __forceinline__ void wave_lds_sync() { asm volatile("s_waitcnt lgkmcnt(0)" ::: "memory"); __builtin_amdgcn_wave_barrier(); asm volatile("" ::: "memory"); }
__device__ __forceinline__ void hgrn_gate(float fl, float lb, float& f, float& g) { const float s = __builtin_amdgcn_rcpf(1.f + __expf(-fl)); f = lb + (1.f - lb) * s; g = __builtin_amdgcn_logf(f) * 0.69314718056f; }
typedef unsigned u32x4h __attribute__((ext_vector_type(4)));

__device__ __forceinline__ void hgrn_h1_item(int item, const GAS bf16_t* U, const GAS float* LBl, GAS unsigned char* ST, GAS float* DC, MIX_LAS unsigned char* wl, int lane) {
    const int j = item & 63, dir = (item >> 6) & 1, h = (item >> 7) & 3, b = item >> 9;
    const int c = dir ? 63 - j : j;
    const size_t row0 = (size_t)b * NS + (size_t)c * 64;
    const int fcol = (dir ? C_HFB : C_HFF) + h * 64 + lane, vcol = C_HI + h * 64 + lane;
    const float lb = LBl[dir * 256 + h * 64 + lane];
    const int r32 = lane & 31, hi = lane >> 5;
    MIX_LAS unsigned char* KT = wl; MIX_LAS unsigned char* VT = wl + 5120;
    f32x16_t acc[2][2];
#pragma unroll
    for (int a = 0; a < 2; ++a)
#pragma unroll
        for (int bb = 0; bb < 2; ++bb)
#pragma unroll
            for (int r = 0; r < 16; ++r) acc[a][bb][r] = 0.f;
    float rsum = 0.f;
#pragma unroll
    for (int half = 0; half < 2; ++half) {
        unsigned kw[16], vw[16], fr[32], vr[32];
#pragma unroll
        for (int i = 0; i < 32; ++i) {
            const int tau = 63 - 32 * half - i, u = dir ? 63 - tau : tau;
            const GAS bf16_t* p = U + (row0 + u) * NU; fr[i] = p[fcol]; vr[i] = p[vcol];
        }
        asm volatile("" ::: "memory");
#pragma unroll
        for (int pr = 0; pr < 16; ++pr) {
            float f, g;
            hgrn_gate(__uint_as_float(fr[2 * pr] << 16), lb, f, g); const float k_hi = (1.f - f) * __expf(rsum); rsum += g;
            hgrn_gate(__uint_as_float(fr[2 * pr + 1] << 16), lb, f, g); const float k_lo = (1.f - f) * __expf(rsum); rsum += g;
            kw[15 - pr] = pkbf(k_lo, k_hi);
            vw[15 - pr] = vr[2 * pr + 1] | (vr[2 * pr] << 16);
        }
#pragma unroll
        for (int g8 = 0; g8 < 4; ++g8) {
            *(MIX_LAS u32x4h*)(KT + lane * 80 + g8 * 16) = (u32x4h){kw[4 * g8], kw[4 * g8 + 1], kw[4 * g8 + 2], kw[4 * g8 + 3]};
            *(MIX_LAS u32x4h*)(VT + lane * 80 + g8 * 16) = (u32x4h){vw[4 * g8], vw[4 * g8 + 1], vw[4 * g8 + 2], vw[4 * g8 + 3]};
        }
        wave_lds_sync();
#pragma unroll
        for (int s = 0; s < 2; ++s) {
            bf16x8_t af[2], bfr[2];
#pragma unroll
            for (int x = 0; x < 2; ++x) { af[x] = *(const MIX_LAS bf16x8_t*)(KT + (r32 + 32 * x) * 80 + (16 * s + 8 * hi) * 2); bfr[x] = *(const MIX_LAS bf16x8_t*)(VT + (r32 + 32 * x) * 80 + (16 * s + 8 * hi) * 2); }
#pragma unroll
            for (int kt = 0; kt < 2; ++kt)
#pragma unroll
                for (int vt = 0; vt < 2; ++vt) acc[kt][vt] = __builtin_amdgcn_mfma_f32_32x32x16_bf16(af[kt], bfr[vt], acc[kt][vt], 0, 0, 0);
        }
        wave_lds_sync();
    }
    DC[(size_t)item * 64 + lane] = __expf(rsum);
    GAS unsigned char* out = ST + (size_t)item * 8192;
#pragma unroll
    for (int kt = 0; kt < 2; ++kt)
#pragma unroll
        for (int vt = 0; vt < 2; ++vt)
#pragma unroll
            for (int g4 = 0; g4 < 4; ++g4) { const int k0 = 32 * kt + 8 * g4 + 4 * hi, v = 32 * vt + r32;
                gu32x2 w; w.x = pkbf(acc[kt][vt][4 * g4], acc[kt][vt][4 * g4 + 1]); w.y = pkbf(acc[kt][vt][4 * g4 + 2], acc[kt][vt][4 * g4 + 3]);
                *(GAS gu32x2*)(out + (v * 64 + k0) * 2) = w; }
}

__device__ __forceinline__ void hgrn_h2_item(int item, GAS unsigned char* ST, const GAS float* DC, int tid) {
    const int seq = item >> 2, e = (item & 3) * 512 + tid, kp = e & 31;
    GAS unsigned char* base = ST + (size_t)seq * 64 * 8192 + (size_t)e * 4;
    const GAS float* dcb = DC + (size_t)seq * 64 * 64 + kp * 2;
    float s0 = 0.f, s1 = 0.f;
    for (int j0 = 0; j0 < 64; j0 += 16) {
        unsigned hc[16]; gf32x2 dc[16];
#pragma unroll
        for (int jj = 0; jj < 16; ++jj) { hc[jj] = *(const GAS unsigned*)(base + (size_t)(j0 + jj) * 8192); dc[jj] = *(const GAS gf32x2*)(dcb + (j0 + jj) * 64); }
#pragma unroll
        for (int jj = 0; jj < 16; ++jj) {
            *(GAS unsigned*)(base + (size_t)(j0 + jj) * 8192) = pkbf(s0, s1);
            s0 = dc[jj].x * s0 + __uint_as_float(hc[jj] << 16); s1 = dc[jj].y * s1 + __uint_as_float(hc[jj] & 0xffff0000u);
        }
    }
}

template <int DIR>
__device__ __forceinline__ void hgrn_h3_dir(f32x16_t (&O)[2][2], const GAS bf16_t* U_, size_t row0, int h, float lb, const GAS unsigned char* Sp, MIX_LAS unsigned char* wl, int lane) {
    const GAS bf16_t* U = U_; asm volatile("" : "+s"(U));
    const int r32 = lane & 31, hi = lane >> 5;
    MIX_LAS unsigned char* Ql = wl; MIX_LAS unsigned char* Kl = wl + 4608; MIX_LAS unsigned char* VTl = wl + 9216; MIX_LAS float* decl = (MIX_LAS float*)(wl + 14336);
    const int fcol = (DIR ? C_HFB : C_HFF) + h * 64 + lane, qcol = C_HQ + h * 64 + lane, vcol = C_HI + h * 64 + lane;
    bf16x8_t kfA[4], vfA[2][2];
#pragma unroll
    for (int sub = 0; sub < 2; ++sub) {
        constexpr int dummy = 0; (void)dummy;
        const int tile = DIR ? 1 - sub : sub;
        float a = 0.f; unsigned vw[16];
        {
            unsigned fr[32], qr[32], vr[32];
#pragma unroll
            for (int x = 0; x < 32; ++x) { const int ul = DIR ? 31 - x : x;
                const GAS bf16_t* p = U + (row0 + 32 * tile + ul) * NU; fr[x] = p[fcol]; qr[x] = p[qcol]; vr[x] = p[vcol]; }
            asm volatile("" ::: "memory");
#pragma unroll
            for (int pr = 0; pr < 16; ++pr) {
#pragma unroll
                for (int x = 0; x < 2; ++x) {
                    const int i = 2 * pr + x, ul = DIR ? 31 - i : i;
                    float f, g; hgrn_gate(__uint_as_float(fr[i] << 16), lb, f, g); a += g;
                    const float qa = __uint_as_float(qr[i] << 16) * __expf(a), ka = (1.f - f) * __expf(fminf(-a, 80.f));
                    *(MIX_LAS unsigned short*)(Ql + ul * 144 + lane * 2) = (unsigned short)(pkbf(qa, 0.f) & 0xffffu);
                    *(MIX_LAS unsigned short*)(Kl + ul * 144 + lane * 2) = (unsigned short)(pkbf(ka, 0.f) & 0xffffu);
                }
                const int ul_even = DIR ? 30 - 2 * pr : 2 * pr;
                const int pe = (ul_even & 0x13) | ((ul_even & 4) << 1) | ((ul_even & 8) >> 1);
                vw[pe >> 1] = DIR ? (vr[2 * pr + 1] | (vr[2 * pr] << 16)) : (vr[2 * pr] | (vr[2 * pr + 1] << 16));
            }
        }
        decl[sub * 64 + lane] = __expf(a);
#pragma unroll
        for (int g8 = 0; g8 < 4; ++g8) *(MIX_LAS u32x4h*)(VTl + lane * 80 + g8 * 16) = (u32x4h){vw[4 * g8], vw[4 * g8 + 1], vw[4 * g8 + 2], vw[4 * g8 + 3]};
        wave_lds_sync();
        bf16x8_t qf[4], kf[4], vf[2][2];
#pragma unroll
        for (int ds = 0; ds < 4; ++ds) { qf[ds] = *(const MIX_LAS bf16x8_t*)(Ql + r32 * 144 + ds * 32 + hi * 16); kf[ds] = *(const MIX_LAS bf16x8_t*)(Kl + r32 * 144 + ds * 32 + hi * 16); }
#pragma unroll
        for (int vt = 0; vt < 2; ++vt)
#pragma unroll
            for (int s = 0; s < 2; ++s) vf[vt][s] = *(const MIX_LAS bf16x8_t*)(VTl + (r32 + 32 * vt) * 80 + (16 * s + 8 * hi) * 2);
        f32x16_t P;
#pragma unroll
        for (int r = 0; r < 16; ++r) P[r] = 0.f;
#pragma unroll
        for (int ds = 0; ds < 4; ++ds) P = __builtin_amdgcn_mfma_f32_32x32x16_bf16(kf[ds], qf[ds], P, 0, 0, 0);
#pragma unroll
        for (int r = 0; r < 16; ++r) { const int s_ = crow_(r, hi); const bool keep = DIR ? (s_ >= r32) : (s_ <= r32); P[r] = keep ? P[r] : 0.f; }
        {
            u32x4h p0, p1;
            p0.x = pkbf(P[0], P[1]); p0.y = pkbf(P[2], P[3]); p0.z = pkbf(P[4], P[5]); p0.w = pkbf(P[6], P[7]);
            p1.x = pkbf(P[8], P[9]); p1.y = pkbf(P[10], P[11]); p1.z = pkbf(P[12], P[13]); p1.w = pkbf(P[14], P[15]);
            const bf16x8_t pf0 = __builtin_bit_cast(bf16x8_t, p0), pf1 = __builtin_bit_cast(bf16x8_t, p1);
#pragma unroll
            for (int vt = 0; vt < 2; ++vt) { O[vt][tile] = __builtin_amdgcn_mfma_f32_32x32x16_bf16(vf[vt][0], pf0, O[vt][tile], 0, 0, 0); O[vt][tile] = __builtin_amdgcn_mfma_f32_32x32x16_bf16(vf[vt][1], pf1, O[vt][tile], 0, 0, 0); }
        }
        if (sub == 0) {
#pragma unroll
            for (int vt = 0; vt < 2; ++vt)
#pragma unroll
                for (int ks = 0; ks < 4; ++ks) { const bf16x8_t sf = *(const GAS bf16x8_t*)(Sp + ((r32 + 32 * vt) * 64 + 16 * ks + 8 * hi) * 2);
                    O[vt][tile] = __builtin_amdgcn_mfma_f32_32x32x16_bf16(sf, qf[ks], O[vt][tile], 0, 0, 0); }
#pragma unroll
            for (int ds = 0; ds < 4; ++ds) kfA[ds] = kf[ds];
#pragma unroll
            for (int vt = 0; vt < 2; ++vt) { vfA[vt][0] = vf[vt][0]; vfA[vt][1] = vf[vt][1]; }
        } else {
            bf16x8_t qd[4];
#pragma unroll
            for (int ds = 0; ds < 4; ++ds) {
                const f32x4m d0 = *(const MIX_LAS f32x4m*)(decl + 16 * ds + 8 * hi), d1 = *(const MIX_LAS f32x4m*)(decl + 16 * ds + 8 * hi + 4);
                const u32x4h qw = __builtin_bit_cast(u32x4h, qf[ds]); u32x4h o;
                o.x = pkbf(__uint_as_float(qw.x << 16) * d0.x, __uint_as_float(qw.x & 0xffff0000u) * d0.y); o.y = pkbf(__uint_as_float(qw.y << 16) * d0.z, __uint_as_float(qw.y & 0xffff0000u) * d0.w);
                o.z = pkbf(__uint_as_float(qw.z << 16) * d1.x, __uint_as_float(qw.z & 0xffff0000u) * d1.y); o.w = pkbf(__uint_as_float(qw.w << 16) * d1.z, __uint_as_float(qw.w & 0xffff0000u) * d1.w);
                qd[ds] = __builtin_bit_cast(bf16x8_t, o);
            }
            f32x16_t P2;
#pragma unroll
            for (int r = 0; r < 16; ++r) P2[r] = 0.f;
#pragma unroll
            for (int ds = 0; ds < 4; ++ds) P2 = __builtin_amdgcn_mfma_f32_32x32x16_bf16(kfA[ds], qd[ds], P2, 0, 0, 0);
            u32x4h p0, p1;
            p0.x = pkbf(P2[0], P2[1]); p0.y = pkbf(P2[2], P2[3]); p0.z = pkbf(P2[4], P2[5]); p0.w = pkbf(P2[6], P2[7]);
            p1.x = pkbf(P2[8], P2[9]); p1.y = pkbf(P2[10], P2[11]); p1.z = pkbf(P2[12], P2[13]); p1.w = pkbf(P2[14], P2[15]);
            const bf16x8_t pf0 = __builtin_bit_cast(bf16x8_t, p0), pf1 = __builtin_bit_cast(bf16x8_t, p1);
#pragma unroll
            for (int vt = 0; vt < 2; ++vt) { O[vt][tile] = __builtin_amdgcn_mfma_f32_32x32x16_bf16(vfA[vt][0], pf0, O[vt][tile], 0, 0, 0); O[vt][tile] = __builtin_amdgcn_mfma_f32_32x32x16_bf16(vfA[vt][1], pf1, O[vt][tile], 0, 0, 0); }
#pragma unroll
            for (int vt = 0; vt < 2; ++vt)
#pragma unroll
                for (int ks = 0; ks < 4; ++ks) { const bf16x8_t sf = *(const GAS bf16x8_t*)(Sp + ((r32 + 32 * vt) * 64 + 16 * ks + 8 * hi) * 2);
                    O[vt][tile] = __builtin_amdgcn_mfma_f32_32x32x16_bf16(sf, qd[ks], O[vt][tile], 0, 0, 0); }
        }
        wave_lds_sync();
    }
}
__device__ __forceinline__ void hgrn_h3_item(int item, const GAS bf16_t* U, const GAS float* LBl, const GAS float* onorm, const GAS unsigned char* ST, GAS bf16_t* Y, MIX_LAS unsigned char* wl, int lane) {
    const int c = item & 63, h = (item >> 6) & 3, b = item >> 8;
    const int r32 = lane & 31, hi = lane >> 5;
    const size_t row0 = (size_t)b * NS + (size_t)c * 64;
    f32x16_t O[2][2];
#pragma unroll
    for (int a = 0; a < 2; ++a)
#pragma unroll
        for (int bb = 0; bb < 2; ++bb)
#pragma unroll
            for (int r = 0; r < 16; ++r) O[a][bb][r] = 0.f;
    const size_t s_f = ((size_t)((b * 4 + h) * 2 + 0) * 64 + c), s_b = ((size_t)((b * 4 + h) * 2 + 1) * 64 + (63 - c));
    hgrn_h3_dir<0>(O, U, row0, h, LBl[0 * 256 + h * 64 + lane], ST + s_f * 8192, wl, lane);
    hgrn_h3_dir<1>(O, U, row0, h, LBl[1 * 256 + h * 64 + lane], ST + s_b * 8192, wl, lane);
#pragma unroll
    for (int tile = 0; tile < 2; ++tile) {
        float ss = 0.f;
#pragma unroll
        for (int vt = 0; vt < 2; ++vt)
#pragma unroll
            for (int r = 0; r < 16; ++r) ss += O[vt][tile][r] * O[vt][tile][r];
        ss += __shfl_xor(ss, 32);
        const float rs = rsqrtf(ss * (1.f / 64.f) + EPSF);
        const size_t m = row0 + 32 * tile + r32;
#pragma unroll
        for (int vt = 0; vt < 2; ++vt)
#pragma unroll
            for (int g4 = 0; g4 < 4; ++g4) { const int v0 = 32 * vt + 8 * g4 + 4 * hi;
                const gu32x2 zw = *(const GAS gu32x2*)(U + m * NU + C_HZ + h * 64 + v0);
                const f32x4m on = *(const GAS f32x4m*)(onorm + v0);
                gu32x2 w;
                w.x = pkbf(O[vt][tile][4 * g4] * rs * on.x * siluf_(__uint_as_float(zw.x << 16)), O[vt][tile][4 * g4 + 1] * rs * on.y * siluf_(__uint_as_float(zw.x & 0xffff0000u)));
                w.y = pkbf(O[vt][tile][4 * g4 + 2] * rs * on.z * siluf_(__uint_as_float(zw.y << 16)), O[vt][tile][4 * g4 + 3] * rs * on.w * siluf_(__uint_as_float(zw.y & 0xffff0000u)));
                *(GAS gu32x2*)(Y + m * NY + h * 64 + v0) = w; }
    }
}
__global__ void __launch_bounds__(NWAVES * 64, 2) mk_fwd(Args a) {
    extern __shared__ __attribute__((aligned(16))) unsigned char lds_raw[];
    LAS unsigned char* lds = (LAS unsigned char*)lds_raw;
    volatile LAS unsigned* MISC = (volatile LAS unsigned*)(lds + MISC_OFF);
    const int tid = threadIdx.x, lane = tid & 63, wave = __builtin_amdgcn_readfirstlane(tid >> 6);
    const int G = gridDim.x; const int bx = blockIdx.x; const int vcu = (G % 8 == 0) ? (bx % 8) * (G / 8) + bx / 8 : bx;
    const int gw = vcu * NWAVES + wave, NGW = G * NWAVES;
    unsigned char* ws = a.ws;
    for (int u = tid; u < (LDS_BYTES - LDSCTL_OFF) / 4; u += NWAVES * 64) ((LAS unsigned*)(lds + LDSCTL_OFF))[u] = 0u;
    __syncthreads();
    XcdBarrier bar = xcd_barrier_post((unsigned*)(ws + WS_CTL) + CW_BAR + a.li * XCD_BAR_WORDS, MISC + 8);
    const int lo = a.ph_lo, hi = a.ph_hi;
#ifndef PROBE_DUP
#define PROBE_DUP -1
#endif
#ifndef PROBE_SUB
#define PROBE_SUB -1
#endif
#define REPS(k) ((PROBE_DUP == (k)) ? 2 : 1)
#define IN(k) (lo <= (k) && (k) < hi)
#define SEAM(k) do { if (IN(k) && IN((k) + 1)) { xcd_barrier(bar); if (PROBE_DUP == 200) xcd_barrier(bar); } } while (0)

#define DEFBUFS(wsp) bf16_t* const H = (bf16_t*)((wsp) + WS_H); bf16_t* const MG = (bf16_t*)((wsp) + WS_U + 160 * MiB); \
    bf16_t* const U = (bf16_t*)((wsp) + WS_U); bf16_t* const GB = (bf16_t*)((wsp) + WS_U); bf16_t* const OUTRAW = (bf16_t*)((wsp) + WS_U); \
    bf16_t* const Y = (bf16_t*)((wsp) + WS_Y); (void)H; (void)MG; (void)U; (void)GB; (void)OUTRAW; (void)Y;
    float* const X = a.out;

    if (IN(0)) for (int rep0 = 0; rep0 < (PROBE_DUP == 100 ? 2 : 1); ++rep0) {
        if (rep0) xcd_barrier(bar);
        DEFBUFS(ws)
        if (bx == 0) {
            float* LB = (float*)(ws + WS_LB); float* BIAS = (float*)(ws + WS_BIAS); const float* lb_logits = a.in[5]; const float* rel_bias = a.in[13];
            { float v[NL], mx = -1e30f, s = 0.f;
#pragma unroll
                for (int l = 0; l < NL; ++l) { v[l] = lb_logits[l * 512 + tid]; mx = fmaxf(mx, v[l]); }
#pragma unroll
                for (int l = 0; l < NL; ++l) { v[l] = __expf(v[l] - mx); s += v[l]; }
                float c = 0.f;
#pragma unroll
                for (int l = 0; l < NL; ++l) { if (l > 0) c += v[l] / s; LB[l * 512 + tid] = c; } }
            for (int i = tid; i < 4 * 257; i += NWAVES * 64) {
                const int h = i / 257, rel = i % 257 - 128; int n = -rel; const int ret = (n < 0) ? 16 : 0; n = n < 0 ? -n : n;
                int bucket;
                if (n < 8) bucket = n; else if (n < 12) bucket = 8; else if (n < 16) bucket = 9; else if (n < 23) bucket = 10; else if (n < 32) bucket = 11;
                else if (n < 46) bucket = 12; else if (n < 64) bucket = 13; else if (n < 91) bucket = 14; else bucket = 15;
                BIAS[i] = rel_bias[(ret + bucket) * 4 + h]; }
        }
        convert_weights(ws, a.in[4], a.in[16], a.in[17], a.in[18], 0, 3, lds, gw, NGW, wave, lane);
        {
            bf16_t* MEMN = (bf16_t*)(ws + WS_Y); bf16_t* WKV = (bf16_t*)(ws + WS_Y + 16 * MiB);
            for (int r = gw; r < NL * NB * MEML; r += NGW) { const int l = r / (NB * MEML), row = r - l * (NB * MEML);
                rms_row_to_bf16(a.in[1] + (size_t)row * ND, a.in[14] + l * ND, MEMN + (size_t)r * ND, lane); }
            LAS float* scr = (LAS float*)(lds + RING_OFF + wave * 16384);
            for (int it = gw; it < NL * 256; it += NGW) { const int l = it >> 8; transpose_item(a.in[15] + (size_t)l * ND * 512, ND, 512, WKV + (size_t)l * 512 * ND, scr, it & 255, lane); }
        }
        for (int m = gw; m < NM; m += NGW) rms_row_to_bf16(a.in[0] + (size_t)m * ND, a.in[2], H + (size_t)m * ND, lane);
        SEAM(0);
    }
    for (int l = 0; l < NL; ++l) {
        const int base = 1 + l * PH_PER_LAYER;
        unsigned char* wsl = ws; asm volatile("" : "+s"(wsl));
        DEFBUFS(wsl)
        if (IN(base + PH_A)) {
            pg8::Gemm g{H, (const bf16_t*)(wsl + WS_WIN), ND, ND, ND, 0u, 0u};
            pg8::TileOrder<1> S; S.init(NM, NU, G, bx);
            pg8::EpiStore E{(GAS bf16_t*)U, NU};
            for (int rep = 0; rep < REPS(PH_A); ++rep) { pg8::gemm_phase<pg8::EpiStore, pg8::TileOrder<1>, true>(lds + RING_OFF, g, S, E); if (rep + 1 < REPS(PH_A)) xcd_barrier(bar); }
            if (l == 0) {
                const int u = bx - 128;
                pg8::OneUnit S2; S2.valid = (u >= 0 && u < 64); S2.u.pz = (u >> 4) & 3; S2.u.pm = (u >> 1) & 7; S2.u.pn = u & 1;
                pg8::Gemm g2{(const bf16_t*)(wsl + WS_Y), (const bf16_t*)(wsl + WS_Y + 16 * MiB), ND, ND, ND, (unsigned)(NB * MEML * ND * 2), (unsigned)(512 * ND * 2)};
                pg8::EpiStoreZ E2{(GAS bf16_t*)(wsl + WS_MEMKV), 512, (size_t)NB * MEML * 512};
                pg8::gemm_phase<pg8::EpiStoreZ, pg8::OneUnit, true>(lds + RING_OFF, g2, S2, E2);
            }
            SEAM(base + PH_A);
        }
        if (IN(base + PH_M1)) {
            int tl = threadIdx.x; asm volatile("" : "+v"(tl));
            const float* cw = a.in[7]; const float* cb = a.in[8]; const float* cg = a.in[9]; const float* cbb = a.in[10]; const float* scw = a.in[11]; const float* snk = a.in[12];
            asm volatile("" : "+s"(cw), "+s"(cb), "+s"(cg), "+s"(cbb), "+s"(scw), "+s"(snk));
            const bf16_t* MKV = (const bf16_t*)(wsl + WS_MEMKV) + (size_t)l * NB * MEML * 512;
            const float* BIASp = (const float*)(wsl + WS_BIAS);
#define M1_WA for (int it = bx; it < 512; it += G) winattn_item(it, (const GAS bf16_t*)U, (const GAS float*)BIASp, (const GAS float*)(snk + l * 4), (GAS bf16_t*)Y, lds + RING_OFF, tl);
#define M1_MA for (int it = bx; it < 512; it += G) memattn_item(it, (const GAS bf16_t*)U, (const GAS bf16_t*)MKV, (GAS bf16_t*)Y, lds + RING_OFF, tl);
#define M1_CF for (int it = bx; it < 512; it += G) conformer_item(it, (const GAS bf16_t*)U, (const GAS float*)(cw + l * 31 * 256), (const GAS float*)(cb + l * 256), (const GAS float*)(cg + l * 256), (const GAS float*)(cbb + l * 256), (GAS bf16_t*)Y, lds + RING_OFF, tl);
#define M1_SC for (int it = bx; it < 512; it += G) shortconv_item(it, (const GAS bf16_t*)U, (const GAS float*)(scw + l * 3 * 256), (GAS bf16_t*)Y, tl);
#define M1_H1 { const float* LBl = (const float*)(wsl + WS_LB) + l * 512; unsigned char* ST = wsl + WS_ST; float* DC = (float*)(wsl + WS_ST + HG_ST_BYTES); \
                const int lane = tl & 63, wave = __builtin_amdgcn_readfirstlane(tl >> 6); \
                for (int it = bx * 8 + wave; it < 4096; it += G * 8) hgrn_h1_item(it, (const GAS bf16_t*)U, (const GAS float*)LBl, (GAS unsigned char*)ST, (GAS float*)DC, lds + RING_OFF + wave * H1_WLDS, lane); }
#if PROBE_DUP == 1 && PROBE_SUB == 10
            for (int it = bx; it < 512; it += G) winattn_item(it, (const GAS bf16_t*)U, (const GAS float*)BIASp, (const GAS float*)(snk + l * 4), (GAS bf16_t*)Y, lds + RING_OFF, tl, false);
#endif
            M1_WA
#if PROBE_DUP == 1 && PROBE_SUB == 0
            M1_WA
#endif
            M1_MA
#if PROBE_DUP == 1 && PROBE_SUB == 1
            M1_MA
#endif
            M1_CF
#if PROBE_DUP == 1 && PROBE_SUB == 2
            M1_CF
#endif
            M1_SC
#if PROBE_DUP == 1 && PROBE_SUB == 3
            M1_SC
#endif
            M1_H1
#if PROBE_DUP == 1 && PROBE_SUB == 4
            __syncthreads();
            M1_H1
#endif
            SEAM(base + PH_M1);
        }
        if (IN(base + PH_M2)) {
            int tl = threadIdx.x; asm volatile("" : "+v"(tl));
            unsigned char* ST = wsl + WS_ST; const float* DC = (const float*)(wsl + WS_ST + HG_ST_BYTES);
            for (int it = bx; it < 256; it += G) hgrn_h2_item(it, (GAS unsigned char*)ST, (const GAS float*)DC, tl);
            if (PROBE_DUP == PH_M2) {
                xcd_barrier(bar);
                const float* LBl = (const float*)(wsl + WS_LB) + l * 512; const int lane = tl & 63, wave = __builtin_amdgcn_readfirstlane(tl >> 6);
                for (int it = bx * 8 + wave; it < 4096; it += G * 8) hgrn_h1_item(it, (const GAS bf16_t*)U, (const GAS float*)LBl, (GAS unsigned char*)ST, (GAS float*)DC, lds + RING_OFF + wave * H1_WLDS, lane);
                xcd_barrier(bar);
                for (int it = bx; it < 256; it += G) hgrn_h2_item(it, (GAS unsigned char*)ST, (const GAS float*)DC, tl);
            }
            SEAM(base + PH_M2);
        }
        if (IN(base + PH_M3)) {
            int tl = threadIdx.x; asm volatile("" : "+v"(tl));
            const float* onp = a.in[6]; asm volatile("" : "+s"(onp));
            const float* LBl = (const float*)(wsl + WS_LB) + l * 512; const unsigned char* ST = wsl + WS_ST;
            const int lane = tl & 63, wave = __builtin_amdgcn_readfirstlane(tl >> 6);
            for (int rep = 0; rep < REPS(PH_M3); ++rep)
            for (int it = bx * 8 + wave; it < 2048; it += G * 8) hgrn_h3_item(it, (const GAS bf16_t*)U, (const GAS float*)LBl, (const GAS float*)(onp + l * 64), (const GAS unsigned char*)ST, (GAS bf16_t*)Y, lds + RING_OFF + wave * H3_WLDS, lane);
            SEAM(base + PH_M3);
        }
        if (IN(base + PH_G)) {
            GAS bf16_t* GS = (GAS bf16_t*)(wsl + WS_U) + (size_t)bx * (5 * pg8::GS_SLOT);
            for (int ti = 0; ti * G + bx < (NM / 256) * (ND / 256); ++ti) {
                { pg8::Gemm g{H, (const bf16_t*)(wsl + WS_WG), ND, ND, ND, 0u, (unsigned)(ND * ND * 2)};
                  pg8::TileRound<5> S; S.T.init(NM, ND, G, bx); S.ti = ti;
                  pg8::EpiGate E{GS};
                  pg8::gemm_phase<pg8::EpiGate, pg8::TileRound<5>, true>(lds + RING_OFF, g, S, E); }
                { pg8::Gemm g{Y, (const bf16_t*)(wsl + WS_WB), NY, NW, NW, (unsigned)(NW * 2), (unsigned)(ND * NW * 2)};
                  pg8::TileRound<5> S; S.T.init(NM, ND, G, bx); S.ti = ti;
                  pg8::EpiMerge E{GS, (GAS bf16_t*)MG};
                  pg8::gemm_phase<pg8::EpiMerge, pg8::TileRound<5>, true>(lds + RING_OFF, g, S, E); }
            }
        }
        if (IN(base + PH_C)) { SEAM(base + PH_C); }
        if (IN(base + PH_D)) {
            pg8::Gemm g{MG, (const bf16_t*)(wsl + WS_WO), ND, ND, ND, 0u, 0u};
            pg8::TileOrder<1> S; S.init(NM, ND, G, bx);
            pg8::EpiStore E{(GAS bf16_t*)OUTRAW, ND};
            for (int rep = 0; rep < REPS(PH_D); ++rep) { pg8::gemm_phase<pg8::EpiStore, pg8::TileOrder<1>, true>(lds + RING_OFF, g, S, E); if (rep + 1 < REPS(PH_D)) xcd_barrier(bar); }
            SEAM(base + PH_D);
        }
        if (IN(base + PH_T)) {
            int tl = threadIdx.x; asm volatile("" : "+v"(tl)); const int lane = tl & 63, wave = __builtin_amdgcn_readfirstlane(tl >> 6), gw = vcu * NWAVES + wave;
            const float* x0 = a.in[0]; const float* npre = a.in[2]; const float* npost = a.in[3]; float* Xl = X;
            const float* wi = a.in[4]; const float* wgt = a.in[16]; const float* wbr = a.in[17]; const float* wou = a.in[18];
            asm volatile("" : "+s"(x0), "+s"(npre), "+s"(npost), "+s"(Xl), "+s"(wi), "+s"(wgt), "+s"(wbr), "+s"(wou));
            const float* xin = (l == 0) ? x0 : Xl;
            const bool has_next = (l + 1 < NL);
            for (int rep = 0; rep < ((PROBE_DUP == PH_T && l == 0) ? 9 : 1); ++rep)
                post_rows(xin, OUTRAW, npost + l * ND, npre + (has_next ? l + 1 : l) * ND, Xl, H, has_next, gw, NGW, lane);
            if (has_next) { convert_weights(wsl, wi, wgt, wbr, wou, l + 1, 3, lds, gw, NGW, wave, lane); SEAM(base + PH_T); }
        }
    }
#undef IN
#undef SEAM
}

extern "C" void kernel_launch(void* const* d_in, const int* in_sizes, int n_in, void* d_out, int out_size, void* d_ws, size_t ws_size, hipStream_t stream) {
    static int grid = 0;
    if (grid == 0) {
        if (n_in != 19 || in_sizes[0] != NM * ND || out_size != NM * ND || ws_size < WS_END) {
            fprintf(stderr, "kernel_launch: unexpected shapes/workspace (n_in %d, in0 %d, out %d, ws %zu, need %zu)\n", n_in, n_in > 0 ? in_sizes[0] : -1, out_size, ws_size, (size_t)WS_END);
            grid = -1; return;
        }
        int dev = 0, cus = 0, per_cu = 0;
        if (hipGetDevice(&dev) != hipSuccess || hipDeviceGetAttribute(&cus, hipDeviceAttributeMultiprocessorCount, dev) != hipSuccess) { grid = -1; return; }
        if (hipFuncSetAttribute((const void*)mk_fwd, hipFuncAttributeMaxDynamicSharedMemorySize, LDS_BYTES) != hipSuccess) { fprintf(stderr, "kernel_launch: hipFuncSetAttribute failed\n"); grid = -1; return; }
        if (hipOccupancyMaxActiveBlocksPerMultiprocessor(&per_cu, (const void*)mk_fwd, NWAVES * 64, LDS_BYTES) != hipSuccess || per_cu < 1)
            fprintf(stderr, "kernel_launch: occupancy query reports %d workgroups per CU\n", per_cu);
        (void)hipGetLastError();
        grid = cus;
    }
    if (grid < 0) return;
    const float* x = (const float*)d_in[0]; const float* mem = (const float*)d_in[1];
    const float* lb_logits = (const float*)d_in[5]; const float* hg_onorm = (const float*)d_in[6];
    const float* conf_dw_w = (const float*)d_in[7]; const float* conf_dw_b = (const float*)d_in[8]; const float* conf_ln_g = (const float*)d_in[9]; const float* conf_ln_b = (const float*)d_in[10];
    const float* sc_w = (const float*)d_in[11]; const float* attn_sink = (const float*)d_in[12]; const float* rel_bias = (const float*)d_in[13];
    const float* mem_norm = (const float*)d_in[14]; const float* w_mem_kv = (const float*)d_in[15];
    unsigned char* ws = (unsigned char*)d_ws;
    float* LB = (float*)(ws + WS_LB); float* BIAS = (float*)(ws + WS_BIAS);
    bf16_t* MEMKV = (bf16_t*)(ws + WS_MEMKV); bf16_t* U = (bf16_t*)(ws + WS_U);
    bf16_t* Y = (bf16_t*)(ws + WS_Y); bf16_t* OHG = (bf16_t*)(ws + WS_ST);
    (void)x; (void)mem; (void)lb_logits; (void)rel_bias; (void)mem_norm; (void)w_mem_kv; (void)LB; (void)BIAS; (void)MEMKV; (void)hg_onorm; (void)U; (void)Y; (void)OHG; (void)conf_dw_w; (void)conf_dw_b; (void)conf_ln_g; (void)conf_ln_b; (void)sc_w; (void)attn_sink;

    if (hipMemsetAsync(ws + WS_CTL, 0, CTL_ZERO_BYTES, stream) != hipSuccess) return;
    Args a{};
    for (int i = 0; i < 19; ++i) a.in[i] = (const float*)d_in[i];
    a.out = (float*)d_out; a.ws = ws;
    int li = 0;
    auto launch = [&](int lo, int hi) {
        a.ph_lo = lo; a.ph_hi = hi; a.li = li++; a.pad = 0;
        hipLaunchKernelGGL(mk_fwd, dim3(grid), dim3(NWAVES * 64), LDS_BYTES, stream, a);
    };
    launch(0, PH_TOTAL);
}
```

```cpp
#include <hip/hip_runtime.h>
#include <cstdio>
#include <cstdint>
#include <cmath>

typedef unsigned short bf16_t;
__device__ __forceinline__ float shx_(float v, int o) {
    const int i = __float_as_int(v); int r;
    switch (o) {
        case 1:  r = __builtin_amdgcn_ds_swizzle(i, (1 << 10) | 0x1f); break;
        case 2:  r = __builtin_amdgcn_ds_swizzle(i, (2 << 10) | 0x1f); break;
        case 4:  r = __builtin_amdgcn_ds_swizzle(i, (4 << 10) | 0x1f); break;
        case 8:  r = __builtin_amdgcn_ds_swizzle(i, (8 << 10) | 0x1f); break;
        case 16: r = __builtin_amdgcn_ds_swizzle(i, (16 << 10) | 0x1f); break;
        default: { int l; asm volatile("v_mbcnt_lo_u32_b32 %0, -1, 0\n\tv_mbcnt_hi_u32_b32 %0, -1, %0" : "=v"(l)); r = __builtin_amdgcn_ds_bpermute((l ^ 32) << 2, i); } break;
    }
    return __int_as_float(r);
}
#define __shfl_xor(v, o) shx_((v), (o))
#define GAS __attribute__((address_space(1)))
typedef unsigned gu32x4 __attribute__((ext_vector_type(4)));
typedef unsigned gu32x2 __attribute__((ext_vector_type(2)));
typedef float gf32x4 __attribute__((ext_vector_type(4)));
typedef float gf32x2 __attribute__((ext_vector_type(2)));

constexpr int NB = 8, NS = 4096, ND = 1024, NL = 4, NM = NB * NS, NW = 256, NU = 4352, NY = 1280;
constexpr int NU_BF = 1024, NU_I8 = 4352 - 1024;
constexpr int MEML = 256;
constexpr float EPSF = 1e-6f;
constexpr int C_HQ = 0, C_HFF = 256, C_HFB = 512, C_HI = 768, C_HZ = 1024, C_CA = 1280, C_CB = 1536, C_CZ = 1792,
              C_SB = 2048, C_SC = 2304, C_SV = 2560, C_SZ = 2816, C_AQ = 3072, C_AK = 3328, C_AV = 3456, C_AZ = 3584,
              C_MQ = 3840, C_MZ = 4096;

constexpr size_t MiB = 1u << 20;
constexpr size_t WS_CTL = 0;
constexpr size_t CTL_ZERO_BYTES = 512 * 1024;
constexpr size_t WS_CQI = 344 * 1024;
constexpr int NQI = NU_I8;
constexpr size_t WS_LB = 640 * 1024;
constexpr size_t WS_BIAS = 704 * 1024;
constexpr size_t WS_CQ = 400 * 1024;
constexpr size_t WS_RQ = 896 * 1024;
constexpr size_t WS_RS = 768 * 1024;
constexpr size_t WS_MEMKV = 1 * MiB;
constexpr size_t WS_WIN = 9 * MiB;
constexpr size_t WS_WG8 = WS_WIN + 4352u * 1024 * 2;
constexpr size_t WS_WB = WS_WG8 + 5120u * 1024;
constexpr size_t WS_WO = WS_WB + 5120u * 256 * 2;
constexpr size_t WS_H = 27 * MiB;
constexpr size_t WS_U = 91 * MiB;
constexpr size_t WS_ST = 363 * MiB;
constexpr size_t WS_Y = 397 * MiB;
constexpr size_t WS_X8 = 477 * MiB;
constexpr size_t WS_END = 509 * MiB;
static_assert(WS_WO + 1024u * 1024 * 2 <= WS_H, "weights fit");

__device__ __forceinline__ float bf2f(bf16_t v) { return __uint_as_float((unsigned)v << 16); }
__device__ __forceinline__ bf16_t f2bf(float f) { unsigned u = __float_as_uint(f); return (bf16_t)((u + 0x7fffu + ((u >> 16) & 1u)) >> 16); }
__device__ __forceinline__ float sigmoidf_(float x) { return __builtin_amdgcn_rcpf(1.f + __expf(-x)); }
__device__ __forceinline__ float siluf_(float x) { return x * __builtin_amdgcn_rcpf(1.f + __expf(-x)); }

__global__ void n_prep(const float* lb_logits, const float* rel_bias, float* LB, float* BIAS) {
    const int tid = threadIdx.x;
    {
        float v[NL], mx = -1e30f, s = 0.f;
        for (int l = 0; l < NL; ++l) { v[l] = lb_logits[l * 512 + tid]; mx = fmaxf(mx, v[l]); }
        for (int l = 0; l < NL; ++l) { v[l] = __expf(v[l] - mx); s += v[l]; }
        float c = 0.f;
        for (int l = 0; l < NL; ++l) { if (l > 0) c += v[l] / s; LB[l * 512 + tid] = c; }
    }
    for (int i = tid; i < 4 * 257; i += blockDim.x) {
        const int h = i / 257, rel = i % 257 - 128;
        int n = -rel; int ret = (n < 0) ? 16 : 0; n = n < 0 ? -n : n;
        int bucket;
        if (n < 8) bucket = n;
        else {
            int large;
            if (n < 12) large = 8; else if (n < 16) large = 9; else if (n < 23) large = 10; else if (n < 32) large = 11;
            else if (n < 46) large = 12; else if (n < 64) large = 13; else if (n < 91) large = 14; else large = 15;
            bucket = large;
        }
        BIAS[i] = rel_bias[(ret + bucket) * 4 + h];
    }
}

__global__ void n_rmsnorm_rows(const float* x, const float* g, bf16_t* out, int rows) {
    const int wave = (blockIdx.x * blockDim.x + threadIdx.x) >> 6, lane = threadIdx.x & 63;
    if (wave >= rows) return;
    const float* xr = x + (size_t)wave * ND;
    float v[16], s = 0.f;
#pragma unroll
    for (int j = 0; j < 16; ++j) { v[j] = xr[lane + 64 * j]; s += v[j] * v[j]; }
#pragma unroll
    for (int o = 1; o < 64; o <<= 1) s += __shfl_xor(s, o);
    const float r = rsqrtf(s * (1.f / ND) + EPSF);
#pragma unroll
    for (int j = 0; j < 16; ++j) out[(size_t)wave * ND + lane + 64 * j] = f2bf(v[j] * r * g[lane + 64 * j]);
}

__global__ void n_memkv(const float* mem, const float* mem_norm, const float* w, bf16_t* out) {
    __shared__ float row[ND]; __shared__ float red[8];
    const int r = blockIdx.x, l = blockIdx.y, tid = threadIdx.x;
    float s = 0.f;
    for (int i = tid; i < ND; i += 512) { float v = mem[(size_t)r * ND + i]; row[i] = v; s += v * v; }
#pragma unroll
    for (int o = 1; o < 64; o <<= 1) s += __shfl_xor(s, o);
    if ((tid & 63) == 0) red[tid >> 6] = s;
    __syncthreads();
    float tot = 0.f; for (int i = 0; i < 8; ++i) tot += red[i];
    const float rs = rsqrtf(tot * (1.f / ND) + EPSF);
    const float* g = mem_norm + l * ND; const float* wl = w + (size_t)l * ND * 512;
    float acc = 0.f;
    for (int k = 0; k < ND; ++k) acc += row[k] * g[k] * wl[(size_t)k * 512 + tid];
    out[((size_t)l * (NB * MEML) + r) * 512 + tid] = f2bf(acc * rs);
}

__global__ __launch_bounds__(256) void n_gemm(const bf16_t* A, int lda, const float* Wt, int ldw, bf16_t* C, int ldc, int K) {
    __shared__ float As[16][132]; __shared__ float Bs[16][132];
    const int tid = threadIdx.x, tx = tid & 15, ty = tid >> 4;
    const int row0 = blockIdx.y * 128, col0 = blockIdx.x * 128;
    float acc[8][8];
#pragma unroll
    for (int i = 0; i < 8; ++i)
#pragma unroll
        for (int j = 0; j < 8; ++j) acc[i][j] = 0.f;
    for (int k0 = 0; k0 < K; k0 += 16) {
#pragma unroll
        for (int it = 0; it < 8; ++it) { const int i = tid + it * 256, r = i >> 4, k = i & 15; As[k][r] = bf2f(A[(size_t)(row0 + r) * lda + k0 + k]); }
#pragma unroll
        for (int it = 0; it < 8; ++it) { const int i = tid + it * 256, k = i >> 7, c = i & 127; Bs[k][c] = Wt[(size_t)(k0 + k) * ldw + col0 + c]; }
        __syncthreads();
#pragma unroll
        for (int k = 0; k < 16; ++k) {
            float a[8], b[8];
#pragma unroll
            for (int i = 0; i < 8; ++i) { a[i] = As[k][ty * 8 + i]; b[i] = Bs[k][tx * 8 + i]; }
#pragma unroll
            for (int i = 0; i < 8; ++i)
#pragma unroll
                for (int j = 0; j < 8; ++j) acc[i][j] += a[i] * b[j];
        }
        __syncthreads();
    }
#pragma unroll
    for (int i = 0; i < 8; ++i)
#pragma unroll
        for (int j = 0; j < 8; ++j) C[(size_t)(row0 + ty * 8 + i) * ldc + col0 + tx * 8 + j] = f2bf(acc[i][j]);
}

__global__ __launch_bounds__(256) void n_merge(const bf16_t* H, const bf16_t* Y, const float* Wg, const float* Wb, bf16_t* MG) {
    __shared__ float As[16][68]; __shared__ float Bs[16][68];
    const int tid = threadIdx.x, tx = tid & 15, ty = tid >> 4;
    const int row0 = blockIdx.y * 64, col0 = blockIdx.x * 64;
    float mg[4][4];
#pragma unroll
    for (int i = 0; i < 4; ++i)
#pragma unroll
        for (int j = 0; j < 4; ++j) mg[i][j] = 0.f;
    for (int n = 0; n < 5; ++n) {
        float ag[4][4], ab[4][4];
#pragma unroll
        for (int i = 0; i < 4; ++i)
#pragma unroll
            for (int j = 0; j < 4; ++j) { ag[i][j] = 0.f; ab[i][j] = 0.f; }
        const float* wg = Wg + (size_t)n * ND * ND;
        for (int k0 = 0; k0 < ND; k0 += 16) {
#pragma unroll
            for (int it = 0; it < 4; ++it) { const int i = tid + it * 256, r = i >> 4, k = i & 15; As[k][r] = bf2f(H[(size_t)(row0 + r) * ND + k0 + k]); }
#pragma unroll
            for (int it = 0; it < 4; ++it) { const int i = tid + it * 256, k = i >> 6, c = i & 63; Bs[k][c] = wg[(size_t)(k0 + k) * ND + col0 + c]; }
            __syncthreads();
#pragma unroll
            for (int k = 0; k < 16; ++k) {
                float a[4], b[4];
#pragma unroll
                for (int i = 0; i < 4; ++i) { a[i] = As[k][ty * 4 + i]; b[i] = Bs[k][tx * 4 + i]; }
#pragma unroll
                for (int i = 0; i < 4; ++i)
#pragma unroll
                    for (int j = 0; j < 4; ++j) ag[i][j] += a[i] * b[j];
            }
            __syncthreads();
        }
        const float* wb = Wb + (size_t)n * NW * ND;
        for (int k0 = 0; k0 < NW; k0 += 16) {
#pragma unroll
            for (int it = 0; it < 4; ++it) { const int i = tid + it * 256, r = i >> 4, k = i & 15; As[k][r] = bf2f(Y[(size_t)(row0 + r) * NY + n * NW + k0 + k]); }
#pragma unroll
            for (int it = 0; it < 4; ++it) { const int i = tid + it * 256, k = i >> 6, c = i & 63; Bs[k][c] = wb[(size_t)(k0 + k) * ND + col0 + c]; }
            __syncthreads();
#pragma unroll
            for (int k = 0; k < 16; ++k) {
                float a[4], b[4];
#pragma unroll
                for (int i = 0; i < 4; ++i) { a[i] = As[k][ty * 4 + i]; b[i] = Bs[k][tx * 4 + i]; }
#pragma unroll
                for (int i = 0; i < 4; ++i)
#pragma unroll
                    for (int j = 0; j < 4; ++j) ab[i][j] += a[i] * b[j];
            }
            __syncthreads();
        }
#pragma unroll
        for (int i = 0; i < 4; ++i)
#pragma unroll
            for (int j = 0; j < 4; ++j) mg[i][j] += sigmoidf_(ag[i][j]) * ab[i][j];
    }
#pragma unroll
    for (int i = 0; i < 4; ++i)
#pragma unroll
        for (int j = 0; j < 4; ++j) MG[(size_t)(row0 + ty * 4 + i) * ND + col0 + tx * 4 + j] = f2bf(mg[i][j]);
}

__global__ void n_shortconv(const bf16_t* U, const float* w  , bf16_t* Y) {
    const size_t idx = (size_t)blockIdx.x * blockDim.x + threadIdx.x;
    const int c = idx & 255; const int m = (int)(idx >> 8); const int t = m & (NS - 1);
    float conv = 0.f;
#pragma unroll
    for (int j = 0; j < 3; ++j) { const int tt = t + j - 1; if (tt >= 0 && tt < NS) { const size_t r = (size_t)(m + j - 1) * NU; conv += w[j * 256 + c] * bf2f(U[r + C_SC + c]) * bf2f(U[r + C_SV + c]); } }
    const size_t r = (size_t)m * NU;
    Y[(size_t)m * NY + 2 * NW + c] = f2bf(bf2f(U[r + C_SB + c]) * conv * siluf_(bf2f(U[r + C_SZ + c])));
}

__global__ void n_conformer(const bf16_t* U, const float* dw_w  , const float* dw_b, const float* ln_g, const float* ln_b, bf16_t* Y) {
    __shared__ float red[4];
    const int m = blockIdx.x, c = threadIdx.x, t = m & (NS - 1);
    float conv = dw_b[c];
    for (int j = 0; j < 31; ++j) { const int tt = t + j - 15; if (tt >= 0 && tt < NS) { const size_t r = (size_t)(m + j - 15) * NU; conv += dw_w[j * 256 + c] * bf2f(U[r + C_CA + c]) * sigmoidf_(bf2f(U[r + C_CB + c])); } }
    float s = conv;
#pragma unroll
    for (int o = 1; o < 64; o <<= 1) s += __shfl_xor(s, o);
    if ((c & 63) == 0) red[c >> 6] = s;
    __syncthreads();
    const float mu = (red[0] + red[1] + red[2] + red[3]) * (1.f / 256.f);
    __syncthreads();
    const float d = conv - mu; float q = d * d;
#pragma unroll
    for (int o = 1; o < 64; o <<= 1) q += __shfl_xor(q, o);
    if ((c & 63) == 0) red[c >> 6] = q;
    __syncthreads();
    const float var = (red[0] + red[1] + red[2] + red[3]) * (1.f / 256.f);
    const float n = d * rsqrtf(var + EPSF) * ln_g[c] + ln_b[c];
    Y[(size_t)m * NY + 1 * NW + c] = f2bf(siluf_(n) * siluf_(bf2f(U[(size_t)m * NU + C_CZ + c])));
}


__device__ __forceinline__ float dot64(const float (&q)[64], const bf16_t* kp) {
    float s = 0.f;
#pragma unroll
    for (int c = 0; c < 8; ++c) { const uint4 w = *(const uint4*)(kp + 8 * c); const unsigned ww[4] = {w.x, w.y, w.z, w.w};
#pragma unroll
        for (int e = 0; e < 4; ++e) { s += q[8 * c + 2 * e] * __uint_as_float(ww[e] << 16); s += q[8 * c + 2 * e + 1] * __uint_as_float(ww[e] & 0xffff0000u); } }
    return s;
}
__device__ __forceinline__ void axpy64(float (&acc)[64], float sc, float p, const bf16_t* vp) {
#pragma unroll
    for (int c = 0; c < 8; ++c) { const uint4 w = *(const uint4*)(vp + 8 * c); const unsigned ww[4] = {w.x, w.y, w.z, w.w};
#pragma unroll
        for (int e = 0; e < 4; ++e) { acc[8 * c + 2 * e] = acc[8 * c + 2 * e] * sc + p * __uint_as_float(ww[e] << 16); acc[8 * c + 2 * e + 1] = acc[8 * c + 2 * e + 1] * sc + p * __uint_as_float(ww[e] & 0xffff0000u); } }
}
__global__ __launch_bounds__(64) void n_winattn(const bf16_t* U, const float* BIAS, const float* sink, bf16_t* Y) {
    const int idx = blockIdx.x * blockDim.x + threadIdx.x;
    const int m = idx, h = blockIdx.y, t = m & (NS - 1), kvh = h >> 1;
    float q[64], acc[64];
    const bf16_t* qp = U + (size_t)m * NU + C_AQ + h * 64;
#pragma unroll
    for (int d = 0; d < 64; ++d) { q[d] = bf2f(qp[d]) * 0.125f; acc[d] = 0.f; }
    float mx = sink[h], l = 1.f;
    const int j0 = (t - 128 < 0) ? 0 : t - 128, j1 = (t + 128 > NS - 1) ? NS - 1 : t + 128;
    const float* bias = BIAS + h * 257;
    for (int j = j0; j <= j1; ++j) {
        const bf16_t* kp = U + (size_t)(m - t + j) * NU + C_AK + kvh * 64;
        const bf16_t* vp = U + (size_t)(m - t + j) * NU + C_AV + kvh * 64;
        float s = dot64(q, kp);
        s += bias[j - t + 128];
        const float nm = fmaxf(mx, s), sc = __expf(mx - nm), p = __expf(s - nm);
        l = l * sc + p; mx = nm;
        axpy64(acc, sc, p, vp);
    }
    const float inv = 1.f / l;
    const bf16_t* zp = U + (size_t)m * NU + C_AZ + h * 64;
    bf16_t* yp = Y + (size_t)m * NY + 3 * NW + h * 64;
#pragma unroll
    for (int d = 0; d < 64; ++d) yp[d] = f2bf(acc[d] * inv * siluf_(bf2f(zp[d])));
}

__global__ __launch_bounds__(64) void n_memattn(const bf16_t* U, const bf16_t* MKV  , bf16_t* Y) {
    const int m = blockIdx.x * blockDim.x + threadIdx.x, h = blockIdx.y, b = m / NS;
    float q[64], acc[64];
    const bf16_t* qp = U + (size_t)m * NU + C_MQ + h * 64;
#pragma unroll
    for (int d = 0; d < 64; ++d) { q[d] = bf2f(qp[d]) * 0.125f; acc[d] = 0.f; }
    float mx = -1e30f, l = 0.f;
    for (int j = 0; j < MEML; ++j) {
        const bf16_t* kp = MKV + (size_t)(b * MEML + j) * 512 + h * 64;
        const bf16_t* vp = kp + 256;
        const float s = dot64(q, kp);
        const float nm = fmaxf(mx, s), sc = __expf(mx - nm), p = __expf(s - nm);
        l = l * sc + p; mx = nm;
        axpy64(acc, sc, p, vp);
    }
    const float inv = 1.f / l;
    const bf16_t* zp = U + (size_t)m * NU + C_MZ + h * 64;
    bf16_t* yp = Y + (size_t)m * NY + 4 * NW + h * 64;
#pragma unroll
    for (int d = 0; d < 64; ++d) yp[d] = f2bf(acc[d] * inv * siluf_(bf2f(zp[d])));
}

__global__ __launch_bounds__(1024) void n_hgrn_scan(const bf16_t* U, const float* LBl  , bf16_t* OHG  ) {
    __shared__ float sq[64], sf[64], sk[64], sv[64]; __shared__ float red[16][64];
    const int b = blockIdx.x >> 3, h = (blockIdx.x >> 1) & 3, dir = blockIdx.x & 1;
    const int tid = threadIdx.x, v = tid & 63, kg = tid >> 6;
    float S[4] = {0.f, 0.f, 0.f, 0.f};
    const float lb = (tid < 64) ? LBl[dir * 256 + h * 64 + tid] : 0.f;
    for (int step = 0; step < NS; ++step) {
        const int t = dir ? (NS - 1 - step) : step;
        const size_t r = ((size_t)b * NS + t) * NU;
        if (tid < 64) {
            const float fl = bf2f(U[r + (dir ? C_HFB : C_HFF) + h * 64 + tid]);
            const float f = lb + (1.f - lb) * sigmoidf_(fl);
            sf[tid] = f; sk[tid] = 1.f - f;
            sq[tid] = bf2f(U[r + C_HQ + h * 64 + tid]);
            sv[tid] = bf2f(U[r + C_HI + h * 64 + tid]);
        }
        __syncthreads();
        const float vv = sv[v]; float part = 0.f;
#pragma unroll
        for (int j = 0; j < 4; ++j) { const int k = kg * 4 + j; S[j] = sf[k] * S[j] + sk[k] * vv; part += sq[k] * S[j]; }
        red[kg][v] = part;
        __syncthreads();
        if (tid < 64) { float o = 0.f;
#pragma unroll
            for (int g = 0; g < 16; ++g) o += red[g][tid];
            OHG[((size_t)dir * NM + (size_t)b * NS + t) * 256 + h * 64 + tid] = f2bf(o); }
    }
}
__global__ void n_hgrn_out(const bf16_t* OHG, const bf16_t* U, const float* onorm  , bf16_t* Y) {
    const int wave = (blockIdx.x * blockDim.x + threadIdx.x) >> 6, lane = threadIdx.x & 63;
    const int m = wave >> 2, h = wave & 3;
    const float o = bf2f(OHG[(size_t)m * 256 + h * 64 + lane]) + bf2f(OHG[((size_t)NM + m) * 256 + h * 64 + lane]);
    float s = o * o;
#pragma unroll
    for (int k = 1; k < 64; k <<= 1) s += __shfl_xor(s, k);
    const float y = o * rsqrtf(s * (1.f / 64.f) + EPSF) * onorm[lane];
    Y[(size_t)m * NY + h * 64 + lane] = f2bf(y * siluf_(bf2f(U[(size_t)m * NU + C_HZ + h * 64 + lane])));
}

__global__ void n_post(const float* xin, const bf16_t* outraw, const float* g_post, const float* g_next, float* xout, bf16_t* H, int has_next) {
    const int wave = (blockIdx.x * blockDim.x + threadIdx.x) >> 6, lane = threadIdx.x & 63;
    const size_t base = (size_t)wave * ND;
    float o[16], s = 0.f;
#pragma unroll
    for (int j = 0; j < 16; ++j) { o[j] = bf2f(outraw[base + lane + 64 * j]); s += o[j] * o[j]; }
#pragma unroll
    for (int k = 1; k < 64; k <<= 1) s += __shfl_xor(s, k);
    const float r = rsqrtf(s * (1.f / ND) + EPSF);
    float s2 = 0.f;
#pragma unroll
    for (int j = 0; j < 16; ++j) { o[j] = xin[base + lane + 64 * j] + o[j] * r * g_post[lane + 64 * j]; s2 += o[j] * o[j]; xout[base + lane + 64 * j] = o[j]; }
    if (has_next) {
#pragma unroll
        for (int k = 1; k < 64; k <<= 1) s2 += __shfl_xor(s2, k);
        const float r2 = rsqrtf(s2 * (1.f / ND) + EPSF);
#pragma unroll
        for (int j = 0; j < 16; ++j) H[base + lane + 64 * j] = f2bf(o[j] * r2 * g_next[lane + 64 * j]);
    }
}


__device__ __forceinline__ int lane_id_() { int l; asm volatile("v_mbcnt_lo_u32_b32 %0, -1, 0\n\tv_mbcnt_hi_u32_b32 %0, -1, %0" : "=v"(l)); return l; }
#define TID_() (wave_u * 64 + lane_id_())
#ifndef DBG_CQ
#define DBG_CQ 0
#endif
namespace pg8 {
#define PG8_LAS __attribute__((address_space(3)))
typedef short bf16x8 __attribute__((ext_vector_type(8)));
typedef float f32x4 __attribute__((ext_vector_type(4)));
typedef unsigned u32x4 __attribute__((ext_vector_type(4)));
constexpr int BM = 256, BK = 64, HALF = 128, HTB = HALF * BK * 2  , STAGE_BYTES = 8 * HTB, NXCD = 8, WGM = 8;

__host__ __device__ __forceinline__ int lds_byte(int r, int c) { const int st = (r >> 4) * 2 + (c >> 5), rr = r & 15, cc = c & 31, ob = rr * 64 + cc * 2; return st * 1024 + (ob ^ (((ob >> 9) & 1) << 5)); }
__host__ __device__ __forceinline__ void stage_rc(int b, int& R, int& C) { const int st = b / 1024, sb = b % 1024, swz = sb ^ (((sb >> 9) & 1) << 5); R = (st >> 1) * 16 + swz / 64; C = (st & 1) * 32 + (swz % 64) / 2; }
__host__ __device__ __forceinline__ int perm32(int rho) { const int n = rho >> 4, i = rho & 15; return 8 * (i >> 2) + 4 * n + (i & 3); }

struct Unit { int pm, pn, pz; };
struct Gemm { const bf16_t* A; const bf16_t* Bt; int lda, ldb, K; unsigned zA, zB; };

template <int NZ> struct TileOrder {
    int nM, nN, nwg, G, c;
    __device__ void init(int M, int N, int G_, int c_) { nM = M / BM; nN = N / BM; nwg = nM * nN; G = G_; c = c_; }
    __device__ bool next(int i, Unit& u) const {
        const int ti = i / NZ; u.pz = i - ti * NZ;
        const long L = (long)ti * G + c; if (L >= nwg) return false;
        int wgid = (int)L; { const int q = nwg / NXCD, r = nwg % NXCD, xcd = wgid % NXCD, off = wgid / NXCD; wgid = (xcd < r ? xcd * (q + 1) : r * (q + 1) + (xcd - r) * q) + off; }
        const int nig = WGM * nN, gid = wgid / nig, fm = gid * WGM, gsz = (nM - fm) < WGM ? (nM - fm) : WGM;
        u.pm = fm + ((wgid % nig) % gsz); u.pn = (wgid % nig) / gsz; return true;
    }
};

template <int NZ> struct TileRound {
    TileOrder<NZ> T; int ti;
    __device__ bool next(int i, Unit& u) const { if (i >= NZ) return false; return T.next(ti * NZ + i, u); }
};
__device__ __forceinline__ unsigned cvt_pk_bf16(float lo, float hi) { unsigned r; asm volatile("v_cvt_pk_bf16_f32 %0, %1, %2" : "=v"(r) : "v"(lo), "v"(hi)); return r; }
__device__ __forceinline__ float bflo(unsigned w) { return __uint_as_float(w << 16); }
__device__ __forceinline__ float bfhi(unsigned w) { return __uint_as_float(w & 0xffff0000u); }

constexpr int SCL_OFF = 139264;
struct EpiStore {
    static constexpr bool PERM = true, CHAINED = false; static constexpr int NSCL = 1;
    GAS bf16_t* O; int ldc; const GAS float* rs;
    __device__ __forceinline__ const GAS float* rowp(const Unit& u) const { return rs + u.pm * BM; }
    __device__ __forceinline__ const GAS float* colp(const Unit& u) const { return rs; }
    __device__ __forceinline__ void operator()(f32x4 (&acc)[2][2][4][2], const Unit& u, int wr, int wc, int fr, int fq, const PG8_LAS float* scl) const {
        const int row0 = u.pm * BM + wr * 64 + fr, col0 = u.pn * BM + wc * 32 + 8 * fq;
#pragma unroll
        for (int ai = 0; ai < 2; ++ai)
#pragma unroll
            for (int m = 0; m < 4; ++m) { GAS bf16_t* rowp = O + (size_t)(row0 + ai * HALF + m * 16) * ldc + col0;
                const float sc = scl[wr * 64 + fr + ai * HALF + m * 16];
#pragma unroll
                for (int bj = 0; bj < 2; ++bj) { const f32x4 v0 = acc[ai][bj][m][0] * sc, v1 = acc[ai][bj][m][1] * sc;
                    u32x4 w; w.x = cvt_pk_bf16(v0[0], v0[1]); w.y = cvt_pk_bf16(v0[2], v0[3]); w.z = cvt_pk_bf16(v1[0], v1[1]); w.w = cvt_pk_bf16(v1[2], v1[3]);
                    *(GAS u32x4*)(rowp + bj * HALF) = w; } }
    }
};
constexpr int GS_LD = 256, GS_SLOT = 256 * 256, GS_SLOT8 = 65536;
struct EpiGate {
    static constexpr bool PERM = true, CHAINED = false; static constexpr int NSCL = 2;
    GAS bf16_t* GS; const GAS float* rq; const GAS float* cq;
    __device__ __forceinline__ const GAS float* rowp(const Unit& u) const { return rq + u.pm * BM; }
    __device__ __forceinline__ const GAS float* colp(const Unit& u) const { return cq + u.pz * 1024 + u.pn * BM; }
    __device__ __forceinline__ void operator()(f32x4 (&acc)[2][2][4][2], const Unit& u, int wr, int wc, int fr, int fq, const PG8_LAS float* scl) const {
        const int n = u.pz;
        f32x4 cs[2][2];
        { const PG8_LAS f32x4* cp = (const PG8_LAS f32x4*)(scl + 256 + wc * 32 + 8 * fq);
#pragma unroll
          for (int bj = 0; bj < 2; ++bj) { cs[bj][0] = cp[bj * (HALF / 4)] * (-1.4426950408889634f / 127.f); cs[bj][1] = cp[bj * (HALF / 4) + 1] * (-1.4426950408889634f / 127.f); } }
        GAS unsigned char* base = (GAS unsigned char*)GS + (size_t)n * GS_SLOT8 + (wr * 4 + wc) * 1024 + (fq * 16 + fr) * 16;
#pragma unroll
        for (int ai = 0; ai < 2; ++ai)
#pragma unroll
            for (int m = 0; m < 4; ++m) { const float rsc = scl[wr * 64 + fr + ai * HALF + m * 16];
                unsigned w[4];
#pragma unroll
                for (int bj = 0; bj < 2; ++bj) {
                    f32x4 x0, x1;
#pragma unroll
                    for (int j = 0; j < 4; ++j) { x0[j] = (float)__float_as_int(acc[ai][bj][m][0][j]); x1[j] = (float)__float_as_int(acc[ai][bj][m][1][j]); }
                    x0 = x0 * (cs[bj][0] * rsc); x1 = x1 * (cs[bj][1] * rsc);
                    unsigned b0[4], b1[4];
#pragma unroll
                    for (int j = 0; j < 4; ++j) { x0[j] = __builtin_amdgcn_exp2f(fminf(x0[j], 15.9f)); x1[j] = __builtin_amdgcn_exp2f(fminf(x1[j], 15.9f)); }
                    x0 = x0 + 1.f; x1 = x1 + 1.f;
#pragma unroll
                    for (int j = 0; j < 4; ++j) { x0[j] = __builtin_amdgcn_rsqf(x0[j]); x1[j] = __builtin_amdgcn_rsqf(x1[j]); }
                    x0 = x0 * 255.f + 12582912.f; x1 = x1 * 255.f + 12582912.f;
#pragma unroll
                    for (int j = 0; j < 4; ++j) { b0[j] = __float_as_uint(x0[j]); b1[j] = __float_as_uint(x1[j]); }
                    w[2 * bj]     = __builtin_amdgcn_perm(__builtin_amdgcn_perm(b0[3], b0[2], 0x0c0c0400u), __builtin_amdgcn_perm(b0[1], b0[0], 0x0c0c0400u), 0x05040100u);
                    w[2 * bj + 1] = __builtin_amdgcn_perm(__builtin_amdgcn_perm(b1[3], b1[2], 0x0c0c0400u), __builtin_amdgcn_perm(b1[1], b1[0], 0x0c0c0400u), 0x05040100u);
                }
                *(GAS u32x4*)(base + (ai * 4 + m) * 8192) = (u32x4){w[0], w[1], w[2], w[3]};
            }
    }
};
struct EpiStoreQ {
    static constexpr bool PERM = true, CHAINED = false; static constexpr int NSCL = 2;
    GAS bf16_t* O; int ldc; const GAS float* rq; const GAS float* cq;
    __device__ __forceinline__ const GAS float* rowp(const Unit& u) const { return rq + u.pm * BM; }
    __device__ __forceinline__ const GAS float* colp(const Unit& u) const { return cq + u.pn * BM; }
    __device__ __forceinline__ void operator()(f32x4 (&acc)[2][2][4][2], const Unit& u, int wr, int wc, int fr, int fq, const PG8_LAS float* scl) const {
        const int row0 = u.pm * BM + wr * 64 + fr, col0 = u.pn * BM + wc * 32 + 8 * fq;
        f32x4 cs[2][2];
        { const PG8_LAS f32x4* cp = (const PG8_LAS f32x4*)(scl + 256 + wc * 32 + 8 * fq);
#pragma unroll
          for (int bj = 0; bj < 2; ++bj) { cs[bj][0] = cp[bj * (HALF / 4)] * (1.f / 127.f); cs[bj][1] = cp[bj * (HALF / 4) + 1] * (1.f / 127.f); } }
#pragma unroll
        for (int ai = 0; ai < 2; ++ai)
#pragma unroll
            for (int m = 0; m < 4; ++m) { GAS bf16_t* rowp_ = O + (size_t)(row0 + ai * HALF + m * 16) * ldc + col0;
                const float rsc = scl[wr * 64 + fr + ai * HALF + m * 16];
#pragma unroll
                for (int bj = 0; bj < 2; ++bj) {
                    f32x4 x0, x1;
#pragma unroll
                    for (int j = 0; j < 4; ++j) { x0[j] = (float)__float_as_int(acc[ai][bj][m][0][j]); x1[j] = (float)__float_as_int(acc[ai][bj][m][1][j]); }
                    x0 = x0 * (cs[bj][0] * rsc); x1 = x1 * (cs[bj][1] * rsc);
                    u32x4 w; w.x = cvt_pk_bf16(x0[0], x0[1]); w.y = cvt_pk_bf16(x0[2], x0[3]); w.z = cvt_pk_bf16(x1[0], x1[1]); w.w = cvt_pk_bf16(x1[2], x1[3]);
                    *(GAS u32x4*)(rowp_ + bj * HALF) = w; } }
    }
};
struct EpiMerge {
    static constexpr bool PERM = true, CHAINED = true; static constexpr int NSCL = 0;
    __device__ __forceinline__ const GAS float* rowp(const Unit&) const { return nullptr; }
    __device__ __forceinline__ const GAS float* colp(const Unit&) const { return nullptr; }
    const GAS bf16_t* GS; GAS bf16_t* MG;
    __device__ __forceinline__ void operator()(f32x4 (&acc)[2][2][4][2], const Unit& u, int wr, int wc, int fr, int fq, const PG8_LAS float*) const {
        const int row0 = u.pm * BM + wr * 64 + fr, col0 = u.pn * BM + wc * 32 + 8 * fq, n = u.pz;
        const GAS unsigned char* base = (const GAS unsigned char*)GS + (size_t)n * GS_SLOT8 + (wr * 4 + wc) * 1024 + (fq * 16 + fr) * 16;
        u32x4 pa_[2][4], pb_[2][4];
#pragma unroll
        for (int ai = 0; ai < 2; ++ai) {
            const GAS unsigned char* q0 = base + (ai * 4) * 8192; const GAS unsigned char* q1 = q0 + 8192; const GAS unsigned char* q2 = q0 + 16384; const GAS unsigned char* q3 = q0 + 24576;
            asm volatile("global_load_dwordx4 %0, %4, off sc1\n\tglobal_load_dwordx4 %1, %5, off sc1\n\tglobal_load_dwordx4 %2, %6, off sc1\n\tglobal_load_dwordx4 %3, %7, off sc1"
                         : "=&v"(pa_[ai][0]), "=&v"(pa_[ai][1]), "=&v"(pa_[ai][2]), "=&v"(pa_[ai][3]) : "v"(q0), "v"(q1), "v"(q2), "v"(q3) : "memory");
            if (n < 4) { const GAS unsigned char* r0 = q0 + GS_SLOT8; const GAS unsigned char* r1 = r0 + 8192; const GAS unsigned char* r2 = r0 + 16384; const GAS unsigned char* r3 = r0 + 24576;
                asm volatile("global_load_dwordx4 %0, %4, off sc1\n\tglobal_load_dwordx4 %1, %5, off sc1\n\tglobal_load_dwordx4 %2, %6, off sc1\n\tglobal_load_dwordx4 %3, %7, off sc1"
                             : "=&v"(pb_[ai][0]), "=&v"(pb_[ai][1]), "=&v"(pb_[ai][2]), "=&v"(pb_[ai][3]) : "v"(r0), "v"(r1), "v"(r2), "v"(r3) : "memory"); }
        }
        asm volatile("s_waitcnt vmcnt(0)" ::: "memory");
#pragma unroll
        for (int ai = 0; ai < 2; ++ai) {
            u32x4 (&pa)[4] = pa_[ai]; u32x4 (&pb)[4] = pb_[ai];
#pragma unroll
            for (int mm = 0; mm < 4; ++mm) { const size_t row = (size_t)(row0 + ai * HALF + mm * 16);
#pragma unroll
                for (int bj = 0; bj < 2; ++bj) {
                    float f[8];
#pragma unroll
                    for (int k = 0; k < 2; ++k) { const unsigned qa = pa[mm][2 * bj + k];
#pragma unroll
                        for (int j = 0; j < 4; ++j) f[4 * k + j] = (float)((qa >> (8 * j)) & 0xffu); }
                    if (n < 4) {
#pragma unroll
                        for (int k = 0; k < 2; ++k) { const unsigned qb = pb[mm][2 * bj + k];
#pragma unroll
                            for (int j = 0; j < 4; ++j) f[4 * k + j] *= __builtin_amdgcn_rcpf((float)((qb >> (8 * j)) & 0xffu)); }
                    } else {
#pragma unroll
                        for (int j = 0; j < 8; ++j) f[j] *= (1.f / 255.f);
                    }
                    f32x4 v0 = acc[ai][bj][mm][0], v1 = acc[ai][bj][mm][1];
                    v0[0] *= f[0] * f[0]; v0[1] *= f[1] * f[1]; v0[2] *= f[2] * f[2]; v0[3] *= f[3] * f[3]; v1[0] *= f[4] * f[4]; v1[1] *= f[5] * f[5]; v1[2] *= f[6] * f[6]; v1[3] *= f[7] * f[7];
                    acc[ai][bj][mm][0] = v0; acc[ai][bj][mm][1] = v1;
                    if (n == 4) { u32x4 w; w.x = cvt_pk_bf16(v0[0], v0[1]); w.y = cvt_pk_bf16(v0[2], v0[3]); w.z = cvt_pk_bf16(v1[0], v1[1]); w.w = cvt_pk_bf16(v1[2], v1[3]);
                        *(GAS u32x4*)(MG + row * 1024 + col0 + bj * HALF) = w; }
                } }
        }
    }
};
struct EpiStoreZ {
    static constexpr bool PERM = true, CHAINED = false; static constexpr int NSCL = 0;
    __device__ __forceinline__ const GAS float* rowp(const Unit&) const { return nullptr; }
    __device__ __forceinline__ const GAS float* colp(const Unit&) const { return nullptr; }
    GAS bf16_t* O; int ldc; size_t zO;
    __device__ __forceinline__ void operator()(f32x4 (&acc)[2][2][4][2], const Unit& u, int wr, int wc, int fr, int fq, const PG8_LAS float*) const {
        const int row0 = u.pm * BM + wr * 64 + fr, col0 = u.pn * BM + wc * 32 + 8 * fq; GAS bf16_t* Ob = O + (size_t)u.pz * zO;
#pragma unroll
        for (int ai = 0; ai < 2; ++ai)
#pragma unroll
            for (int m = 0; m < 4; ++m) { GAS bf16_t* rowp = Ob + (size_t)(row0 + ai * HALF + m * 16) * ldc + col0;
#pragma unroll
                for (int bj = 0; bj < 2; ++bj) { const f32x4 v0 = acc[ai][bj][m][0], v1 = acc[ai][bj][m][1];
                    u32x4 w; w.x = cvt_pk_bf16(v0[0], v0[1]); w.y = cvt_pk_bf16(v0[2], v0[3]); w.z = cvt_pk_bf16(v1[0], v1[1]); w.w = cvt_pk_bf16(v1[2], v1[3]);
                    *(GAS u32x4*)(rowp + bj * HALF) = w; } }
    }
};
struct OneUnit { Unit u; bool valid; __device__ bool next(int i, Unit& o) const { if (i == 0 && valid) { o = u; return true; } return false; } };

template <class Epi, class Sched, bool ALIGN_EPI, bool I8 = false>
__device__ __forceinline__ void gemm_phase(PG8_LAS unsigned char* lds, const Gemm g, const Sched& S, const Epi& E, int wave_u) {
    int tid_ = wave_u * 64 + lane_id_(); asm volatile("" : "+v"(tid_));
    const int tid = tid_, wid = __builtin_amdgcn_readfirstlane(tid >> 6), lane = tid & 63, wr = wid >> 2, wc = wid & 3, fr = lane & 15, fq = lane >> 4;
    const int nt = g.K / BK;
    unsigned voffA[2], voffB[2];
#pragma unroll
    for (int i = 0; i < 2; ++i) { int R, C; stage_rc(tid * 16 + i * 8192, R, C); const int Rb = Epi::PERM ? ((R & ~31) + perm32(R & 31)) : R;
        voffA[i] = (unsigned)(R * g.lda + C) * 2u; voffB[i] = (unsigned)(Rb * g.ldb + C) * 2u; }
    const size_t kstep = (size_t)(BK * 2);
    const size_t hstepA = (size_t)HALF * g.lda * 2, tstepA = 2 * hstepA, hstepB = (size_t)HALF * g.ldb * 2, tstepB = 2 * hstepB;
    const unsigned ldsw = (unsigned)wid * 1024u;
    const int aoff = lds_byte(wr * 64 + fr, fq * 8), boff = lds_byte(wc * 32 + fr, fq * 8);
#define PG8_SA(b, h) (((b) * 2 + (h)) * HTB)
#define PG8_SB(b, h) ((4 + (b) * 2 + (h)) * HTB)
#define PG8_STAGE(bufoff, gbase, voff) do { _Pragma("unroll") for (int _i = 0; _i < 2; ++_i) \
        __builtin_amdgcn_global_load_lds((const unsigned*)((const char*)(gbase) + (voff)[_i]), (PG8_LAS unsigned*)(lds + (bufoff) + ldsw + _i * 8192), 16, 0, 0); } while (0)
#define PG8_LDA(dst, b, h) do { _Pragma("unroll") for (int m = 0; m < 4; ++m) _Pragma("unroll") for (int k = 0; k < 2; ++k) dst[m][k] = *(const PG8_LAS bf16x8*)(lds + PG8_SA(b, h) + aoff + m * 2048 + k * 1024); } while (0)
#define PG8_LDB(dst, b, h) do { _Pragma("unroll") for (int n = 0; n < 2; ++n) _Pragma("unroll") for (int k = 0; k < 2; ++k) dst[n][k] = *(const PG8_LAS bf16x8*)(lds + PG8_SB(b, h) + boff + n * 2048 + k * 1024); } while (0)
    typedef int i32x4_ __attribute__((ext_vector_type(4)));
#define PG8_MMA(ai, bj, At, Bt) do { __builtin_amdgcn_s_setprio(1); _Pragma("unroll") for (int m = 0; m < 4; ++m) _Pragma("unroll") for (int n = 0; n < 2; ++n) _Pragma("unroll") for (int k = 0; k < 2; ++k) { \
        if constexpr (I8) acc[ai][bj][m][n] = __builtin_bit_cast(f32x4, __builtin_amdgcn_mfma_i32_16x16x64_i8(__builtin_bit_cast(i32x4_, Bt[n][k]), __builtin_bit_cast(i32x4_, At[m][k]), __builtin_bit_cast(i32x4_, acc[ai][bj][m][n]), 0, 0, 0)); \
        else acc[ai][bj][m][n] = __builtin_amdgcn_mfma_f32_16x16x32_bf16(Bt[n][k], At[m][k], acc[ai][bj][m][n], 0, 0, 0); } __builtin_amdgcn_s_setprio(0); } while (0)
#define PG8_WAIT_V(n) asm volatile("s_waitcnt vmcnt(" #n ")" ::: "memory")
#define PG8_WAIT_L(n) asm volatile("s_waitcnt lgkmcnt(" #n ")" ::: "memory")
#define PG8_BAR __builtin_amdgcn_s_barrier()
#define PG8_SCHED __builtin_amdgcn_sched_barrier(0)
    Unit cur, nxt; int ui = 0;
    if (!S.next(0, cur)) return;
    f32x4 acc[2][2][4][2];
#pragma unroll
    for (int a = 0; a < 2; ++a)
#pragma unroll
        for (int b = 0; b < 2; ++b)
#pragma unroll
            for (int m = 0; m < 4; ++m)
#pragma unroll
                for (int n = 0; n < 2; ++n) acc[a][b][m][n] = (f32x4){0.f, 0.f, 0.f, 0.f};
    bf16x8 At[4][2], B0[2][2], B1[2][2];
    const char* cA = (const char*)g.A + (size_t)cur.pm * tstepA + (size_t)cur.pz * g.zA; const char* cB = (const char*)g.Bt + (size_t)cur.pn * tstepB + (size_t)cur.pz * g.zB;
    PG8_STAGE(PG8_SB(0, 0), cB, voffB); PG8_STAGE(PG8_SB(0, 1), cB + hstepB, voffB); PG8_STAGE(PG8_SA(0, 0), cA, voffA); PG8_STAGE(PG8_SA(0, 1), cA + hstepA, voffA);
    if (wr == 1) PG8_BAR;
    PG8_WAIT_V(2); PG8_BAR;
    PG8_STAGE(PG8_SB(1, 0), cB + kstep, voffB); PG8_STAGE(PG8_SA(1, 0), cA + kstep, voffA); PG8_STAGE(PG8_SB(1, 1), cB + hstepB + kstep, voffB);
    PG8_WAIT_V(6); PG8_BAR;
    for (;;) {
        const bool has_next = S.next(ui + 1, nxt);
        const char* nA = has_next ? (const char*)g.A + (size_t)nxt.pm * tstepA + (size_t)nxt.pz * g.zA : cA; const char* nB = has_next ? (const char*)g.Bt + (size_t)nxt.pn * tstepB + (size_t)nxt.pz * g.zB : cB;
        for (int t = 0; t < nt; t += 2) {
            const bool last = (t == nt - 2);
            const char* a1 = cA + (size_t)(t + 1) * kstep;
            const char* a2 = last ? nA : cA + (size_t)(t + 2) * kstep; const char* b2 = last ? nB : cB + (size_t)(t + 2) * kstep;
            const char* a3 = a2 + kstep; const char* b3 = b2 + kstep;
            if constexpr (Epi::NSCL > 0) { if (t == 0 && (Epi::NSCL == 2 || wid < 4)) {
                const GAS float* sp = (wid < 4 ? E.rowp(cur) : E.colp(cur) - 256) + wid * 64;
                __builtin_amdgcn_global_load_lds((const unsigned*)((const GAS char*)sp + (unsigned)lane_id_() * 4u), (PG8_LAS unsigned*)(lds + SCL_OFF + (ui & 1) * 2048 + wid * 256), 4, 0, 0); } }
            PG8_LDB(B0, 0, 0); PG8_LDB(B1, 0, 1); PG8_SCHED; PG8_LDA(At, 0, 0); PG8_STAGE(PG8_SA(1, 1), a1 + hstepA, voffA);
            PG8_WAIT_V(8); PG8_WAIT_L(0); PG8_BAR; PG8_MMA(0, 0, At, B0); PG8_MMA(0, 1, At, B1); PG8_BAR; PG8_SCHED;
            PG8_LDA(At, 0, 1); PG8_STAGE(PG8_SB(0, 0), b2, voffB); PG8_STAGE(PG8_SB(0, 1), b2 + hstepB, voffB); PG8_STAGE(PG8_SA(0, 0), a2, voffA);
            PG8_WAIT_V(8); PG8_WAIT_L(0); PG8_BAR; PG8_MMA(1, 0, At, B0); PG8_MMA(1, 1, At, B1); PG8_BAR; PG8_SCHED;
            PG8_LDB(B0, 1, 0); PG8_LDB(B1, 1, 1); PG8_SCHED; PG8_LDA(At, 1, 0); PG8_STAGE(PG8_SA(0, 1), a2 + hstepA, voffA);
            PG8_WAIT_V(8); PG8_WAIT_L(0); PG8_BAR; PG8_MMA(0, 0, At, B0); PG8_MMA(0, 1, At, B1); PG8_BAR; PG8_SCHED;
            PG8_LDA(At, 1, 1); PG8_STAGE(PG8_SB(1, 0), b3, voffB); PG8_STAGE(PG8_SB(1, 1), b3 + hstepB, voffB); PG8_STAGE(PG8_SA(1, 0), a3, voffA);
            PG8_WAIT_V(8); PG8_WAIT_L(0); PG8_BAR; PG8_MMA(1, 0, At, B0); PG8_MMA(1, 1, At, B1); PG8_BAR; PG8_SCHED;
        }
        if constexpr (ALIGN_EPI) { if (wr == 0) PG8_BAR; }
        { const int l_ = lane_id_(); int fr_ = l_ & 15, fq_ = l_ >> 4; asm volatile("" : "+v"(fr_), "+v"(fq_)); E(acc, cur, wr, wc, fr_, fq_, (const PG8_LAS float*)(lds + SCL_OFF + (ui & 1) * 2048)); }
        if (!has_next) break;
        if (!Epi::CHAINED || nxt.pz == 0) {
#pragma unroll
            for (int a = 0; a < 2; ++a)
#pragma unroll
                for (int b = 0; b < 2; ++b)
#pragma unroll
                    for (int m = 0; m < 4; ++m)
#pragma unroll
                        for (int n = 0; n < 2; ++n) acc[a][b][m][n] = (f32x4){0.f, 0.f, 0.f, 0.f};
        }
        cur = nxt; cA = nA; cB = nB; ++ui;
        if constexpr (ALIGN_EPI) { if (wr == 1) PG8_BAR; }
    }
    PG8_WAIT_V(0);
    if constexpr (!ALIGN_EPI) { if (wr == 0) PG8_BAR; }
    PG8_BAR;
#undef PG8_SA
#undef PG8_SB
#undef PG8_STAGE
#undef PG8_LDA
#undef PG8_LDB
#undef PG8_MMA
#undef PG8_WAIT_V
#undef PG8_WAIT_L
#undef PG8_BAR
#undef PG8_SCHED
}
}

#define LAS __attribute__((address_space(3)))
#define XB_TMO      128
#define XB_XCNT(j)  (256  + 64 * (j))
#define XB_XSUB(j)  (1280 + 64 * (j))
#define XB_XGEN(j)  (2304 + 64 * (j))
#define XB_TOP      3328
#define XB_TOPGEN   3392
#define XCD_BAR_WORDS 3456
#define XB_SPIN_CAP (1u << 18)
__device__ __forceinline__ unsigned xb_ld(unsigned* p)              { return __hip_atomic_load(p, __ATOMIC_RELAXED, __HIP_MEMORY_SCOPE_AGENT); }
__device__ __forceinline__ unsigned xb_add(unsigned* p, unsigned v) { return __hip_atomic_fetch_add(p, v, __ATOMIC_RELAXED, __HIP_MEMORY_SCOPE_AGENT); }
__device__ __forceinline__ unsigned xb_xcc_id() { return (unsigned)__builtin_amdgcn_s_getreg((3 << 11) | 20) & 0xFu; }
#define XB_SPIN(cond, bar) do { unsigned _sp = 0; while (cond) { __builtin_amdgcn_s_sleep(1); \
    if ((++_sp & 255u) == 0u) { if (xb_ld(&(bar)[XB_TMO])) break; if (_sp > XB_SPIN_CAP) { atomicAdd(&(bar)[XB_TMO], 1u); break; } } } } while (0)
struct XcdBarrier { unsigned* bar; unsigned x; volatile LAS unsigned* st; int wave_u; };
__device__ __forceinline__ XcdBarrier xcd_barrier_post(unsigned* bar, volatile LAS unsigned* st, int wave_u) {
    XcdBarrier b; b.bar = bar; b.x = xb_xcc_id(); b.st = st; b.wave_u = wave_u;
    if (wave_u == 0 && lane_id_() == 0) (void)xb_add(&bar[XB_XCNT(b.x)], 1u);
    return b;
}
__device__ __forceinline__ void xcd_barrier_complete(unsigned* bar, unsigned x, unsigned& nloc, unsigned& nx) {
    const unsigned G = gridDim.x * gridDim.y * gridDim.z;
    unsigned sum, cnt, mine, sp = 0u;
    for (;;) {
        sum = 0u; cnt = 0u; mine = 0u;
#pragma unroll
        for (unsigned j = 0; j < 16; ++j) { const unsigned c = xb_ld(&bar[XB_XCNT(j)]); sum += c; cnt += (c > 0u) ? 1u : 0u; mine = (j == x) ? c : mine; }
        if (sum == G) break;
        __builtin_amdgcn_s_sleep(1);
        if ((++sp & 255u) == 0u) { if (xb_ld(&bar[XB_TMO])) break; if (sp > XB_SPIN_CAP) { atomicAdd(&bar[XB_TMO], 1u); break; } }
    }
    nloc = mine > 0u ? mine : 1u; nx = cnt > 0u ? cnt : 1u;
}
__device__ __forceinline__ void xcd_barrier(const XcdBarrier& b) {
    asm volatile("s_waitcnt vmcnt(0)" ::: "memory");
    __syncthreads();
    if (b.wave_u == 0 && lane_id_() == 0) {
        unsigned* bar = b.bar;
        __builtin_amdgcn_s_waitcnt(0);
        unsigned nloc = b.st[0], nx = b.st[1];
        if (nloc == 0u) { xcd_barrier_complete(bar, b.x, nloc, nx); b.st[0] = nloc; b.st[1] = nx; }
        const unsigned old = xb_add(&bar[XB_XSUB(b.x)], 1u);
        const unsigned gen = old / nloc;
        if (old + 1u == (gen + 1u) * nloc) {
            __builtin_amdgcn_fence(__ATOMIC_RELEASE, "agent");
            asm volatile("s_waitcnt vmcnt(0)" ::: "memory");
            const unsigned og = xb_add(&bar[XB_TOP], 1u);
            const unsigned tg = og / nx;
            if (og + 1u == (tg + 1u) * nx) xb_add(&bar[XB_TOPGEN], 1u);
            else XB_SPIN(xb_ld(&bar[XB_TOPGEN]) == tg, bar);
            __builtin_amdgcn_fence(__ATOMIC_ACQUIRE, "agent");
            xb_add(&bar[XB_XGEN(b.x)], 1u);
            asm volatile("s_waitcnt vmcnt(0)" ::: "memory");
        } else {
            XB_SPIN(xb_ld(&bar[XB_XGEN(b.x)]) == gen, bar);
            __builtin_amdgcn_fence(__ATOMIC_ACQUIRE, "agent");
            asm volatile("s_waitcnt vmcnt(0)" ::: "memory");
        }
    }
    __syncthreads();
}

constexpr int NWAVES = 8;
constexpr int RING_OFF = 0, RING_BYTES = 131072;
constexpr int LDSCTL_OFF = RING_BYTES, MISC_OFF = LDSCTL_OFF + 320;
constexpr int LDS_BYTES = 147456;
constexpr int CW_BAR = 4096;
constexpr int MAX_LAUNCHES = 24;
static_assert((CW_BAR + MAX_LAUNCHES * XCD_BAR_WORDS) * 4 <= (int)CTL_ZERO_BYTES, "barrier regions inside the memset region");
constexpr int PH_PER_LAYER = 8, PH_TOTAL = 1 + NL * PH_PER_LAYER;
enum { PH_A = 0, PH_M1 = 1, PH_M2 = 2, PH_M3 = 3, PH_G = 4, PH_C = 5, PH_D = 6, PH_T = 7 };

struct Args { const float* in[19]; float* out; unsigned char* ws; int ph_lo, ph_hi, li, pad; };

__device__ __forceinline__ float wave_sum(float v) {
#pragma unroll
    for (int o = 1; o < 64; o <<= 1) v += __shfl_xor(v, o);
    return v;
}
__device__ __forceinline__ unsigned pk2(float lo, float hi) { return (unsigned)f2bf(lo) | ((unsigned)f2bf(hi) << 16); }
typedef float f32x4_t __attribute__((ext_vector_type(4)));
typedef unsigned u32x4_t __attribute__((ext_vector_type(4)));

__device__ __forceinline__ void transpose_item(const float* W_, int K, int N, bf16_t* WT_, LAS float* scr, int item, int lane, const float* gk_ = nullptr, int ldw_ = 0) {
    const GAS float* W = (const GAS float*)W_; GAS bf16_t* WT = (GAS bf16_t*)WT_; const int ldw = ldw_ ? ldw_ : N;
    const int nblk = N / 32, kb = item / nblk, nb = item % nblk, k0 = 64 * kb, n0 = 32 * nb;
    float tv[32];
#pragma unroll
    for (int i = 0; i < 32; ++i) { const int kk = 2 * i + (lane >> 5); tv[i] = W[(size_t)(k0 + kk) * ldw + n0 + (lane & 31)]; }
    asm volatile("" ::: "memory");
#pragma unroll
    for (int i = 0; i < 32; ++i) { const int kk = 2 * i + (lane >> 5); scr[kk * 33 + (lane & 31)] = tv[i]; }
    asm volatile("s_waitcnt lgkmcnt(0)" ::: "memory");
    const int c = lane & 7;
    f32x4_t g0 = {1.f, 1.f, 1.f, 1.f}, g1 = g0;
    if (gk_) { const GAS f32x4_t* gp = (const GAS f32x4_t*)((const GAS float*)gk_ + k0 + 8 * c); g0 = gp[0]; g1 = gp[1]; }
#pragma unroll
    for (int j = 0; j < 4; ++j) { const int n = (lane >> 3) + 8 * j; const LAS float* s = scr + (8 * c) * 33 + n;
        u32x4_t o; o.x = pk2(s[0 * 33] * g0.x, s[1 * 33] * g0.y); o.y = pk2(s[2 * 33] * g0.z, s[3 * 33] * g0.w); o.z = pk2(s[4 * 33] * g1.x, s[5 * 33] * g1.y); o.w = pk2(s[6 * 33] * g1.z, s[7 * 33] * g1.w);
        *(GAS u32x4_t*)(WT + (size_t)(n0 + n) * K + k0 + 8 * c) = o; }
    asm volatile("s_waitcnt lgkmcnt(0)" ::: "memory");
}
__device__ __forceinline__ void convert_weights(unsigned char* ws, const float* w_in_all, const float* w_gate_all, const float* w_branch_all, const float* w_out_all, const float* norm_pre_all, int l, int mask, LAS unsigned char* lds, int gw, int NGW, int wave, int lane) {
    const float* gpre = norm_pre_all + (size_t)l * ND;
    LAS float* scr = (LAS float*)(lds + RING_OFF + wave * 16384);
    const float* w_in = w_in_all + (size_t)l * ND * NU; const float* w_gate = w_gate_all + (size_t)l * 5 * ND * ND;
    const float* w_branch = w_branch_all + (size_t)l * 5 * NW * ND; const float* w_out = w_out_all + (size_t)l * ND * ND;
    constexpr int I_IN = (ND / 64) * (NU_BF / 32), I_G = (ND / 64) * (ND / 32), I_B = (NW / 64) * (ND / 32), I_O = I_G;
    if (mask & 1) for (int it = gw; it < I_IN; it += NGW) transpose_item(w_in, ND, NU_BF, (bf16_t*)(ws + WS_WIN), scr, it, lane, gpre, NU);
    if (mask & 2) for (int it = gw; it < 5 * I_B + I_O; it += NGW) {
        int r = it;
        if (r < 5 * I_B) { const int n = r / I_B; transpose_item(w_branch + (size_t)n * NW * ND, NW, ND, (bf16_t*)(ws + WS_WB) + (size_t)n * ND * NW, scr, r - n * I_B, lane); continue; } r -= 5 * I_B;
        transpose_item(w_out, ND, ND, (bf16_t*)(ws + WS_WO), scr, r, lane);
    }
    (void)w_gate; (void)I_G;
}
__device__ __forceinline__ unsigned q8pack(float a, float b, float c, float d) {
    const int ia = __float2int_rn(a), ib = __float2int_rn(b), ic = __float2int_rn(c), id = __float2int_rn(d);
    return (unsigned)(ia & 0xff) | ((unsigned)(ib & 0xff) << 8) | ((unsigned)(ic & 0xff) << 16) | ((unsigned)(id & 0xff) << 24);
}
__device__ __forceinline__ void colmax_item(int item, const float* w_gate_all, const float* norm_pre_all, float* CQ_, int lane) {
    const int kblk = item & 7, nblk = (item >> 3) & 15, lb = item >> 7, l = lb / 5, br = lb - l * 5;
    const GAS float* W = (const GAS float*)w_gate_all + ((size_t)(l * 5 + br) * ND + kblk * 128) * ND + nblk * 64 + lane;
    const GAS float* g = (const GAS float*)norm_pre_all + (size_t)l * ND + kblk * 128;
    float mx = 0.f;
#pragma unroll
    for (int kb = 0; kb < 128; kb += 64) {
        float wv[64];
#pragma unroll
        for (int k = 0; k < 64; ++k) wv[k] = W[(size_t)(kb + k) * ND];
        asm volatile("" ::: "memory");
#pragma unroll
        for (int k = 0; k < 64; ++k) mx = fmaxf(mx, fabsf(wv[k] * g[kb + k]));
    }
    atomicMax((unsigned*)CQ_ + (size_t)l * 5120 + br * 1024 + nblk * 64 + lane, __float_as_uint(mx));
}
__device__ __forceinline__ void colmax_in_item(int item, const float* w_in_all, const float* norm_pre_all, float* CQ_, int lane) {
    const int kblk = item & 7, ln = item >> 3, l = ln / 52, nblk = ln - l * 52;
    const GAS float* W = (const GAS float*)w_in_all + ((size_t)l * ND + kblk * 128) * NU + NU_BF + nblk * 64 + lane;
    const GAS float* g = (const GAS float*)norm_pre_all + (size_t)l * ND + kblk * 128;
    float mx = 0.f;
#pragma unroll
    for (int kb = 0; kb < 128; kb += 64) {
        float wv[64];
#pragma unroll
        for (int k = 0; k < 64; ++k) wv[k] = W[(size_t)(kb + k) * NU];
        asm volatile("" ::: "memory");
#pragma unroll
        for (int k = 0; k < 64; ++k) mx = fmaxf(mx, fabsf(wv[k] * g[kb + k]));
    }
    atomicMax((unsigned*)CQ_ + (size_t)l * NU_I8 + nblk * 64 + lane, __float_as_uint(mx));
}
template <int N = ND, int LDW = ND>
__device__ __forceinline__ void wg8_item(const float* Wbr_, const float* gk_, const float* cqn_, unsigned char* WT8_, LAS float* scr, int item, int lane) {
    const GAS float* W = (const GAS float*)Wbr_; GAS unsigned char* WT = (GAS unsigned char*)WT8_;
    constexpr int K = ND;
    const int nblk = N / 32, kb = item / nblk, nb = item % nblk, k0 = 64 * kb, n0 = 32 * nb;
    float tv[32];
#pragma unroll
    for (int i = 0; i < 32; ++i) { const int kk = 2 * i + (lane >> 5); tv[i] = W[(size_t)(k0 + kk) * LDW + n0 + (lane & 31)]; }
    asm volatile("" ::: "memory");
#pragma unroll
    for (int i = 0; i < 32; ++i) { const int kk = 2 * i + (lane >> 5); scr[kk * 33 + (lane & 31)] = tv[i]; }
    asm volatile("s_waitcnt lgkmcnt(0)" ::: "memory");
    const int c = lane & 7;
    const GAS f32x4_t* gp = (const GAS f32x4_t*)((const GAS float*)gk_ + k0 + 8 * c); const f32x4_t g0 = gp[0], g1 = gp[1];
#pragma unroll
    for (int j = 0; j < 4; ++j) { const int nn = (lane >> 3) + 8 * j; const LAS float* s = scr + (8 * c) * 33 + nn;
        const float cqv = DBG_CQ ? 0.25f : ((const GAS float*)cqn_)[n0 + nn]; const float inv = cqv > 0.f ? 127.f / cqv : 0.f;
        gu32x2 o; o.x = q8pack(s[0 * 33] * g0.x * inv, s[1 * 33] * g0.y * inv, s[2 * 33] * g0.z * inv, s[3 * 33] * g0.w * inv);
        o.y = q8pack(s[4 * 33] * g1.x * inv, s[5 * 33] * g1.y * inv, s[6 * 33] * g1.z * inv, s[7 * 33] * g1.w * inv);
        *(GAS gu32x2*)(WT + (size_t)(n0 + nn) * K + k0 + 8 * c) = o; }
    asm volatile("s_waitcnt lgkmcnt(0)" ::: "memory");
}
__device__ __forceinline__ void convert_wg8(const float* w_gate_all, const float* norm_pre_all, const float* CQ, unsigned char* WG8, int l, LAS unsigned char* lds, int gw, int NGW, int wave, int lane) {
    LAS float* scr = (LAS float*)(lds + RING_OFF + wave * 16384);
    constexpr int I_G = (ND / 64) * (ND / 32);
    for (int it = gw; it < 5 * I_G; it += NGW) { const int br = it / I_G;
        wg8_item(w_gate_all + ((size_t)l * 5 + br) * ND * ND, norm_pre_all + (size_t)l * ND, CQ + (size_t)l * 5120 + br * 1024, WG8 + (size_t)br * ND * ND, scr, it - br * I_G, lane); }
}
__device__ __forceinline__ void convert_win8(const float* w_in_all, const float* norm_pre_all, const float* CQI, unsigned char* WIN8, int l, LAS unsigned char* lds, int gw, int NGW, int wave, int lane) {
    LAS float* scr = (LAS float*)(lds + RING_OFF + wave * 16384);
    constexpr int I_Q = (ND / 64) * (NU_I8 / 32);
    for (int it = gw; it < I_Q; it += NGW)
        wg8_item<NU_I8, NU>(w_in_all + (size_t)l * ND * NU + NU_BF, norm_pre_all + (size_t)l * ND, CQI + (size_t)l * NU_I8, WIN8, scr, it, lane);
}
__device__ __forceinline__ void rms_row_to_bf16(const float* xrow, const float* g, bf16_t* orow, int lane) {
    const GAS f32x4_t* xr = (const GAS f32x4_t*)xrow + lane; const GAS f32x4_t* gr = (const GAS f32x4_t*)g + lane;
    f32x4_t v[4]; float s = 0.f;
#pragma unroll
    for (int j = 0; j < 4; ++j) { v[j] = xr[64 * j]; s += (v[j].x * v[j].x + v[j].y * v[j].y) + (v[j].z * v[j].z + v[j].w * v[j].w); }
    const float r = rsqrtf(wave_sum(s) * (1.f / ND) + EPSF);
    GAS unsigned long long* o8 = (GAS unsigned long long*)orow + lane;
#pragma unroll
    for (int j = 0; j < 4; ++j) { const f32x4_t gg = gr[64 * j];
        o8[64 * j] = (unsigned long long)pk2(v[j].x * r * gg.x, v[j].y * r * gg.y) | ((unsigned long long)pk2(v[j].z * r * gg.z, v[j].w * r * gg.w) << 32); }
}
__device__ __forceinline__ void post_row(const float* xrow, const bf16_t* orow, const float* g_post, const float* g_next, float* xout, bf16_t* hrow, bool has_next, int lane) {
    const GAS f32x4_t* xr = (const GAS f32x4_t*)xrow + lane; const GAS unsigned long long* o8 = (const GAS unsigned long long*)orow + lane;
    f32x4_t v[4]; float s = 0.f;
#pragma unroll
    for (int j = 0; j < 4; ++j) { const unsigned long long w = o8[64 * j]; const unsigned lo = (unsigned)w, hi = (unsigned)(w >> 32);
        v[j].x = __uint_as_float(lo << 16); v[j].y = __uint_as_float(lo & 0xffff0000u); v[j].z = __uint_as_float(hi << 16); v[j].w = __uint_as_float(hi & 0xffff0000u);
        s += (v[j].x * v[j].x + v[j].y * v[j].y) + (v[j].z * v[j].z + v[j].w * v[j].w); }
    const float r = rsqrtf(wave_sum(s) * (1.f / ND) + EPSF);
    float s2 = 0.f;
#pragma unroll
    for (int j = 0; j < 4; ++j) { const f32x4_t gg = ((const GAS f32x4_t*)g_post + lane)[64 * j]; const f32x4_t xx = xr[64 * j];
        v[j].x = xx.x + v[j].x * r * gg.x; v[j].y = xx.y + v[j].y * r * gg.y; v[j].z = xx.z + v[j].z * r * gg.z; v[j].w = xx.w + v[j].w * r * gg.w;
        s2 += (v[j].x * v[j].x + v[j].y * v[j].y) + (v[j].z * v[j].z + v[j].w * v[j].w);
        ((GAS f32x4_t*)xout + lane)[64 * j] = v[j]; }
    if (has_next) {
        const float r2 = rsqrtf(wave_sum(s2) * (1.f / ND) + EPSF);
        GAS unsigned long long* h8 = (GAS unsigned long long*)hrow + lane;
#pragma unroll
        for (int j = 0; j < 4; ++j) { const f32x4_t gg = ((const GAS f32x4_t*)g_next + lane)[64 * j];
            h8[64 * j] = (unsigned long long)pk2(v[j].x * r2 * gg.x, v[j].y * r2 * gg.y) | ((unsigned long long)pk2(v[j].z * r2 * gg.z, v[j].w * r2 * gg.w) << 32); }
    }
}


__device__ __forceinline__ void post_rows(const float* xin_, const bf16_t* outraw_, const float* g_post_, const float* g_next_, float* xout_, bf16_t* H_, bool has_next, int gw, int NGW, int lane) {
    const GAS f32x4_t* xin = (const GAS f32x4_t*)xin_ + lane; const GAS unsigned long long* orw = (const GAS unsigned long long*)outraw_ + lane;
    GAS f32x4_t* xout = (GAS f32x4_t*)xout_ + lane; GAS unsigned long long* H8 = (GAS unsigned long long*)H_ + lane;
    f32x4_t gp[4], gn[4];
#pragma unroll
    for (int j = 0; j < 4; ++j) { gp[j] = ((const GAS f32x4_t*)g_post_ + lane)[64 * j]; gn[j] = ((const GAS f32x4_t*)g_next_ + lane)[64 * j]; }
    f32x4_t xn[4]; unsigned long long on[4];
    int m = gw;
    if (m < NM) {
#pragma unroll
        for (int j = 0; j < 4; ++j) { xn[j] = xin[(size_t)m * 256 + 64 * j]; on[j] = orw[(size_t)m * 256 + 64 * j]; }
    }
    for (; m < NM; m += NGW) {
        f32x4_t v[4], xc[4]; float s = 0.f;
#pragma unroll
        for (int j = 0; j < 4; ++j) { xc[j] = xn[j]; const unsigned lo = (unsigned)on[j], hi = (unsigned)(on[j] >> 32);
            v[j].x = __uint_as_float(lo << 16); v[j].y = __uint_as_float(lo & 0xffff0000u); v[j].z = __uint_as_float(hi << 16); v[j].w = __uint_as_float(hi & 0xffff0000u);
            s += (v[j].x * v[j].x + v[j].y * v[j].y) + (v[j].z * v[j].z + v[j].w * v[j].w); }
        const int m2 = m + NGW;
        if (m2 < NM) {
#pragma unroll
            for (int j = 0; j < 4; ++j) { xn[j] = xin[(size_t)m2 * 256 + 64 * j]; on[j] = orw[(size_t)m2 * 256 + 64 * j]; }
        }
        asm volatile("" ::: "memory");
        const float r = rsqrtf(wave_sum(s) * (1.f / ND) + EPSF);
        float s2 = 0.f;
#pragma unroll
        for (int j = 0; j < 4; ++j) { v[j] = xc[j] + v[j] * r * gp[j]; s2 += (v[j].x * v[j].x + v[j].y * v[j].y) + (v[j].z * v[j].z + v[j].w * v[j].w); xout[(size_t)m * 256 + 64 * j] = v[j]; }
        if (has_next) {
            const float r2 = rsqrtf(wave_sum(s2) * (1.f / ND) + EPSF);
#pragma unroll
            for (int j = 0; j < 4; ++j) { const f32x4_t o = v[j] * r2 * gn[j];
                H8[(size_t)m * 256 + 64 * j] = (unsigned long long)pk2(o.x, o.y) | ((unsigned long long)pk2(o.z, o.w) << 32); }
        }
    }
}

__device__ __forceinline__ void rms_rows(const float* x_, const float* g_, int gdiv, bf16_t* out_, int nrows, int gw, int NGW, int lane) {
    const GAS f32x4_t* xin = (const GAS f32x4_t*)x_ + lane; GAS unsigned long long* o8 = (GAS unsigned long long*)out_ + lane;
    f32x4_t xn[4];
    int m = gw;
    if (m < nrows) {
#pragma unroll
        for (int j = 0; j < 4; ++j) xn[j] = xin[(size_t)(gdiv ? m % gdiv : m) * 256 + 64 * j];
    }
    for (; m < nrows; m += NGW) {
        f32x4_t v[4]; float s = 0.f;
#pragma unroll
        for (int j = 0; j < 4; ++j) { v[j] = xn[j]; s += (v[j].x * v[j].x + v[j].y * v[j].y) + (v[j].z * v[j].z + v[j].w * v[j].w); }
        const int m2 = m + NGW;
        if (m2 < nrows) {
#pragma unroll
            for (int j = 0; j < 4; ++j) xn[j] = xin[(size_t)(gdiv ? m2 % gdiv : m2) * 256 + 64 * j];
        }
        const GAS f32x4_t* gr = (const GAS f32x4_t*)(g_ + (gdiv ? (size_t)(m / gdiv) * ND : 0)) + lane;
        f32x4_t gg[4];
#pragma unroll
        for (int j = 0; j < 4; ++j) gg[j] = gr[64 * j];
        asm volatile("" ::: "memory");
        const float r = rsqrtf(wave_sum(s) * (1.f / ND) + EPSF);
#pragma unroll
        for (int j = 0; j < 4; ++j) o8[(size_t)m * 256 + 64 * j] = (unsigned long long)pk2(v[j].x * r * gg[j].x, v[j].y * r * gg[j].y) | ((unsigned long long)pk2(v[j].z * r * gg[j].z, v[j].w * r * gg[j].w) << 32);
    }
}

__device__ __forceinline__ void x_to_bf16_rows(const float* x_, bf16_t* XB_, float* RS_, unsigned char* X8_, float* RQ_, int gw, int NGW, int lane) {
    const GAS f32x4_t* xin = (const GAS f32x4_t*)x_ + 2 * lane; GAS u32x4_t* o16 = (GAS u32x4_t*)XB_ + lane; GAS float* RS = (GAS float*)RS_;
    GAS gu32x2* q8 = (GAS gu32x2*)X8_ + lane; GAS float* RQ = (GAS float*)RQ_;
    for (int m = gw; m < NM; m += NGW) {
        f32x4_t v[4]; float s = 0.f, amx = 0.f;
#pragma unroll
        for (int j = 0; j < 4; ++j) { v[j] = xin[(size_t)m * 256 + 128 * (j >> 1) + (j & 1)]; s += (v[j].x * v[j].x + v[j].y * v[j].y) + (v[j].z * v[j].z + v[j].w * v[j].w);
            amx = fmaxf(amx, fmaxf(fmaxf(fabsf(v[j].x), fabsf(v[j].y)), fmaxf(fabsf(v[j].z), fabsf(v[j].w)))); }
#pragma unroll
        for (int o = 1; o < 64; o <<= 1) { s += __shfl_xor(s, o); amx = fmaxf(amx, __shfl_xor(amx, o)); }
        const float r = rsqrtf(s * (1.f / ND) + EPSF), inv = amx > 0.f ? 127.f / amx : 0.f;
#pragma unroll
        for (int c = 0; c < 2; ++c) { const f32x4_t a = v[2 * c], b = v[2 * c + 1];
            o16[(size_t)m * 128 + 64 * c] = (u32x4_t){pk2(a.x, a.y), pk2(a.z, a.w), pk2(b.x, b.y), pk2(b.z, b.w)};
            q8[(size_t)m * 128 + 64 * c] = (gu32x2){q8pack(a.x * inv, a.y * inv, a.z * inv, a.w * inv), q8pack(b.x * inv, b.y * inv, b.z * inv, b.w * inv)}; }
        if (lane == 0) { RS[m] = r; RQ[m] = r * amx * (1.f / 127.f); }
    }
}
__device__ __forceinline__ void post_rows_bf(bf16_t* XB_, const bf16_t* outraw_, const float* g_post_, float* xout_, float* RS_, unsigned char* X8_, float* RQ_, bool last, int gw, int NGW, int lane) {
    GAS gu32x2* q8 = (GAS gu32x2*)X8_ + lane; GAS float* RQ = (GAS float*)RQ_;
    GAS u32x4_t* xb = (GAS u32x4_t*)XB_ + lane; const GAS u32x4_t* orw = (const GAS u32x4_t*)outraw_ + lane;
    GAS f32x4_t* xout = (GAS f32x4_t*)xout_ + 2 * lane; GAS float* RS = (GAS float*)RS_;
    f32x4_t gp[4];
#pragma unroll
    for (int j = 0; j < 4; ++j) gp[j] = ((const GAS f32x4_t*)g_post_ + 2 * lane)[128 * (j >> 1) + (j & 1)];
    u32x4_t xn[2], on[2];
    int m = gw;
    if (m < NM) {
#pragma unroll
        for (int c = 0; c < 2; ++c) { xn[c] = xb[(size_t)m * 128 + 64 * c]; on[c] = orw[(size_t)m * 128 + 64 * c]; }
    }
    for (; m < NM; m += NGW) {
        f32x4_t v[4], xc[4]; float s = 0.f;
#pragma unroll
        for (int c = 0; c < 2; ++c) {
            v[2 * c].x = __uint_as_float(on[c].x << 16); v[2 * c].y = __uint_as_float(on[c].x & 0xffff0000u); v[2 * c].z = __uint_as_float(on[c].y << 16); v[2 * c].w = __uint_as_float(on[c].y & 0xffff0000u);
            v[2 * c + 1].x = __uint_as_float(on[c].z << 16); v[2 * c + 1].y = __uint_as_float(on[c].z & 0xffff0000u); v[2 * c + 1].z = __uint_as_float(on[c].w << 16); v[2 * c + 1].w = __uint_as_float(on[c].w & 0xffff0000u);
            xc[2 * c].x = __uint_as_float(xn[c].x << 16); xc[2 * c].y = __uint_as_float(xn[c].x & 0xffff0000u); xc[2 * c].z = __uint_as_float(xn[c].y << 16); xc[2 * c].w = __uint_as_float(xn[c].y & 0xffff0000u);
            xc[2 * c + 1].x = __uint_as_float(xn[c].z << 16); xc[2 * c + 1].y = __uint_as_float(xn[c].z & 0xffff0000u); xc[2 * c + 1].z = __uint_as_float(xn[c].w << 16); xc[2 * c + 1].w = __uint_as_float(xn[c].w & 0xffff0000u);
        }
#pragma unroll
        for (int j = 0; j < 4; ++j) s += (v[j].x * v[j].x + v[j].y * v[j].y) + (v[j].z * v[j].z + v[j].w * v[j].w);
        const int m2 = m + NGW;
        if (m2 < NM) {
#pragma unroll
            for (int c = 0; c < 2; ++c) { xn[c] = xb[(size_t)m2 * 128 + 64 * c]; on[c] = orw[(size_t)m2 * 128 + 64 * c]; }
        }
        asm volatile("" ::: "memory");
        const float r = rsqrtf(wave_sum(s) * (1.f / ND) + EPSF);
        float s2 = 0.f;
#pragma unroll
        for (int j = 0; j < 4; ++j) { v[j] = xc[j] + v[j] * r * gp[j]; s2 += (v[j].x * v[j].x + v[j].y * v[j].y) + (v[j].z * v[j].z + v[j].w * v[j].w); }
        if (last) {
#pragma unroll
            for (int j = 0; j < 4; ++j) xout[(size_t)m * 256 + 128 * (j >> 1) + (j & 1)] = v[j];
        } else {
            float amx = 0.f;
#pragma unroll
            for (int j = 0; j < 4; ++j) amx = fmaxf(amx, fmaxf(fmaxf(fabsf(v[j].x), fabsf(v[j].y)), fmaxf(fabsf(v[j].z), fabsf(v[j].w))));
#pragma unroll
            for (int o = 1; o < 64; o <<= 1) { s2 += __shfl_xor(s2, o); amx = fmaxf(amx, __shfl_xor(amx, o)); }
            const float r2 = rsqrtf(s2 * (1.f / ND) + EPSF), inv = amx > 0.f ? 127.f / amx : 0.f;
#pragma unroll
            for (int c = 0; c < 2; ++c) { const f32x4_t a = v[2 * c], b = v[2 * c + 1];
                xb[(size_t)m * 128 + 64 * c] = (u32x4_t){pk2(a.x, a.y), pk2(a.z, a.w), pk2(b.x, b.y), pk2(b.z, b.w)};
                q8[(size_t)m * 128 + 64 * c] = (gu32x2){q8pack(a.x * inv, a.y * inv, a.z * inv, a.w * inv), q8pack(b.x * inv, b.y * inv, b.z * inv, b.w * inv)}; }
            if (lane == 0) { RS[m] = r2; RQ[m] = r2 * amx * (1.f / 127.f); }
        }
    }
}

typedef short bf16x8_t __attribute__((ext_vector_type(8)));
typedef float f32x16_t __attribute__((ext_vector_type(16)));
#define MIX_LAS __attribute__((address_space(3)))
typedef float f32x4m __attribute__((ext_vector_type(4)));
typedef unsigned u32x4m __attribute__((ext_vector_type(4)));
__device__ __forceinline__ float wsum_(float v) {
#pragma unroll
    for (int o = 1; o < 64; o <<= 1) v += __shfl_xor(v, o);
    return v;
}
constexpr int KROW = 144;
__device__ __forceinline__ int crow_(int r, int hi) { return (r & 3) + 8 * (r >> 2) + 4 * hi; }
typedef float f32x2m __attribute__((ext_vector_type(2))); typedef __bf16 bf16x2m __attribute__((ext_vector_type(2)));
__device__ __forceinline__ unsigned pkbf(float lo, float hi) { f32x2m v = {lo, hi}; bf16x2m b = __builtin_convertvector(v, bf16x2m); return __builtin_bit_cast(unsigned, b); }

template <bool WIN>
__device__ __forceinline__ void attn_core(const MIX_LAS unsigned char* Kl, const MIX_LAS unsigned char* VTl, int vt_stride, const MIX_LAS float* biasl,
                                          const bf16x8_t (&qf)[4], int t_lo, int t_hi, int t_int_lo, int t_int_hi, int qi_band, float m0, float l0,
                                          const GAS bf16_t* zrow, GAS bf16_t* yrow, int lane) {
    constexpr float C2 = 0.125f * 1.4426950408889634f;
    const int r32 = lane & 31, hi = lane >> 5;
    gu32x2 zpre[2][4];
#pragma unroll
    for (int dt = 0; dt < 2; ++dt)
#pragma unroll
        for (int g4 = 0; g4 < 4; ++g4) zpre[dt][g4] = *(const GAS gu32x2*)(zrow + dt * 32 + 8 * g4 + 4 * hi);
    f32x16_t O0, O1;
#pragma unroll
    for (int r = 0; r < 16; ++r) { O0[r] = 0.f; O1[r] = 0.f; }
    float m = m0, l = l0;
    typedef unsigned u32x4v __attribute__((ext_vector_type(4)));
    for (int t = t_lo; t < t_hi; t += 2) {
        f32x16_t s0, s1;
#pragma unroll
        for (int r = 0; r < 16; ++r) { s0[r] = 0.f; s1[r] = 0.f; }
        const MIX_LAS unsigned char* kp = Kl + (t * 32 + r32) * KROW + hi * 16;
#pragma unroll
        for (int ds = 0; ds < 4; ++ds) { const bf16x8_t a0 = *(const MIX_LAS bf16x8_t*)(kp + ds * 32), a1 = *(const MIX_LAS bf16x8_t*)(kp + 32 * KROW + ds * 32);
            s0 = __builtin_amdgcn_mfma_f32_32x32x16_bf16(a0, qf[ds], s0, 0, 0, 0); s1 = __builtin_amdgcn_mfma_f32_32x32x16_bf16(a1, qf[ds], s1, 0, 0, 0); }
        if (WIN) {
            const int rel0 = t * 32 + 4 * hi - qi_band;
            const MIX_LAS float* bp = biasl + (rel0 + 128);
#pragma unroll
            for (int r = 0; r < 16; ++r) { s0[r] = s0[r] * C2 + bp[(r & 3) + 8 * (r >> 2)]; s1[r] = s1[r] * C2 + bp[32 + (r & 3) + 8 * (r >> 2)]; }
            if (t < t_int_lo || t >= t_int_hi) {
#pragma unroll
                for (int r = 0; r < 16; ++r) { const int rel = rel0 + (r & 3) + 8 * (r >> 2); s0[r] = (rel >= -128 && rel <= 128) ? s0[r] : -INFINITY; }
            }
            if (t + 1 < t_int_lo || t + 1 >= t_int_hi) {
#pragma unroll
                for (int r = 0; r < 16; ++r) { const int rel = rel0 + 32 + (r & 3) + 8 * (r >> 2); s1[r] = (rel >= -128 && rel <= 128) ? s1[r] : -INFINITY; }
            }
        } else {
#pragma unroll
            for (int r = 0; r < 16; ++r) { s0[r] *= C2; s1[r] *= C2; }
        }
        float mx = fmaxf(s0[0], s1[0]);
#pragma unroll
        for (int r = 1; r < 16; ++r) mx = fmaxf(mx, fmaxf(s0[r], s1[r]));
        mx = fmaxf(mx, __shfl_xor(mx, 32));
        if (__any(mx > m)) {
            const float mn = fmaxf(m, mx), sc = __builtin_amdgcn_exp2f(m - mn); m = mn; l *= sc;
#pragma unroll
            for (int r = 0; r < 16; ++r) { O0[r] *= sc; O1[r] *= sc; }
        }
        float ps = 0.f;
#pragma unroll
        for (int r = 0; r < 16; ++r) { const float p0 = __builtin_amdgcn_exp2f(s0[r] - m), p1 = __builtin_amdgcn_exp2f(s1[r] - m); s0[r] = p0; s1[r] = p1; ps += p0 + p1; }
        l += ps;
        u32x4v a0, a1, b0, b1;
        a0.x = pkbf(s0[0], s0[1]); a0.y = pkbf(s0[2], s0[3]); a0.z = pkbf(s0[4], s0[5]); a0.w = pkbf(s0[6], s0[7]);
        a1.x = pkbf(s0[8], s0[9]); a1.y = pkbf(s0[10], s0[11]); a1.z = pkbf(s0[12], s0[13]); a1.w = pkbf(s0[14], s0[15]);
        b0.x = pkbf(s1[0], s1[1]); b0.y = pkbf(s1[2], s1[3]); b0.z = pkbf(s1[4], s1[5]); b0.w = pkbf(s1[6], s1[7]);
        b1.x = pkbf(s1[8], s1[9]); b1.y = pkbf(s1[10], s1[11]); b1.z = pkbf(s1[12], s1[13]); b1.w = pkbf(s1[14], s1[15]);
        const bf16x8_t pf0 = __builtin_bit_cast(bf16x8_t, a0), pf1 = __builtin_bit_cast(bf16x8_t, a1), pf2 = __builtin_bit_cast(bf16x8_t, b0), pf3 = __builtin_bit_cast(bf16x8_t, b1);
        const MIX_LAS unsigned char* vp = VTl + r32 * vt_stride + (t * 32 + 8 * hi) * 2;
        const MIX_LAS unsigned char* vq = vp + 32 * vt_stride;
        { const bf16x8_t x0 = *(const MIX_LAS bf16x8_t*)(vp), y0 = *(const MIX_LAS bf16x8_t*)(vq);
          O0 = __builtin_amdgcn_mfma_f32_32x32x16_bf16(x0, pf0, O0, 0, 0, 0); O1 = __builtin_amdgcn_mfma_f32_32x32x16_bf16(y0, pf0, O1, 0, 0, 0); }
        { const bf16x8_t x0 = *(const MIX_LAS bf16x8_t*)(vp + 32), y0 = *(const MIX_LAS bf16x8_t*)(vq + 32);
          O0 = __builtin_amdgcn_mfma_f32_32x32x16_bf16(x0, pf1, O0, 0, 0, 0); O1 = __builtin_amdgcn_mfma_f32_32x32x16_bf16(y0, pf1, O1, 0, 0, 0); }
        { const bf16x8_t x0 = *(const MIX_LAS bf16x8_t*)(vp + 64), y0 = *(const MIX_LAS bf16x8_t*)(vq + 64);
          O0 = __builtin_amdgcn_mfma_f32_32x32x16_bf16(x0, pf2, O0, 0, 0, 0); O1 = __builtin_amdgcn_mfma_f32_32x32x16_bf16(y0, pf2, O1, 0, 0, 0); }
        { const bf16x8_t x0 = *(const MIX_LAS bf16x8_t*)(vp + 96), y0 = *(const MIX_LAS bf16x8_t*)(vq + 96);
          O0 = __builtin_amdgcn_mfma_f32_32x32x16_bf16(x0, pf3, O0, 0, 0, 0); O1 = __builtin_amdgcn_mfma_f32_32x32x16_bf16(y0, pf3, O1, 0, 0, 0); }
    }
    l += __shfl_xor(l, 32);
    const float inv = __builtin_amdgcn_rcpf(l);
#pragma unroll
    for (int dt = 0; dt < 2; ++dt)
#pragma unroll
        for (int g4 = 0; g4 < 4; ++g4) {
            const int d0 = dt * 32 + 8 * g4 + 4 * hi;
            const gu32x2 zw = zpre[dt][g4];
            const float z0 = __uint_as_float(zw.x << 16), z1 = __uint_as_float(zw.x & 0xffff0000u), z2 = __uint_as_float(zw.y << 16), z3 = __uint_as_float(zw.y & 0xffff0000u);
            float o0, o1, o2, o3;
            if (dt == 0) { o0 = O0[4 * g4]; o1 = O0[4 * g4 + 1]; o2 = O0[4 * g4 + 2]; o3 = O0[4 * g4 + 3]; }
            else { o0 = O1[4 * g4]; o1 = O1[4 * g4 + 1]; o2 = O1[4 * g4 + 2]; o3 = O1[4 * g4 + 3]; }
            gu32x2 w; w.x = pkbf(o0 * inv * siluf_(z0), o1 * inv * siluf_(z1)); w.y = pkbf(o2 * inv * siluf_(z2), o3 * inv * siluf_(z3));
            *(GAS gu32x2*)(yrow + d0) = w;
        }
}
template <int NK, class KP, class VP>
__device__ __forceinline__ void attn_stage(MIX_LAS unsigned char* Kl, MIX_LAS unsigned char* VTl, int vt_stride, const KP& krow, const VP& vrow, int tid) {
    constexpr int NIT = NK * 8 / 512;
    {
        u32x4m kv[NIT];
#pragma unroll
        for (int it = 0; it < NIT; ++it) { const int idx = tid + it * 512, row = idx >> 3, ch = idx & 7; const GAS bf16_t* p = krow(row);
            kv[it] = (u32x4m){0u, 0u, 0u, 0u}; if (p) kv[it] = *(const GAS u32x4m*)(p + ch * 8); }
        asm volatile("" ::: "memory");
#pragma unroll
        for (int it = 0; it < NIT; ++it) { const int idx = tid + it * 512, row = idx >> 3, ch = idx & 7; *(MIX_LAS u32x4m*)(Kl + row * KROW + ch * 16) = kv[it]; }
    }
    {
        u32x4m vv[NIT];
#pragma unroll
        for (int it = 0; it < NIT; ++it) { const int idx = tid + it * 512, ch = idx / NK, row = idx - ch * NK; const GAS bf16_t* p = vrow(row);
            vv[it] = (u32x4m){0u, 0u, 0u, 0u}; if (p) vv[it] = *(const GAS u32x4m*)(p + ch * 8); }
        asm volatile("" ::: "memory");
#pragma unroll
        for (int it = 0; it < NIT; ++it) { const int idx = tid + it * 512, ch = idx / NK, row = idx - ch * NK;
            const int w = row & 31, wp = (w & 0x13) | ((w & 4) << 1) | ((w & 8) >> 1), pos = (row & ~31) + wp;
            MIX_LAS unsigned short* dst = (MIX_LAS unsigned short*)(VTl + (ch * 8) * vt_stride + pos * 2);
            const unsigned ww[4] = {vv[it].x, vv[it].y, vv[it].z, vv[it].w};
#pragma unroll
            for (int e = 0; e < 4; ++e) { dst[(2 * e) * (vt_stride / 2)] = (unsigned short)(ww[e] & 0xffffu); dst[(2 * e + 1) * (vt_stride / 2)] = (unsigned short)(ww[e] >> 16); } }
    }
}

__device__ __forceinline__ void winattn_item(int item, const GAS bf16_t* U, const GAS float* BIAS, const GAS float* sink, GAS bf16_t* Y, MIX_LAS unsigned char* lds, int tid, bool do_core = true) {
    constexpr int NK = 384, VTS = NK * 2 + 16;
    const int qb = item & 31, kvh = (item >> 5) & 1, b = item >> 6;
    MIX_LAS unsigned char* Kl = lds; MIX_LAS unsigned char* VTl = lds + NK * KROW; MIX_LAS float* biasl = (MIX_LAS float*)(lds + NK * KROW + 64 * VTS);
    const int kpos0 = qb * 128 - 128; const size_t rowb = (size_t)b * NS;
    auto krow = [&](int i) -> const GAS bf16_t* { const int p = kpos0 + i; return (p >= 0 && p < NS) ? U + (rowb + p) * NU + C_AK + kvh * 64 : (const GAS bf16_t*)nullptr; };
    auto vrow = [&](int i) -> const GAS bf16_t* { const int p = kpos0 + i; return (p >= 0 && p < NS) ? U + (rowb + p) * NU + C_AV + kvh * 64 : (const GAS bf16_t*)nullptr; };
    attn_stage<NK>(Kl, VTl, VTS, krow, vrow, tid);
    for (int i = tid; i < 2 * 321; i += 512) { const int g_ = i / 321, j = i - g_ * 321 - 32; biasl[i] = (j >= 0 && j < 257) ? BIAS[(kvh * 2 + g_) * 257 + j] * 1.4426950408889634f : 0.f; }
    const int lane = tid & 63, wave = __builtin_amdgcn_readfirstlane(tid >> 6), g = wave >> 2, wq = wave & 3, r32 = lane & 31, hi = lane >> 5, h = kvh * 2 + g;
    const size_t mq = rowb + qb * 128 + wq * 32 + r32;
    bf16x8_t qf[4];
#pragma unroll
    for (int ds = 0; ds < 4; ++ds) qf[ds] = *(const GAS bf16x8_t*)(U + mq * NU + C_AQ + h * 64 + ds * 16 + hi * 8);
    __syncthreads();
    const int tmin = (qb == 0) ? 4 : 0, tmax = (qb == 31) ? 8 : 12;
    int t_lo = wq > tmin ? wq : tmin, t_hi = (wq + 9) < tmax ? (wq + 9) : tmax;
    if ((t_hi - t_lo) & 1) { if (t_hi < tmax) ++t_hi; else --t_lo; }
    if (do_core) attn_core<true>(Kl, VTl, VTS, biasl + g * 321 + 32, qf, t_lo, t_hi, wq + 1, wq + 8, 128 + wq * 32 + r32, sink[h] * 1.4426950408889634f, 1.f, U + mq * NU + C_AZ + h * 64, Y + mq * NY + 3 * NW + h * 64, lane);
    __syncthreads();
}
__device__ __forceinline__ void memattn_item(int item, const GAS bf16_t* U, const GAS bf16_t* MKV, GAS bf16_t* Y, MIX_LAS unsigned char* lds, int tid) {
    constexpr int NK = 256, VTS = NK * 2 + 16;
    const int qblk = item & 15, h = (item >> 4) & 3, b = item >> 6;
    MIX_LAS unsigned char* Kl = lds; MIX_LAS unsigned char* VTl = lds + NK * KROW;
    auto krow = [&](int i) -> const GAS bf16_t* { return MKV + (size_t)(b * MEML + i) * 512 + h * 64; };
    auto vrow = [&](int i) -> const GAS bf16_t* { return MKV + (size_t)(b * MEML + i) * 512 + 256 + h * 64; };
    attn_stage<NK>(Kl, VTl, VTS, krow, vrow, tid);
    const int lane = tid & 63, wave = __builtin_amdgcn_readfirstlane(tid >> 6), r32 = lane & 31, hi = lane >> 5;
    const size_t mq = (size_t)b * NS + qblk * 256 + wave * 32 + r32;
    bf16x8_t qf[4];
#pragma unroll
    for (int ds = 0; ds < 4; ++ds) qf[ds] = *(const GAS bf16x8_t*)(U + mq * NU + C_MQ + h * 64 + ds * 16 + hi * 8);
    __syncthreads();
    attn_core<false>(Kl, VTl, VTS, (const MIX_LAS float*)lds, qf, 0, 8, 0, 8, 0, -1e30f, 0.f, U + mq * NU + C_MZ + h * 64, Y + mq * NY + 4 * NW + h * 64, lane);
    __syncthreads();
}
__device__ __forceinline__ void conformer_item(int item, const GAS bf16_t* U, const GAS float* dw_w, const GAS float* dw_b, const GAS float* ln_g, const GAS float* ln_b, GAS bf16_t* Y, MIX_LAS unsigned char* lds, int tid) {
    MIX_LAS unsigned short* ul = (MIX_LAS unsigned short*)lds; MIX_LAS float* cv = (MIX_LAS float*)(lds + 94 * 512);
    const int tt = item & 63, b = item >> 6; const size_t rowb = (size_t)b * NS; const int t0 = tt * 64;
    {
        u32x4m av[6], bv[6];
#pragma unroll
        for (int it = 0; it < 6; ++it) { const int idx = tid + it * 512, row = idx >> 5, ch = idx & 31, t = t0 - 15 + row;
            av[it] = (u32x4m){0u, 0u, 0u, 0u}; bv[it] = av[it];
            if (idx < 94 * 32 && t >= 0 && t < NS) { const GAS bf16_t* p = U + (rowb + t) * NU; av[it] = *(const GAS u32x4m*)(p + C_CA + ch * 8); bv[it] = *(const GAS u32x4m*)(p + C_CB + ch * 8); } }
        asm volatile("" ::: "memory");
#pragma unroll
        for (int it = 0; it < 6; ++it) { const int idx = tid + it * 512, row = idx >> 5, ch = idx & 31;
            const unsigned aw[4] = {av[it].x, av[it].y, av[it].z, av[it].w}, bw[4] = {bv[it].x, bv[it].y, bv[it].z, bv[it].w}; unsigned ow[4];
#pragma unroll
            for (int e = 0; e < 4; ++e) ow[e] = pkbf(__uint_as_float(aw[e] << 16) * sigmoidf_(__uint_as_float(bw[e] << 16)), __uint_as_float(aw[e] & 0xffff0000u) * sigmoidf_(__uint_as_float(bw[e] & 0xffff0000u)));
            if (idx < 94 * 32) *(MIX_LAS u32x4m*)(ul + row * 256 + ch * 8) = (u32x4m){ow[0], ow[1], ow[2], ow[3]}; }
    }
    __syncthreads();
    {
        const int c = tid & 255, half = tid >> 8;
        float w[31], u[62];
#pragma unroll
        for (int j = 0; j < 31; ++j) w[j] = dw_w[j * 256 + c];
#pragma unroll
        for (int j = 0; j < 62; ++j) u[j] = __uint_as_float((unsigned)ul[(half * 32 + j) * 256 + c] << 16);
        const float bias = dw_b[c];
#pragma unroll
        for (int i = 0; i < 32; ++i) { float a = bias;
#pragma unroll
            for (int j = 0; j < 31; ++j) a += w[j] * u[i + j];
            cv[(half * 32 + i) * 256 + c] = a; }
    }
    __syncthreads();
    {
        const int lane = tid & 63, wave = tid >> 6;
        const f32x4m g4 = ((const GAS f32x4m*)ln_g)[lane], b4 = ((const GAS f32x4m*)ln_b)[lane];
        gu32x2 zpre[8];
#pragma unroll
        for (int i = 0; i < 8; ++i) zpre[i] = *(const GAS gu32x2*)(U + (rowb + t0 + wave * 8 + i) * NU + C_CZ + lane * 4);
#pragma unroll
        for (int i = 0; i < 8; ++i) { const int t = wave * 8 + i;
            const f32x4m v = *(const MIX_LAS f32x4m*)(cv + t * 256 + lane * 4);
            float s1 = (v.x + v.y) + (v.z + v.w), s2 = (v.x * v.x + v.y * v.y) + (v.z * v.z + v.w * v.w);
#pragma unroll
            for (int o_ = 1; o_ < 64; o_ <<= 1) { s1 += __shfl_xor(s1, o_); s2 += __shfl_xor(s2, o_); }
            const float mu = s1 * (1.f / 256.f);
            const f32x4m d = v - mu;
            const float var = fmaxf(s2 * (1.f / 256.f) - mu * mu, 0.f);
            const float rs = rsqrtf(var + EPSF);
            const size_t m = rowb + t0 + t;
            const gu32x2 zw = zpre[i];
            const float n0 = d.x * rs * g4.x + b4.x, n1 = d.y * rs * g4.y + b4.y, n2 = d.z * rs * g4.z + b4.z, n3 = d.w * rs * g4.w + b4.w;
            gu32x2 o; o.x = pkbf(siluf_(n0) * siluf_(__uint_as_float(zw.x << 16)), siluf_(n1) * siluf_(__uint_as_float(zw.x & 0xffff0000u)));
            o.y = pkbf(siluf_(n2) * siluf_(__uint_as_float(zw.y << 16)), siluf_(n3) * siluf_(__uint_as_float(zw.y & 0xffff0000u)));
            *(GAS gu32x2*)(Y + m * NY + 1 * NW + lane * 4) = o; }
    }
    __syncthreads();
}
__device__ __forceinline__ void shortconv_item(int item, const GAS bf16_t* U, const GAS float* w, GAS bf16_t* Y, int tid) {
    const int tt = item & 63, b = item >> 6; const size_t rowb = (size_t)b * NS;
    const int ch = tid & 31, tl = tid >> 5, t0 = tt * 64 + tl * 4;
    u32x4m cr[6], vr[6], br[4], zr[4];
#pragma unroll
    for (int r = 0; r < 6; ++r) { const int t = t0 - 1 + r; cr[r] = (u32x4m){0u, 0u, 0u, 0u}; vr[r] = cr[r];
        if (t >= 0 && t < NS) { const GAS bf16_t* p = U + (rowb + t) * NU; cr[r] = *(const GAS u32x4m*)(p + C_SC + ch * 8); vr[r] = *(const GAS u32x4m*)(p + C_SV + ch * 8); } }
#pragma unroll
    for (int i = 0; i < 4; ++i) { const GAS bf16_t* p = U + (rowb + t0 + i) * NU; br[i] = *(const GAS u32x4m*)(p + C_SB + ch * 8); zr[i] = *(const GAS u32x4m*)(p + C_SZ + ch * 8); }
    float w0[8], w1[8], w2[8];
#pragma unroll
    for (int e = 0; e < 8; ++e) { w0[e] = w[ch * 8 + e]; w1[e] = w[256 + ch * 8 + e]; w2[e] = w[512 + ch * 8 + e]; }
    asm volatile("" ::: "memory");
    float cv[6][8];
#pragma unroll
    for (int r = 0; r < 6; ++r) { const unsigned aw[4] = {cr[r].x, cr[r].y, cr[r].z, cr[r].w}, vw[4] = {vr[r].x, vr[r].y, vr[r].z, vr[r].w};
#pragma unroll
        for (int e = 0; e < 4; ++e) { cv[r][2 * e] = __uint_as_float(aw[e] << 16) * __uint_as_float(vw[e] << 16); cv[r][2 * e + 1] = __uint_as_float(aw[e] & 0xffff0000u) * __uint_as_float(vw[e] & 0xffff0000u); } }
#pragma unroll
    for (int i = 0; i < 4; ++i) {
        const unsigned bw[4] = {br[i].x, br[i].y, br[i].z, br[i].w}, zw[4] = {zr[i].x, zr[i].y, zr[i].z, zr[i].w}; unsigned ow[4];
#pragma unroll
        for (int e = 0; e < 4; ++e) {
            const float c0 = w0[2 * e] * cv[i][2 * e] + w1[2 * e] * cv[i + 1][2 * e] + w2[2 * e] * cv[i + 2][2 * e];
            const float c1 = w0[2 * e + 1] * cv[i][2 * e + 1] + w1[2 * e + 1] * cv[i + 1][2 * e + 1] + w2[2 * e + 1] * cv[i + 2][2 * e + 1];
            ow[e] = pkbf(__uint_as_float(bw[e] << 16) * c0 * siluf_(__uint_as_float(zw[e] << 16)), __uint_as_float(bw[e] & 0xffff0000u) * c1 * siluf_(__uint_as_float(zw[e] & 0xffff0000u))); }
        *(GAS u32x4m*)(Y + (rowb + t0 + i) * NY + 2 * NW + ch * 8) = (u32x4m){ow[0], ow[1], ow[2], ow[3]};
    }
}

constexpr size_t HG_ST_BYTES = (size_t)NB * 4 * 2 * 64 * 8192;
constexpr int H1_WLDS = 10240, H3_WLDS = 14848;
__device__ __forceinline__ void wave_lds_sync() { asm volatile("s_waitcnt lgkmcnt(0)" ::: "memory"); __builtin_amdgcn_wave_barrier(); asm volatile("" ::: "memory"); }
__device__ __forceinline__ void hgrn_gate(float fl, float lb, float& f, float& g) { const float s = __builtin_amdgcn_rcpf(1.f + __expf(-fl)); f = lb + (1.f - lb) * s; g = __builtin_amdgcn_logf(f) * 0.69314718056f; }
typedef unsigned u32x4h __attribute__((ext_vector_type(4)));

__device__ __forceinline__ void hgrn_h1_item(int item, const GAS bf16_t* U, const GAS float* LBl, GAS unsigned char* ST, GAS float* DC, MIX_LAS unsigned char* wl, int lane) {
    const int j = item & 63, dir = (item >> 6) & 1, h = (item >> 7) & 3, b = item >> 9;
    const int c = dir ? 63 - j : j;
    const size_t row0 = (size_t)b * NS + (size_t)c * 64;
    const int fcol = (dir ? C_HFB : C_HFF) + h * 64 + lane, vcol = C_HI + h * 64 + lane;
    const float lb = LBl[dir * 256 + h * 64 + lane];
    const int r32 = lane & 31, hi = lane >> 5;
    MIX_LAS unsigned char* KT = wl; MIX_LAS unsigned char* VT = wl + 5120;
    f32x16_t acc[2][2];
#pragma unroll
    for (int a = 0; a < 2; ++a)
#pragma unroll
        for (int bb = 0; bb < 2; ++bb)
#pragma unroll
            for (int r = 0; r < 16; ++r) acc[a][bb][r] = 0.f;
    float rsum = 0.f;
#pragma unroll
    for (int half = 0; half < 2; ++half) {
        unsigned kw[16], vw[16], fr[32], vr[32];
#pragma unroll
        for (int i = 0; i < 32; ++i) {
            const int tau = 63 - 32 * half - i, u = dir ? 63 - tau : tau;
            const GAS bf16_t* p = U + (row0 + u) * NU; fr[i] = p[fcol]; vr[i] = p[vcol];
        }
        asm volatile("" ::: "memory");
#pragma unroll
        for (int pr = 0; pr < 16; ++pr) {
            float f, g;
            hgrn_gate(__uint_as_float(fr[2 * pr] << 16), lb, f, g); const float k_hi = (1.f - f) * __expf(rsum); rsum += g;
            hgrn_gate(__uint_as_float(fr[2 * pr + 1] << 16), lb, f, g); const float k_lo = (1.f - f) * __expf(rsum); rsum += g;
            kw[15 - pr] = pkbf(k_lo, k_hi);
            vw[15 - pr] = vr[2 * pr + 1] | (vr[2 * pr] << 16);
        }
#pragma unroll
        for (int g8 = 0; g8 < 4; ++g8) {
            *(MIX_LAS u32x4h*)(KT + lane * 80 + g8 * 16) = (u32x4h){kw[4 * g8], kw[4 * g8 + 1], kw[4 * g8 + 2], kw[4 * g8 + 3]};
            *(MIX_LAS u32x4h*)(VT + lane * 80 + g8 * 16) = (u32x4h){vw[4 * g8], vw[4 * g8 + 1], vw[4 * g8 + 2], vw[4 * g8 + 3]};
        }
        wave_lds_sync();
#pragma unroll
        for (int s = 0; s < 2; ++s) {
            bf16x8_t af[2], bfr[2];
#pragma unroll
            for (int x = 0; x < 2; ++x) { af[x] = *(const MIX_LAS bf16x8_t*)(KT + (r32 + 32 * x) * 80 + (16 * s + 8 * hi) * 2); bfr[x] = *(const MIX_LAS bf16x8_t*)(VT + (r32 + 32 * x) * 80 + (16 * s + 8 * hi) * 2); }
#pragma unroll
            for (int kt = 0; kt < 2; ++kt)
#pragma unroll
                for (int vt = 0; vt < 2; ++vt) acc[kt][vt] = __builtin_amdgcn_mfma_f32_32x32x16_bf16(af[kt], bfr[vt], acc[kt][vt], 0, 0, 0);
        }
        wave_lds_sync();
    }
    DC[(size_t)item * 64 + lane] = __expf(rsum);
    GAS unsigned char* out = ST + (size_t)item * 8192;
#pragma unroll
    for (int kt = 0; kt < 2; ++kt)
#pragma unroll
        for (int vt = 0; vt < 2; ++vt)
#pragma unroll
            for (int g4 = 0; g4 < 4; ++g4) { const int k0 = 32 * kt + 8 * g4 + 4 * hi, v = 32 * vt + r32;
                gu32x2 w; w.x = pkbf(acc[kt][vt][4 * g4], acc[kt][vt][4 * g4 + 1]); w.y = pkbf(acc[kt][vt][4 * g4 + 2], acc[kt][vt][4 * g4 + 3]);
                *(GAS gu32x2*)(out + (v * 64 + k0) * 2) = w; }
}

__device__ __forceinline__ void hgrn_h2_item(int item, GAS unsigned char* ST, const GAS float* DC, int tid) {
    const int seq = item >> 2, e = (item & 3) * 512 + tid, kp = e & 31;
    GAS unsigned char* base = ST + (size_t)seq * 64 * 8192 + (size_t)e * 4;
    const GAS float* dcb = DC + (size_t)seq * 64 * 64 + kp * 2;
    float s0 = 0.f, s1 = 0.f;
    for (int j0 = 0; j0 < 64; j0 += 16) {
        unsigned hc[16]; gf32x2 dc[16];
#pragma unroll
        for (int jj = 0; jj < 16; ++jj) { hc[jj] = *(const GAS unsigned*)(base + (size_t)(j0 + jj) * 8192); dc[jj] = *(const GAS gf32x2*)(dcb + (j0 + jj) * 64); }
#pragma unroll
        for (int jj = 0; jj < 16; ++jj) {
            *(GAS unsigned*)(base + (size_t)(j0 + jj) * 8192) = pkbf(s0, s1);
            s0 = dc[jj].x * s0 + __uint_as_float(hc[jj] << 16); s1 = dc[jj].y * s1 + __uint_as_float(hc[jj] & 0xffff0000u);
        }
    }
}

template <int DIR>
__device__ __forceinline__ void hgrn_h3_dir(f32x16_t (&O)[2][2], const GAS bf16_t* U_, size_t row0, int h, float lb, const GAS unsigned char* Sp, MIX_LAS unsigned char* wl, int lane) {
    const GAS bf16_t* U = U_; asm volatile("" : "+s"(U));
    const int r32 = lane & 31, hi = lane >> 5;
    MIX_LAS unsigned char* Ql = wl; MIX_LAS unsigned char* Kl = wl + 4608; MIX_LAS unsigned char* VTl = wl + 9216; MIX_LAS float* decl = (MIX_LAS float*)(wl + 14336);
    const int fcol = (DIR ? C_HFB : C_HFF) + h * 64 + lane, qcol = C_HQ + h * 64 + lane, vcol = C_HI + h * 64 + lane;
    bf16x8_t kfA[4], vfA[2][2];
#pragma unroll
    for (int sub = 0; sub < 2; ++sub) {
        constexpr int dummy = 0; (void)dummy;
        const int tile = DIR ? 1 - sub : sub;
        float a = 0.f; unsigned vw[16];
        {
            unsigned fr[32], qr[32], vr[32];
#pragma unroll
            for (int x = 0; x < 32; ++x) { const int ul = DIR ? 31 - x : x;
                const GAS bf16_t* p = U + (row0 + 32 * tile + ul) * NU; fr[x] = p[fcol]; qr[x] = p[qcol]; vr[x] = p[vcol]; }
            asm volatile("" ::: "memory");
#pragma unroll
            for (int pr = 0; pr < 16; ++pr) {
#pragma unroll
                for (int x = 0; x < 2; ++x) {
                    const int i = 2 * pr + x, ul = DIR ? 31 - i : i;
                    float f, g; hgrn_gate(__uint_as_float(fr[i] << 16), lb, f, g); a += g;
                    const float qa = __uint_as_float(qr[i] << 16) * __expf(a), ka = (1.f - f) * __expf(fminf(-a, 80.f));
                    *(MIX_LAS unsigned short*)(Ql + ul * 144 + lane * 2) = (unsigned short)(pkbf(qa, 0.f) & 0xffffu);
                    *(MIX_LAS unsigned short*)(Kl + ul * 144 + lane * 2) = (unsigned short)(pkbf(ka, 0.f) & 0xffffu);
                }
                const int ul_even = DIR ? 30 - 2 * pr : 2 * pr;
                const int pe = (ul_even & 0x13) | ((ul_even & 4) << 1) | ((ul_even & 8) >> 1);
                vw[pe >> 1] = DIR ? (vr[2 * pr + 1] | (vr[2 * pr] << 16)) : (vr[2 * pr] | (vr[2 * pr + 1] << 16));
            }
        }
        decl[sub * 64 + lane] = __expf(a);
#pragma unroll
        for (int g8 = 0; g8 < 4; ++g8) *(MIX_LAS u32x4h*)(VTl + lane * 80 + g8 * 16) = (u32x4h){vw[4 * g8], vw[4 * g8 + 1], vw[4 * g8 + 2], vw[4 * g8 + 3]};
        wave_lds_sync();
        bf16x8_t qf[4], kf[4], vf[2][2];
#pragma unroll
        for (int ds = 0; ds < 4; ++ds) { qf[ds] = *(const MIX_LAS bf16x8_t*)(Ql + r32 * 144 + ds * 32 + hi * 16); kf[ds] = *(const MIX_LAS bf16x8_t*)(Kl + r32 * 144 + ds * 32 + hi * 16); }
#pragma unroll
        for (int vt = 0; vt < 2; ++vt)
#pragma unroll
            for (int s = 0; s < 2; ++s) vf[vt][s] = *(const MIX_LAS bf16x8_t*)(VTl + (r32 + 32 * vt) * 80 + (16 * s + 8 * hi) * 2);
        f32x16_t P;
#pragma unroll
        for (int r = 0; r < 16; ++r) P[r] = 0.f;
#pragma unroll
        for (int ds = 0; ds < 4; ++ds) P = __builtin_amdgcn_mfma_f32_32x32x16_bf16(kf[ds], qf[ds], P, 0, 0, 0);
#pragma unroll
        for (int r = 0; r < 16; ++r) { const int s_ = crow_(r, hi); const bool keep = DIR ? (s_ >= r32) : (s_ <= r32); P[r] = keep ? P[r] : 0.f; }
        {
            u32x4h p0, p1;
            p0.x = pkbf(P[0], P[1]); p0.y = pkbf(P[2], P[3]); p0.z = pkbf(P[4], P[5]); p0.w = pkbf(P[6], P[7]);
            p1.x = pkbf(P[8], P[9]); p1.y = pkbf(P[10], P[11]); p1.z = pkbf(P[12], P[13]); p1.w = pkbf(P[14], P[15]);
            const bf16x8_t pf0 = __builtin_bit_cast(bf16x8_t, p0), pf1 = __builtin_bit_cast(bf16x8_t, p1);
#pragma unroll
            for (int vt = 0; vt < 2; ++vt) { O[vt][tile] = __builtin_amdgcn_mfma_f32_32x32x16_bf16(vf[vt][0], pf0, O[vt][tile], 0, 0, 0); O[vt][tile] = __builtin_amdgcn_mfma_f32_32x32x16_bf16(vf[vt][1], pf1, O[vt][tile], 0, 0, 0); }
        }
        if (sub == 0) {
#pragma unroll
            for (int vt = 0; vt < 2; ++vt)
#pragma unroll
                for (int ks = 0; ks < 4; ++ks) { const bf16x8_t sf = *(const GAS bf16x8_t*)(Sp + ((r32 + 32 * vt) * 64 + 16 * ks + 8 * hi) * 2);
                    O[vt][tile] = __builtin_amdgcn_mfma_f32_32x32x16_bf16(sf, qf[ks], O[vt][tile], 0, 0, 0); }
#pragma unroll
            for (int ds = 0; ds < 4; ++ds) kfA[ds] = kf[ds];
#pragma unroll
            for (int vt = 0; vt < 2; ++vt) { vfA[vt][0] = vf[vt][0]; vfA[vt][1] = vf[vt][1]; }
        } else {
            bf16x8_t qd[4];
#pragma unroll
            for (int ds = 0; ds < 4; ++ds) {
                const f32x4m d0 = *(const MIX_LAS f32x4m*)(decl + 16 * ds + 8 * hi), d1 = *(const MIX_LAS f32x4m*)(decl + 16 * ds + 8 * hi + 4);
                const u32x4h qw = __builtin_bit_cast(u32x4h, qf[ds]); u32x4h o;
                o.x = pkbf(__uint_as_float(qw.x << 16) * d0.x, __uint_as_float(qw.x & 0xffff0000u) * d0.y); o.y = pkbf(__uint_as_float(qw.y << 16) * d0.z, __uint_as_float(qw.y & 0xffff0000u) * d0.w);
                o.z = pkbf(__uint_as_float(qw.z << 16) * d1.x, __uint_as_float(qw.z & 0xffff0000u) * d1.y); o.w = pkbf(__uint_as_float(qw.w << 16) * d1.z, __uint_as_float(qw.w & 0xffff0000u) * d1.w);
                qd[ds] = __builtin_bit_cast(bf16x8_t, o);
            }
            f32x16_t P2;
#pragma unroll
            for (int r = 0; r < 16; ++r) P2[r] = 0.f;
#pragma unroll
            for (int ds = 0; ds < 4; ++ds) P2 = __builtin_amdgcn_mfma_f32_32x32x16_bf16(kfA[ds], qd[ds], P2, 0, 0, 0);
            u32x4h p0, p1;
            p0.x = pkbf(P2[0], P2[1]); p0.y = pkbf(P2[2], P2[3]); p0.z = pkbf(P2[4], P2[5]); p0.w = pkbf(P2[6], P2[7]);
            p1.x = pkbf(P2[8], P2[9]); p1.y = pkbf(P2[10], P2[11]); p1.z = pkbf(P2[12], P2[13]); p1.w = pkbf(P2[14], P2[15]);
            const bf16x8_t pf0 = __builtin_bit_cast(bf16x8_t, p0), pf1 = __builtin_bit_cast(bf16x8_t, p1);
#pragma unroll
            for (int vt = 0; vt < 2; ++vt) { O[vt][tile] = __builtin_amdgcn_mfma_f32_32x32x16_bf16(vfA[vt][0], pf0, O[vt][tile], 0, 0, 0); O[vt][tile] = __builtin_amdgcn_mfma_f32_32x32x16_bf16(vfA[vt][1], pf1, O[vt][tile], 0, 0, 0); }
#pragma unroll
            for (int vt = 0; vt < 2; ++vt)
#pragma unroll
                for (int ks = 0; ks < 4; ++ks) { const bf16x8_t sf = *(const GAS bf16x8_t*)(Sp + ((r32 + 32 * vt) * 64 + 16 * ks + 8 * hi) * 2);
                    O[vt][tile] = __builtin_amdgcn_mfma_f32_32x32x16_bf16(sf, qd[ks], O[vt][tile], 0, 0, 0); }
        }
        wave_lds_sync();
    }
}
__device__ __forceinline__ void hgrn_h3_item(int item, const GAS bf16_t* U, const GAS float* LBl, const GAS float* onorm, const GAS unsigned char* ST, GAS bf16_t* Y, MIX_LAS unsigned char* wl, int lane) {
    const int c = item & 63, h = (item >> 6) & 3, b = item >> 8;
    const int r32 = lane & 31, hi = lane >> 5;
    const size_t row0 = (size_t)b * NS + (size_t)c * 64;
    f32x16_t O[2][2];
#pragma unroll
    for (int a = 0; a < 2; ++a)
#pragma unroll
        for (int bb = 0; bb < 2; ++bb)
#pragma unroll
            for (int r = 0; r < 16; ++r) O[a][bb][r] = 0.f;
    const size_t s_f = ((size_t)((b * 4 + h) * 2 + 0) * 64 + c), s_b = ((size_t)((b * 4 + h) * 2 + 1) * 64 + (63 - c));
    hgrn_h3_dir<0>(O, U, row0, h, LBl[0 * 256 + h * 64 + lane], ST + s_f * 8192, wl, lane);
    hgrn_h3_dir<1>(O, U, row0, h, LBl[1 * 256 + h * 64 + lane], ST + s_b * 8192, wl, lane);
    gu32x2 zpre[2][2][4]; f32x4m onv[2][4];
#pragma unroll
    for (int vt = 0; vt < 2; ++vt)
#pragma unroll
        for (int g4 = 0; g4 < 4; ++g4) { const int v0 = 32 * vt + 8 * g4 + 4 * hi; onv[vt][g4] = *(const GAS f32x4m*)(onorm + v0);
#pragma unroll
            for (int tile = 0; tile < 2; ++tile) zpre[tile][vt][g4] = *(const GAS gu32x2*)(U + (row0 + 32 * tile + r32) * NU + C_HZ + h * 64 + v0); }
    asm volatile("" ::: "memory");
#pragma unroll
    for (int tile = 0; tile < 2; ++tile) {
        float ss = 0.f;
#pragma unroll
        for (int vt = 0; vt < 2; ++vt)
#pragma unroll
            for (int r = 0; r < 16; ++r) ss += O[vt][tile][r] * O[vt][tile][r];
        ss += __shfl_xor(ss, 32);
        const float rs = rsqrtf(ss * (1.f / 64.f) + EPSF);
        const size_t m = row0 + 32 * tile + r32;
#pragma unroll
        for (int vt = 0; vt < 2; ++vt)
#pragma unroll
            for (int g4 = 0; g4 < 4; ++g4) { const int v0 = 32 * vt + 8 * g4 + 4 * hi;
                const gu32x2 zw = zpre[tile][vt][g4];
                const f32x4m on = onv[vt][g4];
                gu32x2 w;
                w.x = pkbf(O[vt][tile][4 * g4] * rs * on.x * siluf_(__uint_as_float(zw.x << 16)), O[vt][tile][4 * g4 + 1] * rs * on.y * siluf_(__uint_as_float(zw.x & 0xffff0000u)));
                w.y = pkbf(O[vt][tile][4 * g4 + 2] * rs * on.z * siluf_(__uint_as_float(zw.y << 16)), O[vt][tile][4 * g4 + 3] * rs * on.w * siluf_(__uint_as_float(zw.y & 0xffff0000u)));
                *(GAS gu32x2*)(Y + m * NY + h * 64 + v0) = w; }
    }
}
__global__ void __launch_bounds__(NWAVES * 64, 2) mk_fwd(Args a) {
    extern __shared__ __attribute__((aligned(16))) unsigned char lds_raw[];
    LAS unsigned char* lds = (LAS unsigned char*)lds_raw;
    volatile LAS unsigned* MISC = (volatile LAS unsigned*)(lds + MISC_OFF);
    const int wave_u = __builtin_amdgcn_readfirstlane((int)threadIdx.x >> 6);
    const int wave = wave_u;

    const int G = gridDim.x; const int bx = blockIdx.x; const int vcu = (G % 8 == 0) ? (bx % 8) * (G / 8) + bx / 8 : bx;
    const int gw = vcu * NWAVES + wave, NGW = G * NWAVES;
    unsigned char* ws = a.ws;
    for (int u = TID_(); u < (LDS_BYTES - LDSCTL_OFF) / 4; u += NWAVES * 64) ((LAS unsigned*)(lds + LDSCTL_OFF))[u] = 0u;
    __syncthreads();
    XcdBarrier bar = xcd_barrier_post((unsigned*)(ws + WS_CTL) + CW_BAR + a.li * XCD_BAR_WORDS, MISC + 8, wave_u);
    const int lo = a.ph_lo, hi = a.ph_hi;
#ifndef PROBE_DUP
#define PROBE_DUP -1
#endif
#ifndef PROBE_SUB
#define PROBE_SUB -1
#endif
#ifndef PROBE_TS
#define PROBE_TS -1
#endif
#define TS_BEGIN(k) do { if (PROBE_TS == (k) && l == 1 && bx == 0 && TID_() == 0) *(volatile unsigned*)(ws + 600 * 1024 + 64) = (unsigned)__builtin_amdgcn_s_memrealtime(); } while (0)
#define TS_END(k) do { if (PROBE_TS == (k) && l == 1 && bx == 0 && TID_() == 0) { *(volatile unsigned*)(ws + 600 * 1024) = (unsigned)__builtin_amdgcn_s_memrealtime() - *(volatile unsigned*)(ws + 600 * 1024 + 64); } } while (0)
#define REPS(k) ((PROBE_DUP == (k)) ? 2 : 1)
#define IN(k) (lo <= (k) && (k) < hi)
#define SEAM(k) do { if (IN(k) && IN((k) + 1)) { xcd_barrier(bar); if (PROBE_DUP == 200) xcd_barrier(bar); } } while (0)

#define DEFBUFS(wsp) bf16_t* const H = (bf16_t*)((wsp) + WS_H); bf16_t* const MG = (bf16_t*)((wsp) + WS_U + 160 * MiB); \
    bf16_t* const U = (bf16_t*)((wsp) + WS_U); bf16_t* const GB = (bf16_t*)((wsp) + WS_U); bf16_t* const OUTRAW = (bf16_t*)((wsp) + WS_U); \
    bf16_t* const Y = (bf16_t*)((wsp) + WS_Y); (void)H; (void)MG; (void)U; (void)GB; (void)OUTRAW; (void)Y;
    float* const X = a.out;

    if (IN(0)) for (int rep0 = 0; rep0 < (PROBE_DUP == 100 ? 2 : 1); ++rep0) {
        if (rep0) xcd_barrier(bar);
        DEFBUFS(ws)
        const int tid = TID_(), lane = tid & 63;
        if (bx == 0) {
            float* LB = (float*)(ws + WS_LB); float* BIAS = (float*)(ws + WS_BIAS); const float* lb_logits = a.in[5]; const float* rel_bias = a.in[13];
            { float v[NL], mx = -1e30f, s = 0.f;
#pragma unroll
                for (int l = 0; l < NL; ++l) { v[l] = lb_logits[l * 512 + tid]; mx = fmaxf(mx, v[l]); }
#pragma unroll
                for (int l = 0; l < NL; ++l) { v[l] = __expf(v[l] - mx); s += v[l]; }
                float c = 0.f;
#pragma unroll
                for (int l = 0; l < NL; ++l) { if (l > 0) c += v[l] / s; LB[l * 512 + tid] = c; } }
            for (int i = tid; i < 4 * 257; i += NWAVES * 64) {
                const int h = i / 257, rel = i % 257 - 128; int n = -rel; const int ret = (n < 0) ? 16 : 0; n = n < 0 ? -n : n;
                int bucket;
                if (n < 8) bucket = n; else if (n < 12) bucket = 8; else if (n < 16) bucket = 9; else if (n < 23) bucket = 10; else if (n < 32) bucket = 11;
                else if (n < 46) bucket = 12; else if (n < 64) bucket = 13; else if (n < 91) bucket = 14; else bucket = 15;
                BIAS[i] = rel_bias[(ret + bucket) * 4 + h]; }
        }
        if (wave & 4) x_to_bf16_rows(a.in[0], H, (float*)(ws + WS_RS), ws + WS_X8, (float*)(ws + WS_RQ), gw, NGW, lane);
        convert_weights(ws, a.in[4], a.in[16], a.in[17], a.in[18], a.in[2], 0, 3, lds, gw, NGW, wave, lane);
        {
            bf16_t* MEMN = (bf16_t*)(ws + WS_Y); bf16_t* WKV = (bf16_t*)(ws + WS_Y + 16 * MiB);
            for (int r = gw; r < NL * NB * MEML; r += NGW) { const int l = r / (NB * MEML), row = r - l * (NB * MEML);
                rms_row_to_bf16(a.in[1] + (size_t)row * ND, a.in[14] + l * ND, MEMN + (size_t)r * ND, lane); }
            LAS float* scr = (LAS float*)(lds + RING_OFF + wave * 16384);
            for (int it = gw; it < NL * 256; it += NGW) { const int l = it >> 8; transpose_item(a.in[15] + (size_t)l * ND * 512, ND, 512, WKV + (size_t)l * 512 * ND, scr, it & 255, lane); }
        }
        for (int it = gw; it < NL * 52 * 8; it += NGW) colmax_in_item(it, a.in[4], a.in[2], (float*)(ws + WS_CQI), lane);
        for (int it = gw; it < NL * 5 * 16 * 8; it += NGW) colmax_item(it, a.in[16], a.in[2], (float*)(ws + WS_CQ), lane);
        if (!(wave & 4)) x_to_bf16_rows(a.in[0], H, (float*)(ws + WS_RS), ws + WS_X8, (float*)(ws + WS_RQ), gw, NGW, lane);
        SEAM(0);
    }
    for (int l = 0; l < NL; ++l) {
        const int base = 1 + l * PH_PER_LAYER;
        unsigned char* wsl = ws; asm volatile("" : "+s"(wsl));
        DEFBUFS(wsl)
        if (IN(base + PH_A)) { TS_BEGIN(PH_A);
            pg8::Gemm g{H, (const bf16_t*)(wsl + WS_WIN), ND, ND, ND, 0u, 0u};
            unsigned char* WIN8 = wsl + WS_WIN + (size_t)NU_BF * ND * 2;
            if (l == 0) {
                const float* wi0 = a.in[4]; const float* np0 = a.in[2]; asm volatile("" : "+s"(wi0), "+s"(np0));
                convert_win8(wi0, np0, (const float*)(wsl + WS_CQI), WIN8, 0, lds, vcu * NWAVES + wave_u, NGW, wave_u, lane_id_());
                __syncthreads();
            }
            {
                pg8::TileOrder<1> S; S.init(NM, NU_BF, G, bx);
                pg8::EpiStore E{(GAS bf16_t*)U, NU, (const GAS float*)(wsl + WS_RS)};
                pg8::gemm_phase<pg8::EpiStore, pg8::TileOrder<1>, true>(lds + RING_OFF, g, S, E, wave_u);
            }
            if (l == 0) xcd_barrier(bar);
            {
                pg8::Gemm g8{(const bf16_t*)(wsl + WS_X8), (const bf16_t*)WIN8, ND / 2, ND / 2, ND / 2, 0u, 0u};
                pg8::TileOrder<1> S8; S8.init(NM, NU_I8, G, bx);
                pg8::EpiStoreQ E8{(GAS bf16_t*)U + NU_BF, NU, (const GAS float*)(wsl + WS_RQ), (const GAS float*)(wsl + WS_CQI) + (size_t)l * NU_I8};
                pg8::gemm_phase<pg8::EpiStoreQ, pg8::TileOrder<1>, true, true>(lds + RING_OFF, g8, S8, E8, wave_u);
            }
            if (l == 0) {
                const int u = bx - 128;
                pg8::OneUnit S2; S2.valid = (u >= 0 && u < 64); S2.u.pz = (u >> 4) & 3; S2.u.pm = (u >> 1) & 7; S2.u.pn = u & 1;
                pg8::Gemm g2{(const bf16_t*)(wsl + WS_Y), (const bf16_t*)(wsl + WS_Y + 16 * MiB), ND, ND, ND, (unsigned)(NB * MEML * ND * 2), (unsigned)(512 * ND * 2)};
                pg8::EpiStoreZ E2{(GAS bf16_t*)(wsl + WS_MEMKV), 512, (size_t)NB * MEML * 512};
                pg8::gemm_phase<pg8::EpiStoreZ, pg8::OneUnit, true>(lds + RING_OFF, g2, S2, E2, wave_u);
            }
            SEAM(base + PH_A); TS_END(PH_A);
        }
        if (IN(base + PH_M1)) { TS_BEGIN(PH_M1);
            int tl = TID_(); asm volatile("" : "+v"(tl));
            const float* cw = a.in[7]; const float* cb = a.in[8]; const float* cg = a.in[9]; const float* cbb = a.in[10]; const float* scw = a.in[11]; const float* snk = a.in[12];
            asm volatile("" : "+s"(cw), "+s"(cb), "+s"(cg), "+s"(cbb), "+s"(scw), "+s"(snk));
            const bf16_t* MKV = (const bf16_t*)(wsl + WS_MEMKV) + (size_t)l * NB * MEML * 512;
            const float* BIASp = (const float*)(wsl + WS_BIAS);
#define M1_WA for (int it = bx; it < 512; it += G) winattn_item(it, (const GAS bf16_t*)U, (const GAS float*)BIASp, (const GAS float*)(snk + l * 4), (GAS bf16_t*)Y, lds + RING_OFF, tl);
#define M1_MA for (int it = bx; it < 512; it += G) memattn_item(it, (const GAS bf16_t*)U, (const GAS bf16_t*)MKV, (GAS bf16_t*)Y, lds + RING_OFF, tl);
#define M1_CF for (int it = bx; it < 512; it += G) conformer_item(it, (const GAS bf16_t*)U, (const GAS float*)(cw + l * 31 * 256), (const GAS float*)(cb + l * 256), (const GAS float*)(cg + l * 256), (const GAS float*)(cbb + l * 256), (GAS bf16_t*)Y, lds + RING_OFF, tl);
#define M1_SC for (int it = bx; it < 512; it += G) shortconv_item(it, (const GAS bf16_t*)U, (const GAS float*)(scw + l * 3 * 256), (GAS bf16_t*)Y, tl);
#define M1_H1 { const float* LBl = (const float*)(wsl + WS_LB) + l * 512; unsigned char* ST = wsl + WS_ST; float* DC = (float*)(wsl + WS_ST + HG_ST_BYTES); \
                const int lane = tl & 63, wave = __builtin_amdgcn_readfirstlane(tl >> 6); \
                for (int it = bx * 8 + wave; it < 4096; it += G * 8) hgrn_h1_item(it, (const GAS bf16_t*)U, (const GAS float*)LBl, (GAS unsigned char*)ST, (GAS float*)DC, lds + RING_OFF + wave * H1_WLDS, lane); }
#if PROBE_DUP == 1 && PROBE_SUB == 10
            for (int it = bx; it < 512; it += G) winattn_item(it, (const GAS bf16_t*)U, (const GAS float*)BIASp, (const GAS float*)(snk + l * 4), (GAS bf16_t*)Y, lds + RING_OFF, tl, false);
#endif
            M1_WA
#if PROBE_DUP == 1 && PROBE_SUB == 0
            M1_WA
#endif
            M1_MA
#if PROBE_DUP == 1 && PROBE_SUB == 1
            M1_MA
#endif
            M1_CF
#if PROBE_DUP == 1 && PROBE_SUB == 2
            M1_CF
#endif
            M1_SC
#if PROBE_DUP == 1 && PROBE_SUB == 3
            M1_SC
#endif
            M1_H1
#if PROBE_DUP == 1 && PROBE_SUB == 4
            __syncthreads();
            M1_H1
#endif
            SEAM(base + PH_M1); TS_END(PH_M1);
        }
        if (IN(base + PH_M2)) { TS_BEGIN(PH_M2);
            int tl = TID_(); asm volatile("" : "+v"(tl));
            unsigned char* ST = wsl + WS_ST; const float* DC = (const float*)(wsl + WS_ST + HG_ST_BYTES);
            for (int it = bx; it < 256; it += G) hgrn_h2_item(it, (GAS unsigned char*)ST, (const GAS float*)DC, tl);
            {
                const float* wgt = a.in[16]; const float* npre = a.in[2]; asm volatile("" : "+s"(wgt), "+s"(npre));
                convert_wg8(wgt, npre, (const float*)(wsl + WS_CQ), wsl + WS_WG8, l, lds, vcu * NWAVES + wave_u, NGW, wave_u, tl & 63);
            }
            if (PROBE_DUP == PH_M2) {
                xcd_barrier(bar);
                const float* LBl = (const float*)(wsl + WS_LB) + l * 512; const int lane = tl & 63, wave = __builtin_amdgcn_readfirstlane(tl >> 6);
                for (int it = bx * 8 + wave; it < 4096; it += G * 8) hgrn_h1_item(it, (const GAS bf16_t*)U, (const GAS float*)LBl, (GAS unsigned char*)ST, (GAS float*)DC, lds + RING_OFF + wave * H1_WLDS, lane);
                xcd_barrier(bar);
                for (int it = bx; it < 256; it += G) hgrn_h2_item(it, (GAS unsigned char*)ST, (const GAS float*)DC, tl);
            }
            SEAM(base + PH_M2); TS_END(PH_M2);
        }
        if (IN(base + PH_M3)) { TS_BEGIN(PH_M3);
            int tl = TID_(); asm volatile("" : "+v"(tl));
            const float* onp = a.in[6]; asm volatile("" : "+s"(onp));
            const float* LBl = (const float*)(wsl + WS_LB) + l * 512; const unsigned char* ST = wsl + WS_ST;
            const int lane = tl & 63, wave = __builtin_amdgcn_readfirstlane(tl >> 6);
            for (int rep = 0; rep < REPS(PH_M3); ++rep)
            for (int it = bx * 8 + wave; it < 2048; it += G * 8) hgrn_h3_item(it, (const GAS bf16_t*)U, (const GAS float*)LBl, (const GAS float*)(onp + l * 64), (const GAS unsigned char*)ST, (GAS bf16_t*)Y, lds + RING_OFF + wave * H3_WLDS, lane);
            SEAM(base + PH_M3); TS_END(PH_M3);
        }
        if (IN(base + PH_G)) { TS_BEGIN(PH_G);
            GAS bf16_t* GS = (GAS bf16_t*)(wsl + WS_U) + (size_t)bx * (5 * pg8::GS_SLOT);
            for (int ti = 0; ti * G + bx < (NM / 256) * (ND / 256); ++ti) {
                { pg8::Gemm g{(const bf16_t*)(wsl + WS_X8), (const bf16_t*)(wsl + WS_WG8), ND / 2, ND / 2, ND / 2, 0u, (unsigned)(ND * ND)};
                  pg8::TileRound<5> S; S.T.init(NM, ND, G, bx); S.ti = ti;
                  pg8::EpiGate E{GS, (const GAS float*)(wsl + WS_RQ), (const GAS float*)(wsl + WS_CQ) + (size_t)l * 5120};
                  pg8::gemm_phase<pg8::EpiGate, pg8::TileRound<5>, true, true>(lds + RING_OFF, g, S, E, wave_u); }
                { pg8::Gemm g{Y, (const bf16_t*)(wsl + WS_WB), NY, NW, NW, (unsigned)(NW * 2), (unsigned)(ND * NW * 2)};
                  pg8::TileRound<5> S; S.T.init(NM, ND, G, bx); S.ti = ti;
                  pg8::EpiMerge E{GS, (GAS bf16_t*)MG};
                  pg8::gemm_phase<pg8::EpiMerge, pg8::TileRound<5>, true>(lds + RING_OFF, g, S, E, wave_u); }
            }
        }
        if (IN(base + PH_C)) { SEAM(base + PH_C); TS_END(PH_G); }
        if (IN(base + PH_D)) { TS_BEGIN(PH_D);
            pg8::Gemm g{MG, (const bf16_t*)(wsl + WS_WO), ND, ND, ND, 0u, 0u};
            pg8::TileOrder<1> S; S.init(NM, ND, G, bx);
            pg8::EpiStoreZ E{(GAS bf16_t*)OUTRAW, ND, (size_t)0};
            for (int rep = 0; rep < REPS(PH_D); ++rep) { pg8::gemm_phase<pg8::EpiStoreZ, pg8::TileOrder<1>, true>(lds + RING_OFF, g, S, E, wave_u); if (rep + 1 < REPS(PH_D)) xcd_barrier(bar); }
            SEAM(base + PH_D); TS_END(PH_D);
        }
        if (IN(base + PH_T)) { TS_BEGIN(PH_T);
            int tl = TID_(); asm volatile("" : "+v"(tl)); const int lane = tl & 63, wave = __builtin_amdgcn_readfirstlane(tl >> 6), gw = vcu * NWAVES + wave;
            const float* npre = a.in[2]; const float* npost = a.in[3]; float* Xl = X;
            const float* wi = a.in[4]; const float* wgt = a.in[16]; const float* wbr = a.in[17]; const float* wou = a.in[18];
            asm volatile("" : "+s"(npre), "+s"(npost), "+s"(Xl), "+s"(wi), "+s"(wgt), "+s"(wbr), "+s"(wou));
            const bool has_next = (l + 1 < NL);
            post_rows_bf(H, OUTRAW, npost + l * ND, Xl, (float*)(wsl + WS_RS), wsl + WS_X8, (float*)(wsl + WS_RQ), !has_next, gw, NGW, lane);
            if (has_next) { convert_weights(wsl, wi, wgt, wbr, wou, npre, l + 1, 3, lds, gw, NGW, wave, lane);
                convert_win8(wi, npre, (const float*)(wsl + WS_CQI), wsl + WS_WIN + (size_t)NU_BF * ND * 2, l + 1, lds, gw, NGW, wave, lane); SEAM(base + PH_T); TS_END(PH_T); }
        }
    }
    if (PROBE_TS >= 0) {
        xcd_barrier(bar);
        const unsigned ticks = __hip_atomic_load((unsigned*)(ws + 600 * 1024), __ATOMIC_RELAXED, __HIP_MEMORY_SCOPE_AGENT);
        const float sc = 1.f + sqrtf((float)((ticks + 800u) / 1600u) * 1e-3f);
        for (size_t i = (size_t)bx * 512 + TID_(); i < (size_t)NM * ND / 4; i += (size_t)G * 512) { f32x4_t v = ((GAS f32x4_t*)X)[i]; v = v * sc; ((GAS f32x4_t*)X)[i] = v; }
    }
#undef IN
#undef SEAM
}

extern "C" void kernel_launch(void* const* d_in, const int* in_sizes, int n_in, void* d_out, int out_size, void* d_ws, size_t ws_size, hipStream_t stream) {
    static int grid = 0;
    if (grid == 0) {
        if (n_in != 19 || in_sizes[0] != NM * ND || out_size != NM * ND || ws_size < WS_END) {
            fprintf(stderr, "kernel_launch: unexpected shapes/workspace (n_in %d, in0 %d, out %d, ws %zu, need %zu)\n", n_in, n_in > 0 ? in_sizes[0] : -1, out_size, ws_size, (size_t)WS_END);
            grid = -1; return;
        }
        int dev = 0, cus = 0, per_cu = 0;
        if (hipGetDevice(&dev) != hipSuccess || hipDeviceGetAttribute(&cus, hipDeviceAttributeMultiprocessorCount, dev) != hipSuccess) { grid = -1; return; }
        if (hipFuncSetAttribute((const void*)mk_fwd, hipFuncAttributeMaxDynamicSharedMemorySize, LDS_BYTES) != hipSuccess) { fprintf(stderr, "kernel_launch: hipFuncSetAttribute failed\n"); grid = -1; return; }
        if (hipOccupancyMaxActiveBlocksPerMultiprocessor(&per_cu, (const void*)mk_fwd, NWAVES * 64, LDS_BYTES) != hipSuccess || per_cu < 1)
            fprintf(stderr, "kernel_launch: occupancy query reports %d workgroups per CU\n", per_cu);
        (void)hipGetLastError();
        grid = cus;
    }
    if (grid < 0) return;
    const float* x = (const float*)d_in[0]; const float* mem = (const float*)d_in[1];
    const float* lb_logits = (const float*)d_in[5]; const float* hg_onorm = (const float*)d_in[6];
    const float* conf_dw_w = (const float*)d_in[7]; const float* conf_dw_b = (const float*)d_in[8]; const float* conf_ln_g = (const float*)d_in[9]; const float* conf_ln_b = (const float*)d_in[10];
    const float* sc_w = (const float*)d_in[11]; const float* attn_sink = (const float*)d_in[12]; const float* rel_bias = (const float*)d_in[13];
    const float* mem_norm = (const float*)d_in[14]; const float* w_mem_kv = (const float*)d_in[15];
    unsigned char* ws = (unsigned char*)d_ws;
    float* LB = (float*)(ws + WS_LB); float* BIAS = (float*)(ws + WS_BIAS);
    bf16_t* MEMKV = (bf16_t*)(ws + WS_MEMKV); bf16_t* U = (bf16_t*)(ws + WS_U);
    bf16_t* Y = (bf16_t*)(ws + WS_Y); bf16_t* OHG = (bf16_t*)(ws + WS_ST);
    (void)x; (void)mem; (void)lb_logits; (void)rel_bias; (void)mem_norm; (void)w_mem_kv; (void)LB; (void)BIAS; (void)MEMKV; (void)hg_onorm; (void)U; (void)Y; (void)OHG; (void)conf_dw_w; (void)conf_dw_b; (void)conf_ln_g; (void)conf_ln_b; (void)sc_w; (void)attn_sink;

    if (hipMemsetAsync(ws + WS_CTL, 0, CTL_ZERO_BYTES, stream) != hipSuccess) return;
    Args a{};
    for (int i = 0; i < 19; ++i) a.in[i] = (const float*)d_in[i];
    a.out = (float*)d_out; a.ws = ws;
    int li = 0;
    auto launch = [&](int lo, int hi) {
        a.ph_lo = lo; a.ph_hi = hi; a.li = li++; a.pad = 0;
        hipLaunchKernelGGL(mk_fwd, dim3(grid), dim3(NWAVES * 64), LDS_BYTES, stream, a);
    };
    launch(0, PH_TOTAL);
}
```

```cpp
#include <hip/hip_runtime.h>
#include <cstdio>
#include <cstdint>
#include <cmath>

typedef unsigned short bf16_t;
__device__ __forceinline__ float shx_(float v, int o) {
    const int i = __float_as_int(v); int r;
    switch (o) {
        case 1:  r = __builtin_amdgcn_ds_swizzle(i, (1 << 10) | 0x1f); break;
        case 2:  r = __builtin_amdgcn_ds_swizzle(i, (2 << 10) | 0x1f); break;
        case 4:  r = __builtin_amdgcn_ds_swizzle(i, (4 << 10) | 0x1f); break;
        case 8:  r = __builtin_amdgcn_ds_swizzle(i, (8 << 10) | 0x1f); break;
        case 16: r = __builtin_amdgcn_ds_swizzle(i, (16 << 10) | 0x1f); break;
        default: { int l; asm volatile("v_mbcnt_lo_u32_b32 %0, -1, 0\n\tv_mbcnt_hi_u32_b32 %0, -1, %0" : "=v"(l)); r = __builtin_amdgcn_ds_bpermute((l ^ 32) << 2, i); } break;
    }
    return __int_as_float(r);
}
#define __shfl_xor(v, o) shx_((v), (o))
#define GAS __attribute__((address_space(1)))
typedef unsigned gu32x4 __attribute__((ext_vector_type(4)));
typedef unsigned gu32x2 __attribute__((ext_vector_type(2)));
typedef float gf32x4 __attribute__((ext_vector_type(4)));
typedef float gf32x2 __attribute__((ext_vector_type(2)));

constexpr int NB = 8, NS = 4096, ND = 1024, NL = 4, NM = NB * NS, NW = 256, NU = 4352, NY = 1280;
constexpr int NU_BF = 1024, NU_I8 = 4352 - 1024;
constexpr int MEML = 256;
constexpr float EPSF = 1e-6f;
constexpr int C_HQ = 0, C_HFF = 256, C_HFB = 512, C_HI = 768, C_HZ = 1024, C_CA = 1280, C_CB = 1536, C_CZ = 1792,
              C_SB = 2048, C_SC = 2304, C_SV = 2560, C_SZ = 2816, C_AQ = 3072, C_AK = 3328, C_AV = 3456, C_AZ = 3584,
              C_MQ = 3840, C_MZ = 4096;

constexpr size_t MiB = 1u << 20;
constexpr size_t WS_CTL = 0;
constexpr size_t CTL_ZERO_BYTES = 512 * 1024;
constexpr size_t WS_CQI = 344 * 1024;
constexpr int NQI = NU_I8;
constexpr size_t WS_LB = 640 * 1024;
constexpr size_t WS_BIAS = 704 * 1024;
constexpr size_t WS_CQ = 400 * 1024;
constexpr size_t WS_RQ = 896 * 1024;
constexpr size_t WS_RS = 768 * 1024;
constexpr size_t WS_MEMKV = 1 * MiB;
constexpr size_t WS_WIN = 9 * MiB;
constexpr size_t WS_WG8 = WS_WIN + 4352u * 1024 * 2;
constexpr size_t WS_WB = WS_WG8 + 5120u * 1024;
constexpr size_t WS_WO = WS_WB + 5120u * 256 * 2;
constexpr size_t WS_H = 27 * MiB;
constexpr size_t WS_U = 91 * MiB;
constexpr size_t WS_ST = 363 * MiB;
constexpr size_t WS_Y = 397 * MiB;
constexpr size_t WS_X8 = 477 * MiB;
constexpr size_t WS_END = 509 * MiB;
static_assert(WS_WO + 1024u * 1024 * 2 <= WS_H, "weights fit");

__device__ __forceinline__ float bf2f(bf16_t v) { return __uint_as_float((unsigned)v << 16); }
__device__ __forceinline__ bf16_t f2bf(float f) { unsigned u = __float_as_uint(f); return (bf16_t)((u + 0x7fffu + ((u >> 16) & 1u)) >> 16); }
__device__ __forceinline__ float sigmoidf_(float x) { return __builtin_amdgcn_rcpf(1.f + __expf(-x)); }
__device__ __forceinline__ float siluf_(float x) { return x * __builtin_amdgcn_rcpf(1.f + __expf(-x)); }

__global__ void n_prep(const float* lb_logits, const float* rel_bias, float* LB, float* BIAS) {
    const int tid = threadIdx.x;
    {
        float v[NL], mx = -1e30f, s = 0.f;
        for (int l = 0; l < NL; ++l) { v[l] = lb_logits[l * 512 + tid]; mx = fmaxf(mx, v[l]); }
        for (int l = 0; l < NL; ++l) { v[l] = __expf(v[l] - mx); s += v[l]; }
        float c = 0.f;
        for (int l = 0; l < NL; ++l) { if (l > 0) c += v[l] / s; LB[l * 512 + tid] = c; }
    }
    for (int i = tid; i < 4 * 257; i += blockDim.x) {
        const int h = i / 257, rel = i % 257 - 128;
        int n = -rel; int ret = (n < 0) ? 16 : 0; n = n < 0 ? -n : n;
        int bucket;
        if (n < 8) bucket = n;
        else {
            int large;
            if (n < 12) large = 8; else if (n < 16) large = 9; else if (n < 23) large = 10; else if (n < 32) large = 11;
            else if (n < 46) large = 12; else if (n < 64) large = 13; else if (n < 91) large = 14; else large = 15;
            bucket = large;
        }
        BIAS[i] = rel_bias[(ret + bucket) * 4 + h];
    }
}

__global__ void n_rmsnorm_rows(const float* x, const float* g, bf16_t* out, int rows) {
    const int wave = (blockIdx.x * blockDim.x + threadIdx.x) >> 6, lane = threadIdx.x & 63;
    if (wave >= rows) return;
    const float* xr = x + (size_t)wave * ND;
    float v[16], s = 0.f;
#pragma unroll
    for (int j = 0; j < 16; ++j) { v[j] = xr[lane + 64 * j]; s += v[j] * v[j]; }
#pragma unroll
    for (int o = 1; o < 64; o <<= 1) s += __shfl_xor(s, o);
    const float r = rsqrtf(s * (1.f / ND) + EPSF);
#pragma unroll
    for (int j = 0; j < 16; ++j) out[(size_t)wave * ND + lane + 64 * j] = f2bf(v[j] * r * g[lane + 64 * j]);
}

__global__ void n_memkv(const float* mem, const float* mem_norm, const float* w, bf16_t* out) {
    __shared__ float row[ND]; __shared__ float red[8];
    const int r = blockIdx.x, l = blockIdx.y, tid = threadIdx.x;
    float s = 0.f;
    for (int i = tid; i < ND; i += 512) { float v = mem[(size_t)r * ND + i]; row[i] = v; s += v * v; }
#pragma unroll
    for (int o = 1; o < 64; o <<= 1) s += __shfl_xor(s, o);
    if ((tid & 63) == 0) red[tid >> 6] = s;
    __syncthreads();
    float tot = 0.f; for (int i = 0; i < 8; ++i) tot += red[i];
    const float rs = rsqrtf(tot * (1.f / ND) + EPSF);
    const float* g = mem_norm + l * ND; const float* wl = w + (size_t)l * ND * 512;
    float acc = 0.f;
    for (int k = 0; k < ND; ++k) acc += row[k] * g[k] * wl[(size_t)k * 512 + tid];
    out[((size_t)l * (NB * MEML) + r) * 512 + tid] = f2bf(acc * rs);
}

__global__ __launch_bounds__(256) void n_gemm(const bf16_t* A, int lda, const float* Wt, int ldw, bf16_t* C, int ldc, int K) {
    __shared__ float As[16][132]; __shared__ float Bs[16][132];
    const int tid = threadIdx.x, tx = tid & 15, ty = tid >> 4;
    const int row0 = blockIdx.y * 128, col0 = blockIdx.x * 128;
    float acc[8][8];
#pragma unroll
    for (int i = 0; i < 8; ++i)
#pragma unroll
        for (int j = 0; j < 8; ++j) acc[i][j] = 0.f;
    for (int k0 = 0; k0 < K; k0 += 16) {
#pragma unroll
        for (int it = 0; it < 8; ++it) { const int i = tid + it * 256, r = i >> 4, k = i & 15; As[k][r] = bf2f(A[(size_t)(row0 + r) * lda + k0 + k]); }
#pragma unroll
        for (int it = 0; it < 8; ++it) { const int i = tid + it * 256, k = i >> 7, c = i & 127; Bs[k][c] = Wt[(size_t)(k0 + k) * ldw + col0 + c]; }
        __syncthreads();
#pragma unroll
        for (int k = 0; k < 16; ++k) {
            float a[8], b[8];
#pragma unroll
            for (int i = 0; i < 8; ++i) { a[i] = As[k][ty * 8 + i]; b[i] = Bs[k][tx * 8 + i]; }
#pragma unroll
            for (int i = 0; i < 8; ++i)
#pragma unroll
                for (int j = 0; j < 8; ++j) acc[i][j] += a[i] * b[j];
        }
        __syncthreads();
    }
#pragma unroll
    for (int i = 0; i < 8; ++i)
#pragma unroll
        for (int j = 0; j < 8; ++j) C[(size_t)(row0 + ty * 8 + i) * ldc + col0 + tx * 8 + j] = f2bf(acc[i][j]);
}

__global__ __launch_bounds__(256) void n_merge(const bf16_t* H, const bf16_t* Y, const float* Wg, const float* Wb, bf16_t* MG) {
    __shared__ float As[16][68]; __shared__ float Bs[16][68];
    const int tid = threadIdx.x, tx = tid & 15, ty = tid >> 4;
    const int row0 = blockIdx.y * 64, col0 = blockIdx.x * 64;
    float mg[4][4];
#pragma unroll
    for (int i = 0; i < 4; ++i)
#pragma unroll
        for (int j = 0; j < 4; ++j) mg[i][j] = 0.f;
    for (int n = 0; n < 5; ++n) {
        float ag[4][4], ab[4][4];
#pragma unroll
        for (int i = 0; i < 4; ++i)
#pragma unroll
            for (int j = 0; j < 4; ++j) { ag[i][j] = 0.f; ab[i][j] = 0.f; }
        const float* wg = Wg + (size_t)n * ND * ND;
        for (int k0 = 0; k0 < ND; k0 += 16) {
#pragma unroll
            for (int it = 0; it < 4; ++it) { const int i = tid + it * 256, r = i >> 4, k = i & 15; As[k][r] = bf2f(H[(size_t)(row0 + r) * ND + k0 + k]); }
#pragma unroll
            for (int it = 0; it < 4; ++it) { const int i = tid + it * 256, k = i >> 6, c = i & 63; Bs[k][c] = wg[(size_t)(k0 + k) * ND + col0 + c]; }
            __syncthreads();
#pragma unroll
            for (int k = 0; k < 16; ++k) {
                float a[4], b[4];
#pragma unroll
                for (int i = 0; i < 4; ++i) { a[i] = As[k][ty * 4 + i]; b[i] = Bs[k][tx * 4 + i]; }
#pragma unroll
                for (int i = 0; i < 4; ++i)
#pragma unroll
                    for (int j = 0; j < 4; ++j) ag[i][j] += a[i] * b[j];
            }
            __syncthreads();
        }
        const float* wb = Wb + (size_t)n * NW * ND;
        for (int k0 = 0; k0 < NW; k0 += 16) {
#pragma unroll
            for (int it = 0; it < 4; ++it) { const int i = tid + it * 256, r = i >> 4, k = i & 15; As[k][r] = bf2f(Y[(size_t)(row0 + r) * NY + n * NW + k0 + k]); }
#pragma unroll
            for (int it = 0; it < 4; ++it) { const int i = tid + it * 256, k = i >> 6, c = i & 63; Bs[k][c] = wb[(size_t)(k0 + k) * ND + col0 + c]; }
            __syncthreads();
#pragma unroll
            for (int k = 0; k < 16; ++k) {
                float a[4], b[4];
#pragma unroll
                for (int i = 0; i < 4; ++i) { a[i] = As[k][ty * 4 + i]; b[i] = Bs[k][tx * 4 + i]; }
#pragma unroll
                for (int i = 0; i < 4; ++i)
#pragma unroll
                    for (int j = 0; j < 4; ++j) ab[i][j] += a[i] * b[j];
            }
            __syncthreads();
        }
#pragma unroll
        for (int i = 0; i < 4; ++i)
#pragma unroll
            for (int j = 0; j < 4; ++j) mg[i][j] += sigmoidf_(ag[i][j]) * ab[i][j];
    }
#pragma unroll
    for (int i = 0; i < 4; ++i)
#pragma unroll
        for (int j = 0; j < 4; ++j) MG[(size_t)(row0 + ty * 4 + i) * ND + col0 + tx * 4 + j] = f2bf(mg[i][j]);
}

__global__ void n_shortconv(const bf16_t* U, const float* w  , bf16_t* Y) {
    const size_t idx = (size_t)blockIdx.x * blockDim.x + threadIdx.x;
    const int c = idx & 255; const int m = (int)(idx >> 8); const int t = m & (NS - 1);
    float conv = 0.f;
#pragma unroll
    for (int j = 0; j < 3; ++j) { const int tt = t + j - 1; if (tt >= 0 && tt < NS) { const size_t r = (size_t)(m + j - 1) * NU; conv += w[j * 256 + c] * bf2f(U[r + C_SC + c]) * bf2f(U[r + C_SV + c]); } }
    const size_t r = (size_t)m * NU;
    Y[(size_t)m * NY + 2 * NW + c] = f2bf(bf2f(U[r + C_SB + c]) * conv * siluf_(bf2f(U[r + C_SZ + c])));
}

__global__ void n_conformer(const bf16_t* U, const float* dw_w  , const float* dw_b, const float* ln_g, const float* ln_b, bf16_t* Y) {
    __shared__ float red[4];
    const int m = blockIdx.x, c = threadIdx.x, t = m & (NS - 1);
    float conv = dw_b[c];
    for (int j = 0; j < 31; ++j) { const int tt = t + j - 15; if (tt >= 0 && tt < NS) { const size_t r = (size_t)(m + j - 15) * NU; conv += dw_w[j * 256 + c] * bf2f(U[r + C_CA + c]) * sigmoidf_(bf2f(U[r + C_CB + c])); } }
    float s = conv;
#pragma unroll
    for (int o = 1; o < 64; o <<= 1) s += __shfl_xor(s, o);
    if ((c & 63) == 0) red[c >> 6] = s;
    __syncthreads();
    const float mu = (red[0] + red[1] + red[2] + red[3]) * (1.f / 256.f);
    __syncthreads();
    const float d = conv - mu; float q = d * d;
#pragma unroll
    for (int o = 1; o < 64; o <<= 1) q += __shfl_xor(q, o);
    if ((c & 63) == 0) red[c >> 6] = q;
    __syncthreads();
    const float var = (red[0] + red[1] + red[2] + red[3]) * (1.f / 256.f);
    const float n = d * rsqrtf(var + EPSF) * ln_g[c] + ln_b[c];
    Y[(size_t)m * NY + 1 * NW + c] = f2bf(siluf_(n) * siluf_(bf2f(U[(size_t)m * NU + C_CZ + c])));
}


__device__ __forceinline__ float dot64(const float (&q)[64], const bf16_t* kp) {
    float s = 0.f;
#pragma unroll
    for (int c = 0; c < 8; ++c) { const uint4 w = *(const uint4*)(kp + 8 * c); const unsigned ww[4] = {w.x, w.y, w.z, w.w};
#pragma unroll
        for (int e = 0; e < 4; ++e) { s += q[8 * c + 2 * e] * __uint_as_float(ww[e] << 16); s += q[8 * c + 2 * e + 1] * __uint_as_float(ww[e] & 0xffff0000u); } }
    return s;
}
__device__ __forceinline__ void axpy64(float (&acc)[64], float sc, float p, const bf16_t* vp) {
#pragma unroll
    for (int c = 0; c < 8; ++c) { const uint4 w = *(const uint4*)(vp + 8 * c); const unsigned ww[4] = {w.x, w.y, w.z, w.w};
#pragma unroll
        for (int e = 0; e < 4; ++e) { acc[8 * c + 2 * e] = acc[8 * c + 2 * e] * sc + p * __uint_as_float(ww[e] << 16); acc[8 * c + 2 * e + 1] = acc[8 * c + 2 * e + 1] * sc + p * __uint_as_float(ww[e] & 0xffff0000u); } }
}
__global__ __launch_bounds__(64) void n_winattn(const bf16_t* U, const float* BIAS, const float* sink, bf16_t* Y) {
    const int idx = blockIdx.x * blockDim.x + threadIdx.x;
    const int m = idx, h = blockIdx.y, t = m & (NS - 1), kvh = h >> 1;
    float q[64], acc[64];
    const bf16_t* qp = U + (size_t)m * NU + C_AQ + h * 64;
#pragma unroll
    for (int d = 0; d < 64; ++d) { q[d] = bf2f(qp[d]) * 0.125f; acc[d] = 0.f; }
    float mx = sink[h], l = 1.f;
    const int j0 = (t - 128 < 0) ? 0 : t - 128, j1 = (t + 128 > NS - 1) ? NS - 1 : t + 128;
    const float* bias = BIAS + h * 257;
    for (int j = j0; j <= j1; ++j) {
        const bf16_t* kp = U + (size_t)(m - t + j) * NU + C_AK + kvh * 64;
        const bf16_t* vp = U + (size_t)(m - t + j) * NU + C_AV + kvh * 64;
        float s = dot64(q, kp);
        s += bias[j - t + 128];
        const float nm = fmaxf(mx, s), sc = __expf(mx - nm), p = __expf(s - nm);
        l = l * sc + p; mx = nm;
        axpy64(acc, sc, p, vp);
    }
    const float inv = 1.f / l;
    const bf16_t* zp = U + (size_t)m * NU + C_AZ + h * 64;
    bf16_t* yp = Y + (size_t)m * NY + 3 * NW + h * 64;
#pragma unroll
    for (int d = 0; d < 64; ++d) yp[d] = f2bf(acc[d] * inv * siluf_(bf2f(zp[d])));
}

__global__ __launch_bounds__(64) void n_memattn(const bf16_t* U, const bf16_t* MKV  , bf16_t* Y) {
    const int m = blockIdx.x * blockDim.x + threadIdx.x, h = blockIdx.y, b = m / NS;
    float q[64], acc[64];
    const bf16_t* qp = U + (size_t)m * NU + C_MQ + h * 64;
#pragma unroll
    for (int d = 0; d < 64; ++d) { q[d] = bf2f(qp[d]) * 0.125f; acc[d] = 0.f; }
    float mx = -1e30f, l = 0.f;
    for (int j = 0; j < MEML; ++j) {
        const bf16_t* kp = MKV + (size_t)(b * MEML + j) * 512 + h * 64;
        const bf16_t* vp = kp + 256;
        const float s = dot64(q, kp);
        const float nm = fmaxf(mx, s), sc = __expf(mx - nm), p = __expf(s - nm);
        l = l * sc + p; mx = nm;
        axpy64(acc, sc, p, vp);
    }
    const float inv = 1.f / l;
    const bf16_t* zp = U + (size_t)m * NU + C_MZ + h * 64;
    bf16_t* yp = Y + (size_t)m * NY + 4 * NW + h * 64;
#pragma unroll
    for (int d = 0; d < 64; ++d) yp[d] = f2bf(acc[d] * inv * siluf_(bf2f(zp[d])));
}

__global__ __launch_bounds__(1024) void n_hgrn_scan(const bf16_t* U, const float* LBl  , bf16_t* OHG  ) {
    __shared__ float sq[64], sf[64], sk[64], sv[64]; __shared__ float red[16][64];
    const int b = blockIdx.x >> 3, h = (blockIdx.x >> 1) & 3, dir = blockIdx.x & 1;
    const int tid = threadIdx.x, v = tid & 63, kg = tid >> 6;
    float S[4] = {0.f, 0.f, 0.f, 0.f};
    const float lb = (tid < 64) ? LBl[dir * 256 + h * 64 + tid] : 0.f;
    for (int step = 0; step < NS; ++step) {
        const int t = dir ? (NS - 1 - step) : step;
        const size_t r = ((size_t)b * NS + t) * NU;
        if (tid < 64) {
            const float fl = bf2f(U[r + (dir ? C_HFB : C_HFF) + h * 64 + tid]);
            const float f = lb + (1.f - lb) * sigmoidf_(fl);
            sf[tid] = f; sk[tid] = 1.f - f;
            sq[tid] = bf2f(U[r + C_HQ + h * 64 + tid]);
            sv[tid] = bf2f(U[r + C_HI + h * 64 + tid]);
        }
        __syncthreads();
        const float vv = sv[v]; float part = 0.f;
#pragma unroll
        for (int j = 0; j < 4; ++j) { const int k = kg * 4 + j; S[j] = sf[k] * S[j] + sk[k] * vv; part += sq[k] * S[j]; }
        red[kg][v] = part;
        __syncthreads();
        if (tid < 64) { float o = 0.f;
#pragma unroll
            for (int g = 0; g < 16; ++g) o += red[g][tid];
            OHG[((size_t)dir * NM + (size_t)b * NS + t) * 256 + h * 64 + tid] = f2bf(o); }
    }
}
__global__ void n_hgrn_out(const bf16_t* OHG, const bf16_t* U, const float* onorm  , bf16_t* Y) {
    const int wave = (blockIdx.x * blockDim.x + threadIdx.x) >> 6, lane = threadIdx.x & 63;
    const int m = wave >> 2, h = wave & 3;
    const float o = bf2f(OHG[(size_t)m * 256 + h * 64 + lane]) + bf2f(OHG[((size_t)NM + m) * 256 + h * 64 + lane]);
    float s = o * o;
#pragma unroll
    for (int k = 1; k < 64; k <<= 1) s += __shfl_xor(s, k);
    const float y = o * rsqrtf(s * (1.f / 64.f) + EPSF) * onorm[lane];
    Y[(size_t)m * NY + h * 64 + lane] = f2bf(y * siluf_(bf2f(U[(size_t)m * NU + C_HZ + h * 64 + lane])));
}

__global__ void n_post(const float* xin, const bf16_t* outraw, const float* g_post, const float* g_next, float* xout, bf16_t* H, int has_next) {
    const int wave = (blockIdx.x * blockDim.x + threadIdx.x) >> 6, lane = threadIdx.x & 63;
    const size_t base = (size_t)wave * ND;
    float o[16], s = 0.f;
#pragma unroll
    for (int j = 0; j < 16; ++j) { o[j] = bf2f(outraw[base + lane + 64 * j]); s += o[j] * o[j]; }
#pragma unroll
    for (int k = 1; k < 64; k <<= 1) s += __shfl_xor(s, k);
    const float r = rsqrtf(s * (1.f / ND) + EPSF);
    float s2 = 0.f;
#pragma unroll
    for (int j = 0; j < 16; ++j) { o[j] = xin[base + lane + 64 * j] + o[j] * r * g_post[lane + 64 * j]; s2 += o[j] * o[j]; xout[base + lane + 64 * j] = o[j]; }
    if (has_next) {
#pragma unroll
        for (int k = 1; k < 64; k <<= 1) s2 += __shfl_xor(s2, k);
        const float r2 = rsqrtf(s2 * (1.f / ND) + EPSF);
#pragma unroll
        for (int j = 0; j < 16; ++j) H[base + lane + 64 * j] = f2bf(o[j] * r2 * g_next[lane + 64 * j]);
    }
}


__device__ __forceinline__ int lane_id_() { int l; asm volatile("v_mbcnt_lo_u32_b32 %0, -1, 0\n\tv_mbcnt_hi_u32_b32 %0, -1, %0" : "=v"(l)); return l; }
#define TID_() (wave_u * 64 + lane_id_())
#ifndef DBG_CQ
#define DBG_CQ 0
#endif
namespace pg8 {
#define PG8_LAS __attribute__((address_space(3)))
typedef short bf16x8 __attribute__((ext_vector_type(8)));
typedef float f32x4 __attribute__((ext_vector_type(4)));
typedef unsigned u32x4 __attribute__((ext_vector_type(4)));
constexpr int BM = 256, BK = 64, HALF = 128, HTB = HALF * BK * 2  , STAGE_BYTES = 8 * HTB, NXCD = 8, WGM = 8;

__host__ __device__ __forceinline__ int lds_byte(int r, int c) { const int st = (r >> 4) * 2 + (c >> 5), rr = r & 15, cc = c & 31, ob = rr * 64 + cc * 2; return st * 1024 + (ob ^ (((ob >> 9) & 1) << 5)); }
__host__ __device__ __forceinline__ void stage_rc(int b, int& R, int& C) { const int st = b / 1024, sb = b % 1024, swz = sb ^ (((sb >> 9) & 1) << 5); R = (st >> 1) * 16 + swz / 64; C = (st & 1) * 32 + (swz % 64) / 2; }
__host__ __device__ __forceinline__ int perm32(int rho) { const int n = rho >> 4, i = rho & 15; return 8 * (i >> 2) + 4 * n + (i & 3); }

struct Unit { int pm, pn, pz; };
struct Gemm { const bf16_t* A; const bf16_t* Bt; int lda, ldb, K; unsigned zA, zB; };

template <int NZ> struct TileOrder {
    int nM, nN, nwg, G, c;
    __device__ void init(int M, int N, int G_, int c_) { nM = M / BM; nN = N / BM; nwg = nM * nN; G = G_; c = c_; }
    __device__ bool next(int i, Unit& u) const {
        const int ti = i / NZ; u.pz = i - ti * NZ;
        const long L = (long)ti * G + c; if (L >= nwg) return false;
        int wgid = (int)L; { const int q = nwg / NXCD, r = nwg % NXCD, xcd = wgid % NXCD, off = wgid / NXCD; wgid = (xcd < r ? xcd * (q + 1) : r * (q + 1) + (xcd - r) * q) + off; }
        const int nig = WGM * nN, gid = wgid / nig, fm = gid * WGM, gsz = (nM - fm) < WGM ? (nM - fm) : WGM;
        u.pm = fm + ((wgid % nig) % gsz); u.pn = (wgid % nig) / gsz; return true;
    }
};

template <int NZ> struct TileRound {
    TileOrder<NZ> T; int ti;
    __device__ bool next(int i, Unit& u) const { if (i >= NZ) return false; return T.next(ti * NZ + i, u); }
};
__device__ __forceinline__ unsigned cvt_pk_bf16(float lo, float hi) { unsigned r; asm volatile("v_cvt_pk_bf16_f32 %0, %1, %2" : "=v"(r) : "v"(lo), "v"(hi)); return r; }
__device__ __forceinline__ float bflo(unsigned w) { return __uint_as_float(w << 16); }
__device__ __forceinline__ float bfhi(unsigned w) { return __uint_as_float(w & 0xffff0000u); }

constexpr int SCL_OFF = 139264;
struct EpiStore {
    static constexpr bool PERM = true, CHAINED = false; static constexpr int NSCL = 1;
    GAS bf16_t* O; int ldc; const GAS float* rs;
    __device__ __forceinline__ const GAS float* rowp(const Unit& u) const { return rs + u.pm * BM; }
    __device__ __forceinline__ const GAS float* colp(const Unit& u) const { return rs; }
    __device__ __forceinline__ void operator()(f32x4 (&acc)[2][2][4][2], const Unit& u, int wr, int wc, int fr, int fq, const PG8_LAS float* scl) const {
        const int row0 = u.pm * BM + wr * 64 + fr, col0 = u.pn * BM + wc * 32 + 8 * fq;
#pragma unroll
        for (int ai = 0; ai < 2; ++ai)
#pragma unroll
            for (int m = 0; m < 4; ++m) { GAS bf16_t* rowp = O + (size_t)(row0 + ai * HALF + m * 16) * ldc + col0;
                const float sc = scl[wr * 64 + fr + ai * HALF + m * 16];
#pragma unroll
                for (int bj = 0; bj < 2; ++bj) { const f32x4 v0 = acc[ai][bj][m][0] * sc, v1 = acc[ai][bj][m][1] * sc;
                    u32x4 w; w.x = cvt_pk_bf16(v0[0], v0[1]); w.y = cvt_pk_bf16(v0[2], v0[3]); w.z = cvt_pk_bf16(v1[0], v1[1]); w.w = cvt_pk_bf16(v1[2], v1[3]);
                    *(GAS u32x4*)(rowp + bj * HALF) = w; } }
    }
};
constexpr int GS_LD = 256, GS_SLOT = 256 * 256, GS_SLOT8 = 65536;
struct EpiGate {
    static constexpr bool PERM = true, CHAINED = false; static constexpr int NSCL = 2;
    GAS bf16_t* GS; const GAS float* rq; const GAS float* cq;
    __device__ __forceinline__ const GAS float* rowp(const Unit& u) const { return rq + u.pm * BM; }
    __device__ __forceinline__ const GAS float* colp(const Unit& u) const { return cq + u.pz * 1024 + u.pn * BM; }
    __device__ __forceinline__ void operator()(f32x4 (&acc)[2][2][4][2], const Unit& u, int wr, int wc, int fr, int fq, const PG8_LAS float* scl) const {
        const int n = u.pz;
        f32x4 cs[2][2];
        { const PG8_LAS f32x4* cp = (const PG8_LAS f32x4*)(scl + 256 + wc * 32 + 8 * fq);
#pragma unroll
          for (int bj = 0; bj < 2; ++bj) { cs[bj][0] = cp[bj * (HALF / 4)] * (-1.4426950408889634f / 127.f); cs[bj][1] = cp[bj * (HALF / 4) + 1] * (-1.4426950408889634f / 127.f); } }
        GAS unsigned char* base = (GAS unsigned char*)GS + (size_t)n * GS_SLOT8 + (wr * 4 + wc) * 1024 + (fq * 16 + fr) * 16;
#pragma unroll
        for (int ai = 0; ai < 2; ++ai)
#pragma unroll
            for (int m = 0; m < 4; ++m) { const float rsc = scl[wr * 64 + fr + ai * HALF + m * 16];
                unsigned w[4];
#pragma unroll
                for (int bj = 0; bj < 2; ++bj) {
                    f32x4 x0, x1;
#pragma unroll
                    for (int j = 0; j < 4; ++j) { x0[j] = (float)__float_as_int(acc[ai][bj][m][0][j]); x1[j] = (float)__float_as_int(acc[ai][bj][m][1][j]); }
                    x0 = x0 * (cs[bj][0] * rsc); x1 = x1 * (cs[bj][1] * rsc);
                    unsigned b0[4], b1[4];
#pragma unroll
                    for (int j = 0; j < 4; ++j) { x0[j] = __builtin_amdgcn_exp2f(fminf(x0[j], 15.9f)); x1[j] = __builtin_amdgcn_exp2f(fminf(x1[j], 15.9f)); }
                    x0 = x0 + 1.f; x1 = x1 + 1.f;
#pragma unroll
                    for (int j = 0; j < 4; ++j) { x0[j] = __builtin_amdgcn_rsqf(x0[j]); x1[j] = __builtin_amdgcn_rsqf(x1[j]); }
                    x0 = x0 * 255.f + 12582912.f; x1 = x1 * 255.f + 12582912.f;
#pragma unroll
                    for (int j = 0; j < 4; ++j) { b0[j] = __float_as_uint(x0[j]); b1[j] = __float_as_uint(x1[j]); }
                    w[2 * bj]     = __builtin_amdgcn_perm(__builtin_amdgcn_perm(b0[3], b0[2], 0x0c0c0400u), __builtin_amdgcn_perm(b0[1], b0[0], 0x0c0c0400u), 0x05040100u);
                    w[2 * bj + 1] = __builtin_amdgcn_perm(__builtin_amdgcn_perm(b1[3], b1[2], 0x0c0c0400u), __builtin_amdgcn_perm(b1[1], b1[0], 0x0c0c0400u), 0x05040100u);
                }
                *(GAS u32x4*)(base + (ai * 4 + m) * 8192) = (u32x4){w[0], w[1], w[2], w[3]};
            }
    }
};
struct EpiStoreQ {
    static constexpr bool PERM = true, CHAINED = false; static constexpr int NSCL = 2;
    GAS bf16_t* O; int ldc; const GAS float* rq; const GAS float* cq;
    __device__ __forceinline__ const GAS float* rowp(const Unit& u) const { return rq + u.pm * BM; }
    __device__ __forceinline__ const GAS float* colp(const Unit& u) const { return cq + u.pn * BM; }
    __device__ __forceinline__ void operator()(f32x4 (&acc)[2][2][4][2], const Unit& u, int wr, int wc, int fr, int fq, const PG8_LAS float* scl) const {
        const int row0 = u.pm * BM + wr * 64 + fr, col0 = u.pn * BM + wc * 32 + 8 * fq;
        f32x4 cs[2][2];
        { const PG8_LAS f32x4* cp = (const PG8_LAS f32x4*)(scl + 256 + wc * 32 + 8 * fq);
#pragma unroll
          for (int bj = 0; bj < 2; ++bj) { cs[bj][0] = cp[bj * (HALF / 4)] * (1.f / 127.f); cs[bj][1] = cp[bj * (HALF / 4) + 1] * (1.f / 127.f); } }
#pragma unroll
        for (int ai = 0; ai < 2; ++ai)
#pragma unroll
            for (int m = 0; m < 4; ++m) { GAS bf16_t* rowp_ = O + (size_t)(row0 + ai * HALF + m * 16) * ldc + col0;
                const float rsc = scl[wr * 64 + fr + ai * HALF + m * 16];
#pragma unroll
                for (int bj = 0; bj < 2; ++bj) {
                    f32x4 x0, x1;
#pragma unroll
                    for (int j = 0; j < 4; ++j) { x0[j] = (float)__float_as_int(acc[ai][bj][m][0][j]); x1[j] = (float)__float_as_int(acc[ai][bj][m][1][j]); }
                    x0 = x0 * (cs[bj][0] * rsc); x1 = x1 * (cs[bj][1] * rsc);
                    u32x4 w; w.x = cvt_pk_bf16(x0[0], x0[1]); w.y = cvt_pk_bf16(x0[2], x0[3]); w.z = cvt_pk_bf16(x1[0], x1[1]); w.w = cvt_pk_bf16(x1[2], x1[3]);
                    *(GAS u32x4*)(rowp_ + bj * HALF) = w; } }
    }
};
struct EpiMerge {
    static constexpr bool PERM = true, CHAINED = true; static constexpr int NSCL = 0;
    __device__ __forceinline__ const GAS float* rowp(const Unit&) const { return nullptr; }
    __device__ __forceinline__ const GAS float* colp(const Unit&) const { return nullptr; }
    const GAS bf16_t* GS; GAS bf16_t* MG;
    __device__ __forceinline__ void operator()(f32x4 (&acc)[2][2][4][2], const Unit& u, int wr, int wc, int fr, int fq, const PG8_LAS float*) const {
        const int row0 = u.pm * BM + wr * 64 + fr, col0 = u.pn * BM + wc * 32 + 8 * fq, n = u.pz;
        const GAS unsigned char* base = (const GAS unsigned char*)GS + (size_t)n * GS_SLOT8 + (wr * 4 + wc) * 1024 + (fq * 16 + fr) * 16;
#pragma unroll
        for (int ai = 0; ai < 2; ++ai) {
            u32x4 pa[4], pb[4];
            { const GAS unsigned char* q0 = base + (ai * 4) * 8192; const GAS unsigned char* q1 = q0 + 8192; const GAS unsigned char* q2 = q0 + 16384; const GAS unsigned char* q3 = q0 + 24576;
              asm volatile("global_load_dwordx4 %0, %4, off sc1\n\tglobal_load_dwordx4 %1, %5, off sc1\n\tglobal_load_dwordx4 %2, %6, off sc1\n\tglobal_load_dwordx4 %3, %7, off sc1"
                           : "=&v"(pa[0]), "=&v"(pa[1]), "=&v"(pa[2]), "=&v"(pa[3]) : "v"(q0), "v"(q1), "v"(q2), "v"(q3) : "memory");
              if (n < 4) { const GAS unsigned char* r0 = q0 + GS_SLOT8; const GAS unsigned char* r1 = r0 + 8192; const GAS unsigned char* r2 = r0 + 16384; const GAS unsigned char* r3 = r0 + 24576;
                  asm volatile("global_load_dwordx4 %0, %4, off sc1\n\tglobal_load_dwordx4 %1, %5, off sc1\n\tglobal_load_dwordx4 %2, %6, off sc1\n\tglobal_load_dwordx4 %3, %7, off sc1"
                               : "=&v"(pb[0]), "=&v"(pb[1]), "=&v"(pb[2]), "=&v"(pb[3]) : "v"(r0), "v"(r1), "v"(r2), "v"(r3) : "memory"); }
              asm volatile("s_waitcnt vmcnt(0)" ::: "memory"); }
#pragma unroll
            for (int mm = 0; mm < 4; ++mm) { const size_t row = (size_t)(row0 + ai * HALF + mm * 16);
#pragma unroll
                for (int bj = 0; bj < 2; ++bj) {
                    float f[8];
#pragma unroll
                    for (int k = 0; k < 2; ++k) { const unsigned qa = pa[mm][2 * bj + k];
#pragma unroll
                        for (int j = 0; j < 4; ++j) f[4 * k + j] = (float)((qa >> (8 * j)) & 0xffu); }
                    if (n < 4) {
#pragma unroll
                        for (int k = 0; k < 2; ++k) { const unsigned qb = pb[mm][2 * bj + k];
#pragma unroll
                            for (int j = 0; j < 4; ++j) f[4 * k + j] *= __builtin_amdgcn_rcpf((float)((qb >> (8 * j)) & 0xffu)); }
                    } else {
#pragma unroll
                        for (int j = 0; j < 8; ++j) f[j] *= (1.f / 255.f);
                    }
                    f32x4 v0 = acc[ai][bj][mm][0], v1 = acc[ai][bj][mm][1];
                    v0[0] *= f[0] * f[0]; v0[1] *= f[1] * f[1]; v0[2] *= f[2] * f[2]; v0[3] *= f[3] * f[3]; v1[0] *= f[4] * f[4]; v1[1] *= f[5] * f[5]; v1[2] *= f[6] * f[6]; v1[3] *= f[7] * f[7];
                    acc[ai][bj][mm][0] = v0; acc[ai][bj][mm][1] = v1;
                    if (n == 4) { u32x4 w; w.x = cvt_pk_bf16(v0[0], v0[1]); w.y = cvt_pk_bf16(v0[2], v0[3]); w.z = cvt_pk_bf16(v1[0], v1[1]); w.w = cvt_pk_bf16(v1[2], v1[3]);
                        *(GAS u32x4*)(MG + row * 1024 + col0 + bj * HALF) = w; }
                } }
        }
    }
};
struct EpiStoreZ {
    static constexpr bool PERM = true, CHAINED = false; static constexpr int NSCL = 0;
    __device__ __forceinline__ const GAS float* rowp(const Unit&) const { return nullptr; }
    __device__ __forceinline__ const GAS float* colp(const Unit&) const { return nullptr; }
    GAS bf16_t* O; int ldc; size_t zO;
    __device__ __forceinline__ void operator()(f32x4 (&acc)[2][2][4][2], const Unit& u, int wr, int wc, int fr, int fq, const PG8_LAS float*) const {
        const int row0 = u.pm * BM + wr * 64 + fr, col0 = u.pn * BM + wc * 32 + 8 * fq; GAS bf16_t* Ob = O + (size_t)u.pz * zO;
#pragma unroll
        for (int ai = 0; ai < 2; ++ai)
#pragma unroll
            for (int m = 0; m < 4; ++m) { GAS bf16_t* rowp = Ob + (size_t)(row0 + ai * HALF + m * 16) * ldc + col0;
#pragma unroll
                for (int bj = 0; bj < 2; ++bj) { const f32x4 v0 = acc[ai][bj][m][0], v1 = acc[ai][bj][m][1];
                    u32x4 w; w.x = cvt_pk_bf16(v0[0], v0[1]); w.y = cvt_pk_bf16(v0[2], v0[3]); w.z = cvt_pk_bf16(v1[0], v1[1]); w.w = cvt_pk_bf16(v1[2], v1[3]);
                    *(GAS u32x4*)(rowp + bj * HALF) = w; } }
    }
};
struct OneUnit { Unit u; bool valid; __device__ bool next(int i, Unit& o) const { if (i == 0 && valid) { o = u; return true; } return false; } };

template <class Epi, class Sched, bool ALIGN_EPI, bool I8 = false>
__device__ __forceinline__ void gemm_phase(PG8_LAS unsigned char* lds, const Gemm g, const Sched& S, const Epi& E, int wave_u) {
    int tid_ = wave_u * 64 + lane_id_(); asm volatile("" : "+v"(tid_));
    const int tid = tid_, wid = __builtin_amdgcn_readfirstlane(tid >> 6), lane = tid & 63, wr = wid >> 2, wc = wid & 3, fr = lane & 15, fq = lane >> 4;
    const int nt = g.K / BK;
    unsigned voffA[2], voffB[2];
#pragma unroll
    for (int i = 0; i < 2; ++i) { int R, C; stage_rc(tid * 16 + i * 8192, R, C); const int Rb = Epi::PERM ? ((R & ~31) + perm32(R & 31)) : R;
        voffA[i] = (unsigned)(R * g.lda + C) * 2u; voffB[i] = (unsigned)(Rb * g.ldb + C) * 2u; }
    const size_t kstep = (size_t)(BK * 2);
    const size_t hstepA = (size_t)HALF * g.lda * 2, tstepA = 2 * hstepA, hstepB = (size_t)HALF * g.ldb * 2, tstepB = 2 * hstepB;
    const unsigned ldsw = (unsigned)wid * 1024u;
    const int aoff = lds_byte(wr * 64 + fr, fq * 8), boff = lds_byte(wc * 32 + fr, fq * 8);
#define PG8_SA(b, h) (((b) * 2 + (h)) * HTB)
#define PG8_SB(b, h) ((4 + (b) * 2 + (h)) * HTB)
#define PG8_STAGE(bufoff, gbase, voff) do { _Pragma("unroll") for (int _i = 0; _i < 2; ++_i) \
        __builtin_amdgcn_global_load_lds((const unsigned*)((const char*)(gbase) + (voff)[_i]), (PG8_LAS unsigned*)(lds + (bufoff) + ldsw + _i * 8192), 16, 0, 0); } while (0)
#define PG8_LDA(dst, b, h) do { _Pragma("unroll") for (int m = 0; m < 4; ++m) _Pragma("unroll") for (int k = 0; k < 2; ++k) dst[m][k] = *(const PG8_LAS bf16x8*)(lds + PG8_SA(b, h) + aoff + m * 2048 + k * 1024); } while (0)
#define PG8_LDB(dst, b, h) do { _Pragma("unroll") for (int n = 0; n < 2; ++n) _Pragma("unroll") for (int k = 0; k < 2; ++k) dst[n][k] = *(const PG8_LAS bf16x8*)(lds + PG8_SB(b, h) + boff + n * 2048 + k * 1024); } while (0)
    typedef int i32x4_ __attribute__((ext_vector_type(4)));
#define PG8_MMA(ai, bj, At, Bt) do { __builtin_amdgcn_s_setprio(1); _Pragma("unroll") for (int m = 0; m < 4; ++m) _Pragma("unroll") for (int n = 0; n < 2; ++n) _Pragma("unroll") for (int k = 0; k < 2; ++k) { \
        if constexpr (I8) acc[ai][bj][m][n] = __builtin_bit_cast(f32x4, __builtin_amdgcn_mfma_i32_16x16x64_i8(__builtin_bit_cast(i32x4_, Bt[n][k]), __builtin_bit_cast(i32x4_, At[m][k]), __builtin_bit_cast(i32x4_, acc[ai][bj][m][n]), 0, 0, 0)); \
        else acc[ai][bj][m][n] = __builtin_amdgcn_mfma_f32_16x16x32_bf16(Bt[n][k], At[m][k], acc[ai][bj][m][n], 0, 0, 0); } __builtin_amdgcn_s_setprio(0); } while (0)
#define PG8_WAIT_V(n) asm volatile("s_waitcnt vmcnt(" #n ")" ::: "memory")
#define PG8_WAIT_L(n) asm volatile("s_waitcnt lgkmcnt(" #n ")" ::: "memory")
#define PG8_BAR __builtin_amdgcn_s_barrier()
#define PG8_SCHED __builtin_amdgcn_sched_barrier(0)
    Unit cur, nxt; int ui = 0;
    if (!S.next(0, cur)) return;
    f32x4 acc[2][2][4][2];
#pragma unroll
    for (int a = 0; a < 2; ++a)
#pragma unroll
        for (int b = 0; b < 2; ++b)
#pragma unroll
            for (int m = 0; m < 4; ++m)
#pragma unroll
                for (int n = 0; n < 2; ++n) acc[a][b][m][n] = (f32x4){0.f, 0.f, 0.f, 0.f};
    bf16x8 At[4][2], B0[2][2], B1[2][2];
    const char* cA = (const char*)g.A + (size_t)cur.pm * tstepA + (size_t)cur.pz * g.zA; const char* cB = (const char*)g.Bt + (size_t)cur.pn * tstepB + (size_t)cur.pz * g.zB;
    PG8_STAGE(PG8_SB(0, 0), cB, voffB); PG8_STAGE(PG8_SB(0, 1), cB + hstepB, voffB); PG8_STAGE(PG8_SA(0, 0), cA, voffA); PG8_STAGE(PG8_SA(0, 1), cA + hstepA, voffA);
    if (wr == 1) PG8_BAR;
    PG8_WAIT_V(2); PG8_BAR;
    PG8_STAGE(PG8_SB(1, 0), cB + kstep, voffB); PG8_STAGE(PG8_SA(1, 0), cA + kstep, voffA); PG8_STAGE(PG8_SB(1, 1), cB + hstepB + kstep, voffB);
    PG8_WAIT_V(6); PG8_BAR;
    for (;;) {
        const bool has_next = S.next(ui + 1, nxt);
        const char* nA = has_next ? (const char*)g.A + (size_t)nxt.pm * tstepA + (size_t)nxt.pz * g.zA : cA; const char* nB = has_next ? (const char*)g.Bt + (size_t)nxt.pn * tstepB + (size_t)nxt.pz * g.zB : cB;
        for (int t = 0; t < nt; t += 2) {
            const bool last = (t == nt - 2);
            const char* a1 = cA + (size_t)(t + 1) * kstep;
            const char* a2 = last ? nA : cA + (size_t)(t + 2) * kstep; const char* b2 = last ? nB : cB + (size_t)(t + 2) * kstep;
            const char* a3 = a2 + kstep; const char* b3 = b2 + kstep;
            if constexpr (Epi::NSCL > 0) { if (t == 0 && (Epi::NSCL == 2 || wid < 4)) {
                const GAS float* sp = (wid < 4 ? E.rowp(cur) : E.colp(cur) - 256) + wid * 64;
                __builtin_amdgcn_global_load_lds((const unsigned*)((const GAS char*)sp + (unsigned)lane_id_() * 4u), (PG8_LAS unsigned*)(lds + SCL_OFF + (ui & 1) * 2048 + wid * 256), 4, 0, 0); } }
            PG8_LDB(B0, 0, 0); PG8_LDB(B1, 0, 1); PG8_SCHED; PG8_LDA(At, 0, 0); PG8_STAGE(PG8_SA(1, 1), a1 + hstepA, voffA);
            PG8_WAIT_V(8); PG8_WAIT_L(0); PG8_BAR; PG8_MMA(0, 0, At, B0); PG8_MMA(0, 1, At, B1); PG8_BAR; PG8_SCHED;
            PG8_LDA(At, 0, 1); PG8_STAGE(PG8_SB(0, 0), b2, voffB); PG8_STAGE(PG8_SB(0, 1), b2 + hstepB, voffB); PG8_STAGE(PG8_SA(0, 0), a2, voffA);
            PG8_WAIT_V(8); PG8_WAIT_L(0); PG8_BAR; PG8_MMA(1, 0, At, B0); PG8_MMA(1, 1, At, B1); PG8_BAR; PG8_SCHED;
            PG8_LDB(B0, 1, 0); PG8_LDB(B1, 1, 1); PG8_SCHED; PG8_LDA(At, 1, 0); PG8_STAGE(PG8_SA(0, 1), a2 + hstepA, voffA);
            PG8_WAIT_V(8); PG8_WAIT_L(0); PG8_BAR; PG8_MMA(0, 0, At, B0); PG8_MMA(0, 1, At, B1); PG8_BAR; PG8_SCHED;
            PG8_LDA(At, 1, 1); PG8_STAGE(PG8_SB(1, 0), b3, voffB); PG8_STAGE(PG8_SB(1, 1), b3 + hstepB, voffB); PG8_STAGE(PG8_SA(1, 0), a3, voffA);
            PG8_WAIT_V(8); PG8_WAIT_L(0); PG8_BAR; PG8_MMA(1, 0, At, B0); PG8_MMA(1, 1, At, B1); PG8_BAR; PG8_SCHED;
        }
        if constexpr (ALIGN_EPI) { if (wr == 0) PG8_BAR; }
        { const int l_ = lane_id_(); int fr_ = l_ & 15, fq_ = l_ >> 4; asm volatile("" : "+v"(fr_), "+v"(fq_)); E(acc, cur, wr, wc, fr_, fq_, (const PG8_LAS float*)(lds + SCL_OFF + (ui & 1) * 2048)); }
        if (!has_next) break;
        if (!Epi::CHAINED || nxt.pz == 0) {
#pragma unroll
            for (int a = 0; a < 2; ++a)
#pragma unroll
                for (int b = 0; b < 2; ++b)
#pragma unroll
                    for (int m = 0; m < 4; ++m)
#pragma unroll
                        for (int n = 0; n < 2; ++n) acc[a][b][m][n] = (f32x4){0.f, 0.f, 0.f, 0.f};
        }
        cur = nxt; cA = nA; cB = nB; ++ui;
        if constexpr (ALIGN_EPI) { if (wr == 1) PG8_BAR; }
    }
    PG8_WAIT_V(0);
    if constexpr (!ALIGN_EPI) { if (wr == 0) PG8_BAR; }
    PG8_BAR;
#undef PG8_SA
#undef PG8_SB
#undef PG8_STAGE
#undef PG8_LDA
#undef PG8_LDB
#undef PG8_MMA
#undef PG8_WAIT_V
#undef PG8_WAIT_L
#undef PG8_BAR
#undef PG8_SCHED
}
}

#define LAS __attribute__((address_space(3)))
#define XB_TMO      128
#define XB_XCNT(j)  (256  + 64 * (j))
#define XB_XSUB(j)  (1280 + 64 * (j))
#define XB_XGEN(j)  (2304 + 64 * (j))
#define XB_TOP      3328
#define XB_TOPGEN   3392
#define XCD_BAR_WORDS 3456
#define XB_SPIN_CAP (1u << 18)
__device__ __forceinline__ unsigned xb_ld(unsigned* p)              { return __hip_atomic_load(p, __ATOMIC_RELAXED, __HIP_MEMORY_SCOPE_AGENT); }
__device__ __forceinline__ unsigned xb_add(unsigned* p, unsigned v) { return __hip_atomic_fetch_add(p, v, __ATOMIC_RELAXED, __HIP_MEMORY_SCOPE_AGENT); }
__device__ __forceinline__ unsigned xb_xcc_id() { return (unsigned)__builtin_amdgcn_s_getreg((3 << 11) | 20) & 0xFu; }
#define XB_SPIN(cond, bar) do { unsigned _sp = 0; while (cond) { __builtin_amdgcn_s_sleep(1); \
    if ((++_sp & 255u) == 0u) { if (xb_ld(&(bar)[XB_TMO])) break; if (_sp > XB_SPIN_CAP) { atomicAdd(&(bar)[XB_TMO], 1u); break; } } } } while (0)
struct XcdBarrier { unsigned* bar; unsigned x; volatile LAS unsigned* st; int wave_u; };
__device__ __forceinline__ XcdBarrier xcd_barrier_post(unsigned* bar, volatile LAS unsigned* st, int wave_u) {
    XcdBarrier b; b.bar = bar; b.x = xb_xcc_id(); b.st = st; b.wave_u = wave_u;
    if (wave_u == 0 && lane_id_() == 0) (void)xb_add(&bar[XB_XCNT(b.x)], 1u);
    return b;
}
__device__ __forceinline__ void xcd_barrier_complete(unsigned* bar, unsigned x, unsigned& nloc, unsigned& nx) {
    const unsigned G = gridDim.x * gridDim.y * gridDim.z;
    unsigned sum, cnt, mine, sp = 0u;
    for (;;) {
        sum = 0u; cnt = 0u; mine = 0u;
#pragma unroll
        for (unsigned j = 0; j < 16; ++j) { const unsigned c = xb_ld(&bar[XB_XCNT(j)]); sum += c; cnt += (c > 0u) ? 1u : 0u; mine = (j == x) ? c : mine; }
        if (sum == G) break;
        __builtin_amdgcn_s_sleep(1);
        if ((++sp & 255u) == 0u) { if (xb_ld(&bar[XB_TMO])) break; if (sp > XB_SPIN_CAP) { atomicAdd(&bar[XB_TMO], 1u); break; } }
    }
    nloc = mine > 0u ? mine : 1u; nx = cnt > 0u ? cnt : 1u;
}
__device__ __forceinline__ void xcd_barrier(const XcdBarrier& b) {
    asm volatile("s_waitcnt vmcnt(0)" ::: "memory");
    __syncthreads();
    if (b.wave_u == 0 && lane_id_() == 0) {
        unsigned* bar = b.bar;
        __builtin_amdgcn_s_waitcnt(0);
        unsigned nloc = b.st[0], nx = b.st[1];
        if (nloc == 0u) { xcd_barrier_complete(bar, b.x, nloc, nx); b.st[0] = nloc; b.st[1] = nx; }
        const unsigned old = xb_add(&bar[XB_XSUB(b.x)], 1u);
        const unsigned gen = old / nloc;
        if (old + 1u == (gen + 1u) * nloc) {
            __builtin_amdgcn_fence(__ATOMIC_RELEASE, "agent");
            asm volatile("s_waitcnt vmcnt(0)" ::: "memory");
            const unsigned og = xb_add(&bar[XB_TOP], 1u);
            const unsigned tg = og / nx;
            if (og + 1u == (tg + 1u) * nx) xb_add(&bar[XB_TOPGEN], 1u);
            else XB_SPIN(xb_ld(&bar[XB_TOPGEN]) == tg, bar);
            __builtin_amdgcn_fence(__ATOMIC_ACQUIRE, "agent");
            xb_add(&bar[XB_XGEN(b.x)], 1u);
            asm volatile("s_waitcnt vmcnt(0)" ::: "memory");
        } else {
            XB_SPIN(xb_ld(&bar[XB_XGEN(b.x)]) == gen, bar);
            __builtin_amdgcn_fence(__ATOMIC_ACQUIRE, "agent");
            asm volatile("s_waitcnt vmcnt(0)" ::: "memory");
        }
    }
    __syncthreads();
}

constexpr int NWAVES = 8;
constexpr int RING_OFF = 0, RING_BYTES = 131072;
constexpr int LDSCTL_OFF = RING_BYTES, MISC_OFF = LDSCTL_OFF + 320;
constexpr int LDS_BYTES = 147456;
constexpr int CW_BAR = 4096;
constexpr int MAX_LAUNCHES = 24;
static_assert((CW_BAR + MAX_LAUNCHES * XCD_BAR_WORDS) * 4 <= (int)CTL_ZERO_BYTES, "barrier regions inside the memset region");
constexpr int PH_PER_LAYER = 8, PH_TOTAL = 1 + NL * PH_PER_LAYER;
enum { PH_A = 0, PH_M1 = 1, PH_M2 = 2, PH_M3 = 3, PH_G = 4, PH_C = 5, PH_D = 6, PH_T = 7 };

struct Args { const float* in[19]; float* out; unsigned char* ws; int ph_lo, ph_hi, li, pad; };

__device__ __forceinline__ float wave_sum(float v) {
#pragma unroll
    for (int o = 1; o < 64; o <<= 1) v += __shfl_xor(v, o);
    return v;
}
__device__ __forceinline__ unsigned pk2(float lo, float hi) { return (unsigned)f2bf(lo) | ((unsigned)f2bf(hi) << 16); }
typedef float f32x4_t __attribute__((ext_vector_type(4)));
typedef unsigned u32x4_t __attribute__((ext_vector_type(4)));

__device__ __forceinline__ void transpose_item(const float* W_, int K, int N, bf16_t* WT_, LAS float* scr, int item, int lane, const float* gk_ = nullptr, int ldw_ = 0) {
    const GAS float* W = (const GAS float*)W_; GAS bf16_t* WT = (GAS bf16_t*)WT_; const int ldw = ldw_ ? ldw_ : N;
    const int nblk = N / 32, kb = item / nblk, nb = item % nblk, k0 = 64 * kb, n0 = 32 * nb;
    float tv[32];
#pragma unroll
    for (int i = 0; i < 32; ++i) { const int kk = 2 * i + (lane >> 5); tv[i] = W[(size_t)(k0 + kk) * ldw + n0 + (lane & 31)]; }
    asm volatile("" ::: "memory");
#pragma unroll
    for (int i = 0; i < 32; ++i) { const int kk = 2 * i + (lane >> 5); scr[kk * 33 + (lane & 31)] = tv[i]; }
    asm volatile("s_waitcnt lgkmcnt(0)" ::: "memory");
    const int c = lane & 7;
    f32x4_t g0 = {1.f, 1.f, 1.f, 1.f}, g1 = g0;
    if (gk_) { const GAS f32x4_t* gp = (const GAS f32x4_t*)((const GAS float*)gk_ + k0 + 8 * c); g0 = gp[0]; g1 = gp[1]; }
#pragma unroll
    for (int j = 0; j < 4; ++j) { const int n = (lane >> 3) + 8 * j; const LAS float* s = scr + (8 * c) * 33 + n;
        u32x4_t o; o.x = pk2(s[0 * 33] * g0.x, s[1 * 33] * g0.y); o.y = pk2(s[2 * 33] * g0.z, s[3 * 33] * g0.w); o.z = pk2(s[4 * 33] * g1.x, s[5 * 33] * g1.y); o.w = pk2(s[6 * 33] * g1.z, s[7 * 33] * g1.w);
        *(GAS u32x4_t*)(WT + (size_t)(n0 + n) * K + k0 + 8 * c) = o; }
    asm volatile("s_waitcnt lgkmcnt(0)" ::: "memory");
}
__device__ __forceinline__ void convert_weights(unsigned char* ws, const float* w_in_all, const float* w_gate_all, const float* w_branch_all, const float* w_out_all, const float* norm_pre_all, int l, int mask, LAS unsigned char* lds, int gw, int NGW, int wave, int lane) {
    const float* gpre = norm_pre_all + (size_t)l * ND;
    LAS float* scr = (LAS float*)(lds + RING_OFF + wave * 16384);
    const float* w_in = w_in_all + (size_t)l * ND * NU; const float* w_gate = w_gate_all + (size_t)l * 5 * ND * ND;
    const float* w_branch = w_branch_all + (size_t)l * 5 * NW * ND; const float* w_out = w_out_all + (size_t)l * ND * ND;
    constexpr int I_IN = (ND / 64) * (NU_BF / 32), I_G = (ND / 64) * (ND / 32), I_B = (NW / 64) * (ND / 32), I_O = I_G;
    if (mask & 1) for (int it = gw; it < I_IN; it += NGW) transpose_item(w_in, ND, NU_BF, (bf16_t*)(ws + WS_WIN), scr, it, lane, gpre, NU);
    if (mask & 2) for (int it = gw; it < 5 * I_B + I_O; it += NGW) {
        int r = it;
        if (r < 5 * I_B) { const int n = r / I_B; transpose_item(w_branch + (size_t)n * NW * ND, NW, ND, (bf16_t*)(ws + WS_WB) + (size_t)n * ND * NW, scr, r - n * I_B, lane); continue; } r -= 5 * I_B;
        transpose_item(w_out, ND, ND, (bf16_t*)(ws + WS_WO), scr, r, lane);
    }
    (void)w_gate; (void)I_G;
}
__device__ __forceinline__ unsigned q8pack(float a, float b, float c, float d) {
    const int ia = __float2int_rn(a), ib = __float2int_rn(b), ic = __float2int_rn(c), id = __float2int_rn(d);
    return (unsigned)(ia & 0xff) | ((unsigned)(ib & 0xff) << 8) | ((unsigned)(ic & 0xff) << 16) | ((unsigned)(id & 0xff) << 24);
}
__device__ __forceinline__ void colmax_item(int item, const float* w_gate_all, const float* norm_pre_all, float* CQ_, int lane) {
    const int kblk = item & 7, nblk = (item >> 3) & 15, lb = item >> 7, l = lb / 5, br = lb - l * 5;
    const GAS float* W = (const GAS float*)w_gate_all + ((size_t)(l * 5 + br) * ND + kblk * 128) * ND + nblk * 64 + lane;
    const GAS float* g = (const GAS float*)norm_pre_all + (size_t)l * ND + kblk * 128;
    float mx = 0.f;
#pragma unroll
    for (int kb = 0; kb < 128; kb += 64) {
        float wv[64];
#pragma unroll
        for (int k = 0; k < 64; ++k) wv[k] = W[(size_t)(kb + k) * ND];
        asm volatile("" ::: "memory");
#pragma unroll
        for (int k = 0; k < 64; ++k) mx = fmaxf(mx, fabsf(wv[k] * g[kb + k]));
    }
    atomicMax((unsigned*)CQ_ + (size_t)l * 5120 + br * 1024 + nblk * 64 + lane, __float_as_uint(mx));
}
__device__ __forceinline__ void colmax_in_item(int item, const float* w_in_all, const float* norm_pre_all, float* CQ_, int lane) {
    const int kblk = item & 7, ln = item >> 3, l = ln / 52, nblk = ln - l * 52;
    const GAS float* W = (const GAS float*)w_in_all + ((size_t)l * ND + kblk * 128) * NU + NU_BF + nblk * 64 + lane;
    const GAS float* g = (const GAS float*)norm_pre_all + (size_t)l * ND + kblk * 128;
    float mx = 0.f;
#pragma unroll
    for (int kb = 0; kb < 128; kb += 64) {
        float wv[64];
#pragma unroll
        for (int k = 0; k < 64; ++k) wv[k] = W[(size_t)(kb + k) * NU];
        asm volatile("" ::: "memory");
#pragma unroll
        for (int k = 0; k < 64; ++k) mx = fmaxf(mx, fabsf(wv[k] * g[kb + k]));
    }
    atomicMax((unsigned*)CQ_ + (size_t)l * NU_I8 + nblk * 64 + lane, __float_as_uint(mx));
}
template <int N = ND, int LDW = ND>
__device__ __forceinline__ void wg8_item(const float* Wbr_, const float* gk_, const float* cqn_, unsigned char* WT8_, LAS float* scr, int item, int lane) {
    const GAS float* W = (const GAS float*)Wbr_; GAS unsigned char* WT = (GAS unsigned char*)WT8_;
    constexpr int K = ND;
    const int nblk = N / 32, kb = item / nblk, nb = item % nblk, k0 = 64 * kb, n0 = 32 * nb;
    float tv[32];
#pragma unroll
    for (int i = 0; i < 32; ++i) { const int kk = 2 * i + (lane >> 5); tv[i] = W[(size_t)(k0 + kk) * LDW + n0 + (lane & 31)]; }
    asm volatile("" ::: "memory");
#pragma unroll
    for (int i = 0; i < 32; ++i) { const int kk = 2 * i + (lane >> 5); scr[kk * 33 + (lane & 31)] = tv[i]; }
    asm volatile("s_waitcnt lgkmcnt(0)" ::: "memory");
    const int c = lane & 7;
    const GAS f32x4_t* gp = (const GAS f32x4_t*)((const GAS float*)gk_ + k0 + 8 * c); const f32x4_t g0 = gp[0], g1 = gp[1];
#pragma unroll
    for (int j = 0; j < 4; ++j) { const int nn = (lane >> 3) + 8 * j; const LAS float* s = scr + (8 * c) * 33 + nn;
        const float cqv = DBG_CQ ? 0.25f : ((const GAS float*)cqn_)[n0 + nn]; const float inv = cqv > 0.f ? 127.f / cqv : 0.f;
        gu32x2 o; o.x = q8pack(s[0 * 33] * g0.x * inv, s[1 * 33] * g0.y * inv, s[2 * 33] * g0.z * inv, s[3 * 33] * g0.w * inv);
        o.y = q8pack(s[4 * 33] * g1.x * inv, s[5 * 33] * g1.y * inv, s[6 * 33] * g1.z * inv, s[7 * 33] * g1.w * inv);
        *(GAS gu32x2*)(WT + (size_t)(n0 + nn) * K + k0 + 8 * c) = o; }
    asm volatile("s_waitcnt lgkmcnt(0)" ::: "memory");
}
__device__ __forceinline__ void convert_wg8(const float* w_gate_all, const float* norm_pre_all, const float* CQ, unsigned char* WG8, int l, LAS unsigned char* lds, int gw, int NGW, int wave, int lane) {
    LAS float* scr = (LAS float*)(lds + RING_OFF + wave * 16384);
    constexpr int I_G = (ND / 64) * (ND / 32);
    for (int it = gw; it < 5 * I_G; it += NGW) { const int br = it / I_G;
        wg8_item(w_gate_all + ((size_t)l * 5 + br) * ND * ND, norm_pre_all + (size_t)l * ND, CQ + (size_t)l * 5120 + br * 1024, WG8 + (size_t)br * ND * ND, scr, it - br * I_G, lane); }
}
__device__ __forceinline__ void convert_win8(const float* w_in_all, const float* norm_pre_all, const float* CQI, unsigned char* WIN8, int l, LAS unsigned char* lds, int gw, int NGW, int wave, int lane) {
    LAS float* scr = (LAS float*)(lds + RING_OFF + wave * 16384);
    constexpr int I_Q = (ND / 64) * (NU_I8 / 32);
    for (int it = gw; it < I_Q; it += NGW)
        wg8_item<NU_I8, NU>(w_in_all + (size_t)l * ND * NU + NU_BF, norm_pre_all + (size_t)l * ND, CQI + (size_t)l * NU_I8, WIN8, scr, it, lane);
}
__device__ __forceinline__ void rms_row_to_bf16(const float* xrow, const float* g, bf16_t* orow, int lane) {
    const GAS f32x4_t* xr = (const GAS f32x4_t*)xrow + lane; const GAS f32x4_t* gr = (const GAS f32x4_t*)g + lane;
    f32x4_t v[4]; float s = 0.f;
#pragma unroll
    for (int j = 0; j < 4; ++j) { v[j] = xr[64 * j]; s += (v[j].x * v[j].x + v[j].y * v[j].y) + (v[j].z * v[j].z + v[j].w * v[j].w); }
    const float r = rsqrtf(wave_sum(s) * (1.f / ND) + EPSF);
    GAS unsigned long long* o8 = (GAS unsigned long long*)orow + lane;
#pragma unroll
    for (int j = 0; j < 4; ++j) { const f32x4_t gg = gr[64 * j];
        o8[64 * j] = (unsigned long long)pk2(v[j].x * r * gg.x, v[j].y * r * gg.y) | ((unsigned long long)pk2(v[j].z * r * gg.z, v[j].w * r * gg.w) << 32); }
}
__device__ __forceinline__ void post_row(const float* xrow, const bf16_t* orow, const float* g_post, const float* g_next, float* xout, bf16_t* hrow, bool has_next, int lane) {
    const GAS f32x4_t* xr = (const GAS f32x4_t*)xrow + lane; const GAS unsigned long long* o8 = (const GAS unsigned long long*)orow + lane;
    f32x4_t v[4]; float s = 0.f;
#pragma unroll
    for (int j = 0; j < 4; ++j) { const unsigned long long w = o8[64 * j]; const unsigned lo = (unsigned)w, hi = (unsigned)(w >> 32);
        v[j].x = __uint_as_float(lo << 16); v[j].y = __uint_as_float(lo & 0xffff0000u); v[j].z = __uint_as_float(hi << 16); v[j].w = __uint_as_float(hi & 0xffff0000u);
        s += (v[j].x * v[j].x + v[j].y * v[j].y) + (v[j].z * v[j].z + v[j].w * v[j].w); }
    const float r = rsqrtf(wave_sum(s) * (1.f / ND) + EPSF);
    float s2 = 0.f;
#pragma unroll
    for (int j = 0; j < 4; ++j) { const f32x4_t gg = ((const GAS f32x4_t*)g_post + lane)[64 * j]; const f32x4_t xx = xr[64 * j];
        v[j].x = xx.x + v[j].x * r * gg.x; v[j].y = xx.y + v[j].y * r * gg.y; v[j].z = xx.z + v[j].z * r * gg.z; v[j].w = xx.w + v[j].w * r * gg.w;
        s2 += (v[j].x * v[j].x + v[j].y * v[j].y) + (v[j].z * v[j].z + v[j].w * v[j].w);
        ((GAS f32x4_t*)xout + lane)[64 * j] = v[j]; }
    if (has_next) {
        const float r2 = rsqrtf(wave_sum(s2) * (1.f / ND) + EPSF);
        GAS unsigned long long* h8 = (GAS unsigned long long*)hrow + lane;
#pragma unroll
        for (int j = 0; j < 4; ++j) { const f32x4_t gg = ((const GAS f32x4_t*)g_next + lane)[64 * j];
            h8[64 * j] = (unsigned long long)pk2(v[j].x * r2 * gg.x, v[j].y * r2 * gg.y) | ((unsigned long long)pk2(v[j].z * r2 * gg.z, v[j].w * r2 * gg.w) << 32); }
    }
}


__device__ __forceinline__ void post_rows(const float* xin_, const bf16_t* outraw_, const float* g_post_, const float* g_next_, float* xout_, bf16_t* H_, bool has_next, int gw, int NGW, int lane) {
    const GAS f32x4_t* xin = (const GAS f32x4_t*)xin_ + lane; const GAS unsigned long long* orw = (const GAS unsigned long long*)outraw_ + lane;
    GAS f32x4_t* xout = (GAS f32x4_t*)xout_ + lane; GAS unsigned long long* H8 = (GAS unsigned long long*)H_ + lane;
    f32x4_t gp[4], gn[4];
#pragma unroll
    for (int j = 0; j < 4; ++j) { gp[j] = ((const GAS f32x4_t*)g_post_ + lane)[64 * j]; gn[j] = ((const GAS f32x4_t*)g_next_ + lane)[64 * j]; }
    f32x4_t xn[4]; unsigned long long on[4];
    int m = gw;
    if (m < NM) {
#pragma unroll
        for (int j = 0; j < 4; ++j) { xn[j] = xin[(size_t)m * 256 + 64 * j]; on[j] = orw[(size_t)m * 256 + 64 * j]; }
    }
    for (; m < NM; m += NGW) {
        f32x4_t v[4], xc[4]; float s = 0.f;
#pragma unroll
        for (int j = 0; j < 4; ++j) { xc[j] = xn[j]; const unsigned lo = (unsigned)on[j], hi = (unsigned)(on[j] >> 32);
            v[j].x = __uint_as_float(lo << 16); v[j].y = __uint_as_float(lo & 0xffff0000u); v[j].z = __uint_as_float(hi << 16); v[j].w = __uint_as_float(hi & 0xffff0000u);
            s += (v[j].x * v[j].x + v[j].y * v[j].y) + (v[j].z * v[j].z + v[j].w * v[j].w); }
        const int m2 = m + NGW;
        if (m2 < NM) {
#pragma unroll
            for (int j = 0; j < 4; ++j) { xn[j] = xin[(size_t)m2 * 256 + 64 * j]; on[j] = orw[(size_t)m2 * 256 + 64 * j]; }
        }
        asm volatile("" ::: "memory");
        const float r = rsqrtf(wave_sum(s) * (1.f / ND) + EPSF);
        float s2 = 0.f;
#pragma unroll
        for (int j = 0; j < 4; ++j) { v[j] = xc[j] + v[j] * r * gp[j]; s2 += (v[j].x * v[j].x + v[j].y * v[j].y) + (v[j].z * v[j].z + v[j].w * v[j].w); xout[(size_t)m * 256 + 64 * j] = v[j]; }
        if (has_next) {
            const float r2 = rsqrtf(wave_sum(s2) * (1.f / ND) + EPSF);
#pragma unroll
            for (int j = 0; j < 4; ++j) { const f32x4_t o = v[j] * r2 * gn[j];
                H8[(size_t)m * 256 + 64 * j] = (unsigned long long)pk2(o.x, o.y) | ((unsigned long long)pk2(o.z, o.w) << 32); }
        }
    }
}

__device__ __forceinline__ void rms_rows(const float* x_, const float* g_, int gdiv, bf16_t* out_, int nrows, int gw, int NGW, int lane) {
    const GAS f32x4_t* xin = (const GAS f32x4_t*)x_ + lane; GAS unsigned long long* o8 = (GAS unsigned long long*)out_ + lane;
    f32x4_t xn[4];
    int m = gw;
    if (m < nrows) {
#pragma unroll
        for (int j = 0; j < 4; ++j) xn[j] = xin[(size_t)(gdiv ? m % gdiv : m) * 256 + 64 * j];
    }
    for (; m < nrows; m += NGW) {
        f32x4_t v[4]; float s = 0.f;
#pragma unroll
        for (int j = 0; j < 4; ++j) { v[j] = xn[j]; s += (v[j].x * v[j].x + v[j].y * v[j].y) + (v[j].z * v[j].z + v[j].w * v[j].w); }
        const int m2 = m + NGW;
        if (m2 < nrows) {
#pragma unroll
            for (int j = 0; j < 4; ++j) xn[j] = xin[(size_t)(gdiv ? m2 % gdiv : m2) * 256 + 64 * j];
        }
        const GAS f32x4_t* gr = (const GAS f32x4_t*)(g_ + (gdiv ? (size_t)(m / gdiv) * ND : 0)) + lane;
        f32x4_t gg[4];
#pragma unroll
        for (int j = 0; j < 4; ++j) gg[j] = gr[64 * j];
        asm volatile("" ::: "memory");
        const float r = rsqrtf(wave_sum(s) * (1.f / ND) + EPSF);
#pragma unroll
        for (int j = 0; j < 4; ++j) o8[(size_t)m * 256 + 64 * j] = (unsigned long long)pk2(v[j].x * r * gg[j].x, v[j].y * r * gg[j].y) | ((unsigned long long)pk2(v[j].z * r * gg[j].z, v[j].w * r * gg[j].w) << 32);
    }
}

__device__ __forceinline__ void x_to_bf16_rows(const float* x_, bf16_t* XB_, float* RS_, unsigned char* X8_, float* RQ_, int gw, int NGW, int lane) {
    const GAS f32x4_t* xin = (const GAS f32x4_t*)x_ + 2 * lane; GAS u32x4_t* o16 = (GAS u32x4_t*)XB_ + lane; GAS float* RS = (GAS float*)RS_;
    GAS gu32x2* q8 = (GAS gu32x2*)X8_ + lane; GAS float* RQ = (GAS float*)RQ_;
    for (int m = gw; m < NM; m += NGW) {
        f32x4_t v[4]; float s = 0.f, amx = 0.f;
#pragma unroll
        for (int j = 0; j < 4; ++j) { v[j] = xin[(size_t)m * 256 + 128 * (j >> 1) + (j & 1)]; s += (v[j].x * v[j].x + v[j].y * v[j].y) + (v[j].z * v[j].z + v[j].w * v[j].w);
            amx = fmaxf(amx, fmaxf(fmaxf(fabsf(v[j].x), fabsf(v[j].y)), fmaxf(fabsf(v[j].z), fabsf(v[j].w)))); }
#pragma unroll
        for (int o = 1; o < 64; o <<= 1) { s += __shfl_xor(s, o); amx = fmaxf(amx, __shfl_xor(amx, o)); }
        const float r = rsqrtf(s * (1.f / ND) + EPSF), inv = amx > 0.f ? 127.f / amx : 0.f;
#pragma unroll
        for (int c = 0; c < 2; ++c) { const f32x4_t a = v[2 * c], b = v[2 * c + 1];
            o16[(size_t)m * 128 + 64 * c] = (u32x4_t){pk2(a.x, a.y), pk2(a.z, a.w), pk2(b.x, b.y), pk2(b.z, b.w)};
            q8[(size_t)m * 128 + 64 * c] = (gu32x2){q8pack(a.x * inv, a.y * inv, a.z * inv, a.w * inv), q8pack(b.x * inv, b.y * inv, b.z * inv, b.w * inv)}; }
        if (lane == 0) { RS[m] = r; RQ[m] = r * amx * (1.f / 127.f); }
    }
}
__device__ __forceinline__ void post_rows_bf(bf16_t* XB_, const bf16_t* outraw_, const float* g_post_, float* xout_, float* RS_, unsigned char* X8_, float* RQ_, bool last, int gw, int NGW, int lane) {
    GAS gu32x2* q8 = (GAS gu32x2*)X8_ + lane; GAS float* RQ = (GAS float*)RQ_;
    GAS u32x4_t* xb = (GAS u32x4_t*)XB_ + lane; const GAS u32x4_t* orw = (const GAS u32x4_t*)outraw_ + lane;
    GAS f32x4_t* xout = (GAS f32x4_t*)xout_ + 2 * lane; GAS float* RS = (GAS float*)RS_;
    f32x4_t gp[4];
#pragma unroll
    for (int j = 0; j < 4; ++j) gp[j] = ((const GAS f32x4_t*)g_post_ + 2 * lane)[128 * (j >> 1) + (j & 1)];
    u32x4_t xn[2], on[2];
    int m = gw;
    if (m < NM) {
#pragma unroll
        for (int c = 0; c < 2; ++c) { xn[c] = xb[(size_t)m * 128 + 64 * c]; on[c] = orw[(size_t)m * 128 + 64 * c]; }
    }
    for (; m < NM; m += NGW) {
        f32x4_t v[4], xc[4]; float s = 0.f;
#pragma unroll
        for (int c = 0; c < 2; ++c) {
            v[2 * c].x = __uint_as_float(on[c].x << 16); v[2 * c].y = __uint_as_float(on[c].x & 0xffff0000u); v[2 * c].z = __uint_as_float(on[c].y << 16); v[2 * c].w = __uint_as_float(on[c].y & 0xffff0000u);
            v[2 * c + 1].x = __uint_as_float(on[c].z << 16); v[2 * c + 1].y = __uint_as_float(on[c].z & 0xffff0000u); v[2 * c + 1].z = __uint_as_float(on[c].w << 16); v[2 * c + 1].w = __uint_as_float(on[c].w & 0xffff0000u);
            xc[2 * c].x = __uint_as_float(xn[c].x << 16); xc[2 * c].y = __uint_as_float(xn[c].x & 0xffff0000u); xc[2 * c].z = __uint_as_float(xn[c].y << 16); xc[2 * c].w = __uint_as_float(xn[c].y & 0xffff0000u);
            xc[2 * c + 1].x = __uint_as_float(xn[c].z << 16); xc[2 * c + 1].y = __uint_as_float(xn[c].z & 0xffff0000u); xc[2 * c + 1].z = __uint_as_float(xn[c].w << 16); xc[2 * c + 1].w = __uint_as_float(xn[c].w & 0xffff0000u);
        }
#pragma unroll
        for (int j = 0; j < 4; ++j) s += (v[j].x * v[j].x + v[j].y * v[j].y) + (v[j].z * v[j].z + v[j].w * v[j].w);
        const int m2 = m + NGW;
        if (m2 < NM) {
#pragma unroll
            for (int c = 0; c < 2; ++c) { xn[c] = xb[(size_t)m2 * 128 + 64 * c]; on[c] = orw[(size_t)m2 * 128 + 64 * c]; }
        }
        asm volatile("" ::: "memory");
        const float r = rsqrtf(wave_sum(s) * (1.f / ND) + EPSF);
        float s2 = 0.f;
#pragma unroll
        for (int j = 0; j < 4; ++j) { v[j] = xc[j] + v[j] * r * gp[j]; s2 += (v[j].x * v[j].x + v[j].y * v[j].y) + (v[j].z * v[j].z + v[j].w * v[j].w); }
        if (last) {
#pragma unroll
            for (int j = 0; j < 4; ++j) xout[(size_t)m * 256 + 128 * (j >> 1) + (j & 1)] = v[j];
        } else {
            float amx = 0.f;
#pragma unroll
            for (int j = 0; j < 4; ++j) amx = fmaxf(amx, fmaxf(fmaxf(fabsf(v[j].x), fabsf(v[j].y)), fmaxf(fabsf(v[j].z), fabsf(v[j].w))));
#pragma unroll
            for (int o = 1; o < 64; o <<= 1) { s2 += __shfl_xor(s2, o); amx = fmaxf(amx, __shfl_xor(amx, o)); }
            const float r2 = rsqrtf(s2 * (1.f / ND) + EPSF), inv = amx > 0.f ? 127.f / amx : 0.f;
#pragma unroll
            for (int c = 0; c < 2; ++c) { const f32x4_t a = v[2 * c], b = v[2 * c + 1];
                xb[(size_t)m * 128 + 64 * c] = (u32x4_t){pk2(a.x, a.y), pk2(a.z, a.w), pk2(b.x, b.y), pk2(b.z, b.w)};
                q8[(size_t)m * 128 + 64 * c] = (gu32x2){q8pack(a.x * inv, a.y * inv, a.z * inv, a.w * inv), q8pack(b.x * inv, b.y * inv, b.z * inv, b.w * inv)}; }
            if (lane == 0) { RS[m] = r2; RQ[m] = r2 * amx * (1.f / 127.f); }
        }
    }
}

typedef short bf16x8_t __attribute__((ext_vector_type(8)));
typedef float f32x16_t __attribute__((ext_vector_type(16)));
#define MIX_LAS __attribute__((address_space(3)))
typedef float f32x4m __attribute__((ext_vector_type(4)));
typedef unsigned u32x4m __attribute__((ext_vector_type(4)));
__device__ __forceinline__ float wsum_(float v) {
#pragma unroll
    for (int o = 1; o < 64; o <<= 1) v += __shfl_xor(v, o);
    return v;
}
constexpr int KROW = 144;
__device__ __forceinline__ int crow_(int r, int hi) { return (r & 3) + 8 * (r >> 2) + 4 * hi; }
typedef float f32x2m __attribute__((ext_vector_type(2))); typedef __bf16 bf16x2m __attribute__((ext_vector_type(2)));
__device__ __forceinline__ unsigned pkbf(float lo, float hi) { f32x2m v = {lo, hi}; bf16x2m b = __builtin_convertvector(v, bf16x2m); return __builtin_bit_cast(unsigned, b); }

template <bool WIN>
__device__ __forceinline__ void attn_core(const MIX_LAS unsigned char* Kl, const MIX_LAS unsigned char* VTl, int vt_stride, const MIX_LAS float* biasl,
                                          const bf16x8_t (&qf)[4], int t_lo, int t_hi, int t_int_lo, int t_int_hi, int qi_band, float m0, float l0,
                                          const GAS bf16_t* zrow, GAS bf16_t* yrow, int lane) {
    constexpr float C2 = 0.125f * 1.4426950408889634f;
    const int r32 = lane & 31, hi = lane >> 5;
    gu32x2 zpre[2][4];
#pragma unroll
    for (int dt = 0; dt < 2; ++dt)
#pragma unroll
        for (int g4 = 0; g4 < 4; ++g4) zpre[dt][g4] = *(const GAS gu32x2*)(zrow + dt * 32 + 8 * g4 + 4 * hi);
    f32x16_t O0, O1;
#pragma unroll
    for (int r = 0; r < 16; ++r) { O0[r] = 0.f; O1[r] = 0.f; }
    float m = m0, l = l0;
    typedef unsigned u32x4v __attribute__((ext_vector_type(4)));
    for (int t = t_lo; t < t_hi; t += 2) {
        f32x16_t s0, s1;
#pragma unroll
        for (int r = 0; r < 16; ++r) { s0[r] = 0.f; s1[r] = 0.f; }
        const MIX_LAS unsigned char* kp = Kl + (t * 32 + r32) * KROW + hi * 16;
#pragma unroll
        for (int ds = 0; ds < 4; ++ds) { const bf16x8_t a0 = *(const MIX_LAS bf16x8_t*)(kp + ds * 32), a1 = *(const MIX_LAS bf16x8_t*)(kp + 32 * KROW + ds * 32);
            s0 = __builtin_amdgcn_mfma_f32_32x32x16_bf16(a0, qf[ds], s0, 0, 0, 0); s1 = __builtin_amdgcn_mfma_f32_32x32x16_bf16(a1, qf[ds], s1, 0, 0, 0); }
        if (WIN) {
            const int rel0 = t * 32 + 4 * hi - qi_band;
            const MIX_LAS float* bp = biasl + (rel0 + 128);
#pragma unroll
            for (int r = 0; r < 16; ++r) { s0[r] = s0[r] * C2 + bp[(r & 3) + 8 * (r >> 2)]; s1[r] = s1[r] * C2 + bp[32 + (r & 3) + 8 * (r >> 2)]; }
            if (t < t_int_lo || t >= t_int_hi) {
#pragma unroll
                for (int r = 0; r < 16; ++r) { const int rel = rel0 + (r & 3) + 8 * (r >> 2); s0[r] = (rel >= -128 && rel <= 128) ? s0[r] : -INFINITY; }
            }
            if (t + 1 < t_int_lo || t + 1 >= t_int_hi) {
#pragma unroll
                for (int r = 0; r < 16; ++r) { const int rel = rel0 + 32 + (r & 3) + 8 * (r >> 2); s1[r] = (rel >= -128 && rel <= 128) ? s1[r] : -INFINITY; }
            }
        } else {
#pragma unroll
            for (int r = 0; r < 16; ++r) { s0[r] *= C2; s1[r] *= C2; }
        }
        float mx = fmaxf(s0[0], s1[0]);
#pragma unroll
        for (int r = 1; r < 16; ++r) mx = fmaxf(mx, fmaxf(s0[r], s1[r]));
        mx = fmaxf(mx, __shfl_xor(mx, 32));
        if (__any(mx > m)) {
            const float mn = fmaxf(m, mx), sc = __builtin_amdgcn_exp2f(m - mn); m = mn; l *= sc;
#pragma unroll
            for (int r = 0; r < 16; ++r) { O0[r] *= sc; O1[r] *= sc; }
        }
        float ps = 0.f;
#pragma unroll
        for (int r = 0; r < 16; ++r) { const float p0 = __builtin_amdgcn_exp2f(s0[r] - m), p1 = __builtin_amdgcn_exp2f(s1[r] - m); s0[r] = p0; s1[r] = p1; ps += p0 + p1; }
        l += ps;
        u32x4v a0, a1, b0, b1;
        a0.x = pkbf(s0[0], s0[1]); a0.y = pkbf(s0[2], s0[3]); a0.z = pkbf(s0[4], s0[5]); a0.w = pkbf(s0[6], s0[7]);
        a1.x = pkbf(s0[8], s0[9]); a1.y = pkbf(s0[10], s0[11]); a1.z = pkbf(s0[12], s0[13]); a1.w = pkbf(s0[14], s0[15]);
        b0.x = pkbf(s1[0], s1[1]); b0.y = pkbf(s1[2], s1[3]); b0.z = pkbf(s1[4], s1[5]); b0.w = pkbf(s1[6], s1[7]);
        b1.x = pkbf(s1[8], s1[9]); b1.y = pkbf(s1[10], s1[11]); b1.z = pkbf(s1[12], s1[13]); b1.w = pkbf(s1[14], s1[15]);
        const bf16x8_t pf0 = __builtin_bit_cast(bf16x8_t, a0), pf1 = __builtin_bit_cast(bf16x8_t, a1), pf2 = __builtin_bit_cast(bf16x8_t, b0), pf3 = __builtin_bit_cast(bf16x8_t, b1);
        const MIX_LAS unsigned char* vp = VTl + r32 * vt_stride + (t * 32 + 8 * hi) * 2;
        const MIX_LAS unsigned char* vq = vp + 32 * vt_stride;
        { const bf16x8_t x0 = *(const MIX_LAS bf16x8_t*)(vp), y0 = *(const MIX_LAS bf16x8_t*)(vq);
          O0 = __builtin_amdgcn_mfma_f32_32x32x16_bf16(x0, pf0, O0, 0, 0, 0); O1 = __builtin_amdgcn_mfma_f32_32x32x16_bf16(y0, pf0, O1, 0, 0, 0); }
        { const bf16x8_t x0 = *(const MIX_LAS bf16x8_t*)(vp + 32), y0 = *(const MIX_LAS bf16x8_t*)(vq + 32);
          O0 = __builtin_amdgcn_mfma_f32_32x32x16_bf16(x0, pf1, O0, 0, 0, 0); O1 = __builtin_amdgcn_mfma_f32_32x32x16_bf16(y0, pf1, O1, 0, 0, 0); }
        { const bf16x8_t x0 = *(const MIX_LAS bf16x8_t*)(vp + 64), y0 = *(const MIX_LAS bf16x8_t*)(vq + 64);
          O0 = __builtin_amdgcn_mfma_f32_32x32x16_bf16(x0, pf2, O0, 0, 0, 0); O1 = __builtin_amdgcn_mfma_f32_32x32x16_bf16(y0, pf2, O1, 0, 0, 0); }
        { const bf16x8_t x0 = *(const MIX_LAS bf16x8_t*)(vp + 96), y0 = *(const MIX_LAS bf16x8_t*)(vq + 96);
          O0 = __builtin_amdgcn_mfma_f32_32x32x16_bf16(x0, pf3, O0, 0, 0, 0); O1 = __builtin_amdgcn_mfma_f32_32x32x16_bf16(y0, pf3, O1, 0, 0, 0); }
    }
    l += __shfl_xor(l, 32);
    const float inv = __builtin_amdgcn_rcpf(l);
#pragma unroll
    for (int dt = 0; dt < 2; ++dt)
#pragma unroll
        for (int g4 = 0; g4 < 4; ++g4) {
            const int d0 = dt * 32 + 8 * g4 + 4 * hi;
            const gu32x2 zw = zpre[dt][g4];
            const float z0 = __uint_as_float(zw.x << 16), z1 = __uint_as_float(zw.x & 0xffff0000u), z2 = __uint_as_float(zw.y << 16), z3 = __uint_as_float(zw.y & 0xffff0000u);
            float o0, o1, o2, o3;
            if (dt == 0) { o0 = O0[4 * g4]; o1 = O0[4 * g4 + 1]; o2 = O0[4 * g4 + 2]; o3 = O0[4 * g4 + 3]; }
            else { o0 = O1[4 * g4]; o1 = O1[4 * g4 + 1]; o2 = O1[4 * g4 + 2]; o3 = O1[4 * g4 + 3]; }
            gu32x2 w; w.x = pkbf(o0 * inv * siluf_(z0), o1 * inv * siluf_(z1)); w.y = pkbf(o2 * inv * siluf_(z2), o3 * inv * siluf_(z3));
            *(GAS gu32x2*)(yrow + d0) = w;
        }
}
template <int NK, class KP, class VP>
__device__ __forceinline__ void attn_stage(MIX_LAS unsigned char* Kl, MIX_LAS unsigned char* VTl, int vt_stride, const KP& krow, const VP& vrow, int tid) {
    constexpr int NIT = NK * 8 / 512;
    {
        u32x4m kv[NIT];
#pragma unroll
        for (int it = 0; it < NIT; ++it) { const int idx = tid + it * 512, row = idx >> 3, ch = idx & 7; const GAS bf16_t* p = krow(row);
            kv[it] = (u32x4m){0u, 0u, 0u, 0u}; if (p) kv[it] = *(const GAS u32x4m*)(p + ch * 8); }
        asm volatile("" ::: "memory");
#pragma unroll
        for (int it = 0; it < NIT; ++it) { const int idx = tid + it * 512, row = idx >> 3, ch = idx & 7; *(MIX_LAS u32x4m*)(Kl + row * KROW + ch * 16) = kv[it]; }
    }
    {
        u32x4m vv[NIT];
#pragma unroll
        for (int it = 0; it < NIT; ++it) { const int idx = tid + it * 512, ch = idx / NK, row = idx - ch * NK; const GAS bf16_t* p = vrow(row);
            vv[it] = (u32x4m){0u, 0u, 0u, 0u}; if (p) vv[it] = *(const GAS u32x4m*)(p + ch * 8); }
        asm volatile("" ::: "memory");
#pragma unroll
        for (int it = 0; it < NIT; ++it) { const int idx = tid + it * 512, ch = idx / NK, row = idx - ch * NK;
            const int w = row & 31, wp = (w & 0x13) | ((w & 4) << 1) | ((w & 8) >> 1), pos = (row & ~31) + wp;
            MIX_LAS unsigned short* dst = (MIX_LAS unsigned short*)(VTl + (ch * 8) * vt_stride + pos * 2);
            const unsigned ww[4] = {vv[it].x, vv[it].y, vv[it].z, vv[it].w};
#pragma unroll
            for (int e = 0; e < 4; ++e) { dst[(2 * e) * (vt_stride / 2)] = (unsigned short)(ww[e] & 0xffffu); dst[(2 * e + 1) * (vt_stride / 2)] = (unsigned short)(ww[e] >> 16); } }
    }
}

__device__ __forceinline__ void winattn_item(int item, const GAS bf16_t* U, const GAS float* BIAS, const GAS float* sink, GAS bf16_t* Y, MIX_LAS unsigned char* lds, int tid, bool do_core = true) {
    constexpr int NK = 384, VTS = NK * 2 + 16;
    const int qb = item & 31, kvh = (item >> 5) & 1, b = item >> 6;
    MIX_LAS unsigned char* Kl = lds; MIX_LAS unsigned char* VTl = lds + NK * KROW; MIX_LAS float* biasl = (MIX_LAS float*)(lds + NK * KROW + 64 * VTS);
    const int kpos0 = qb * 128 - 128; const size_t rowb = (size_t)b * NS;
    auto krow = [&](int i) -> const GAS bf16_t* { const int p = kpos0 + i; return (p >= 0 && p < NS) ? U + (rowb + p) * NU + C_AK + kvh * 64 : (const GAS bf16_t*)nullptr; };
    auto vrow = [&](int i) -> const GAS bf16_t* { const int p = kpos0 + i; return (p >= 0 && p < NS) ? U + (rowb + p) * NU + C_AV + kvh * 64 : (const GAS bf16_t*)nullptr; };
    attn_stage<NK>(Kl, VTl, VTS, krow, vrow, tid);
    for (int i = tid; i < 2 * 321; i += 512) { const int g_ = i / 321, j = i - g_ * 321 - 32; biasl[i] = (j >= 0 && j < 257) ? BIAS[(kvh * 2 + g_) * 257 + j] * 1.4426950408889634f : 0.f; }
    const int lane = tid & 63, wave = __builtin_amdgcn_readfirstlane(tid >> 6), g = wave >> 2, wq = wave & 3, r32 = lane & 31, hi = lane >> 5, h = kvh * 2 + g;
    const size_t mq = rowb + qb * 128 + wq * 32 + r32;
    bf16x8_t qf[4];
#pragma unroll
    for (int ds = 0; ds < 4; ++ds) qf[ds] = *(const GAS bf16x8_t*)(U + mq * NU + C_AQ + h * 64 + ds * 16 + hi * 8);
    __syncthreads();
    const int tmin = (qb == 0) ? 4 : 0, tmax = (qb == 31) ? 8 : 12;
    int t_lo = wq > tmin ? wq : tmin, t_hi = (wq + 9) < tmax ? (wq + 9) : tmax;
    if ((t_hi - t_lo) & 1) { if (t_hi < tmax) ++t_hi; else --t_lo; }
    if (do_core) attn_core<true>(Kl, VTl, VTS, biasl + g * 321 + 32, qf, t_lo, t_hi, wq + 1, wq + 8, 128 + wq * 32 + r32, sink[h] * 1.4426950408889634f, 1.f, U + mq * NU + C_AZ + h * 64, Y + mq * NY + 3 * NW + h * 64, lane);
    __syncthreads();
}
__device__ __forceinline__ void memattn_item(int item, const GAS bf16_t* U, const GAS bf16_t* MKV, GAS bf16_t* Y, MIX_LAS unsigned char* lds, int tid) {
    constexpr int NK = 256, VTS = NK * 2 + 16;
    const int qblk = item & 15, h = (item >> 4) & 3, b = item >> 6;
    MIX_LAS unsigned char* Kl = lds; MIX_LAS unsigned char* VTl = lds + NK * KROW;
    auto krow = [&](int i) -> const GAS bf16_t* { return MKV + (size_t)(b * MEML + i) * 512 + h * 64; };
    auto vrow = [&](int i) -> const GAS bf16_t* { return MKV + (size_t)(b * MEML + i) * 512 + 256 + h * 64; };
    attn_stage<NK>(Kl, VTl, VTS, krow, vrow, tid);
    const int lane = tid & 63, wave = __builtin_amdgcn_readfirstlane(tid >> 6), r32 = lane & 31, hi = lane >> 5;
    const size_t mq = (size_t)b * NS + qblk * 256 + wave * 32 + r32;
    bf16x8_t qf[4];
#pragma unroll
    for (int ds = 0; ds < 4; ++ds) qf[ds] = *(const GAS bf16x8_t*)(U + mq * NU + C_MQ + h * 64 + ds * 16 + hi * 8);
    __syncthreads();
    attn_core<false>(Kl, VTl, VTS, (const MIX_LAS float*)lds, qf, 0, 8, 0, 8, 0, -1e30f, 0.f, U + mq * NU + C_MZ + h * 64, Y + mq * NY + 4 * NW + h * 64, lane);
    __syncthreads();
}
__device__ __forceinline__ void conformer_item(int item, const GAS bf16_t* U, const GAS float* dw_w, const GAS float* dw_b, const GAS float* ln_g, const GAS float* ln_b, GAS bf16_t* Y, MIX_LAS unsigned char* lds, int tid) {
    MIX_LAS unsigned short* ul = (MIX_LAS unsigned short*)lds; MIX_LAS float* cv = (MIX_LAS float*)(lds + 94 * 512);
    const int tt = item & 63, b = item >> 6; const size_t rowb = (size_t)b * NS; const int t0 = tt * 64;
    {
        u32x4m av[6], bv[6];
#pragma unroll
        for (int it = 0; it < 6; ++it) { const int idx = tid + it * 512, row = idx >> 5, ch = idx & 31, t = t0 - 15 + row;
            av[it] = (u32x4m){0u, 0u, 0u, 0u}; bv[it] = av[it];
            if (idx < 94 * 32 && t >= 0 && t < NS) { const GAS bf16_t* p = U + (rowb + t) * NU; av[it] = *(const GAS u32x4m*)(p + C_CA + ch * 8); bv[it] = *(const GAS u32x4m*)(p + C_CB + ch * 8); } }
        asm volatile("" ::: "memory");
#pragma unroll
        for (int it = 0; it < 6; ++it) { const int idx = tid + it * 512, row = idx >> 5, ch = idx & 31;
            const unsigned aw[4] = {av[it].x, av[it].y, av[it].z, av[it].w}, bw[4] = {bv[it].x, bv[it].y, bv[it].z, bv[it].w}; unsigned ow[4];
#pragma unroll
            for (int e = 0; e < 4; ++e) ow[e] = pkbf(__uint_as_float(aw[e] << 16) * sigmoidf_(__uint_as_float(bw[e] << 16)), __uint_as_float(aw[e] & 0xffff0000u) * sigmoidf_(__uint_as_float(bw[e] & 0xffff0000u)));
            if (idx < 94 * 32) *(MIX_LAS u32x4m*)(ul + row * 256 + ch * 8) = (u32x4m){ow[0], ow[1], ow[2], ow[3]}; }
    }
    __syncthreads();
    {
        const int c = tid & 255, half = tid >> 8;
        float w[31], u[62];
#pragma unroll
        for (int j = 0; j < 31; ++j) w[j] = dw_w[j * 256 + c];
#pragma unroll
        for (int j = 0; j < 62; ++j) u[j] = __uint_as_float((unsigned)ul[(half * 32 + j) * 256 + c] << 16);
        const float bias = dw_b[c];
#pragma unroll
        for (int i = 0; i < 32; ++i) { float a = bias;
#pragma unroll
            for (int j = 0; j < 31; ++j) a += w[j] * u[i + j];
            cv[(half * 32 + i) * 256 + c] = a; }
    }
    __syncthreads();
    {
        const int lane = tid & 63, wave = tid >> 6;
        const f32x4m g4 = ((const GAS f32x4m*)ln_g)[lane], b4 = ((const GAS f32x4m*)ln_b)[lane];
        gu32x2 zpre[8];
#pragma unroll
        for (int i = 0; i < 8; ++i) zpre[i] = *(const GAS gu32x2*)(U + (rowb + t0 + wave * 8 + i) * NU + C_CZ + lane * 4);
#pragma unroll
        for (int i = 0; i < 8; ++i) { const int t = wave * 8 + i;
            const f32x4m v = *(const MIX_LAS f32x4m*)(cv + t * 256 + lane * 4);
            float s1 = (v.x + v.y) + (v.z + v.w), s2 = (v.x * v.x + v.y * v.y) + (v.z * v.z + v.w * v.w);
#pragma unroll
            for (int o_ = 1; o_ < 64; o_ <<= 1) { s1 += __shfl_xor(s1, o_); s2 += __shfl_xor(s2, o_); }
            const float mu = s1 * (1.f / 256.f);
            const f32x4m d = v - mu;
            const float var = fmaxf(s2 * (1.f / 256.f) - mu * mu, 0.f);
            const float rs = rsqrtf(var + EPSF);
            const size_t m = rowb + t0 + t;
            const gu32x2 zw = zpre[i];
            const float n0 = d.x * rs * g4.x + b4.x, n1 = d.y * rs * g4.y + b4.y, n2 = d.z * rs * g4.z + b4.z, n3 = d.w * rs * g4.w + b4.w;
            gu32x2 o; o.x = pkbf(siluf_(n0) * siluf_(__uint_as_float(zw.x << 16)), siluf_(n1) * siluf_(__uint_as_float(zw.x & 0xffff0000u)));
            o.y = pkbf(siluf_(n2) * siluf_(__uint_as_float(zw.y << 16)), siluf_(n3) * siluf_(__uint_as_float(zw.y & 0xffff0000u)));
            *(GAS gu32x2*)(Y + m * NY + 1 * NW + lane * 4) = o; }
    }
    __syncthreads();
}
__device__ __forceinline__ void shortconv_item(int item, const GAS bf16_t* U, const GAS float* w, GAS bf16_t* Y, int tid) {
    const int tt = item & 63, b = item >> 6; const size_t rowb = (size_t)b * NS;
    const int ch = tid & 31, tl = tid >> 5, t0 = tt * 64 + tl * 4;
    u32x4m cr[6], vr[6], br[4], zr[4];
#pragma unroll
    for (int r = 0; r < 6; ++r) { const int t = t0 - 1 + r; cr[r] = (u32x4m){0u, 0u, 0u, 0u}; vr[r] = cr[r];
        if (t >= 0 && t < NS) { const GAS bf16_t* p = U + (rowb + t) * NU; cr[r] = *(const GAS u32x4m*)(p + C_SC + ch * 8); vr[r] = *(const GAS u32x4m*)(p + C_SV + ch * 8); } }
#pragma unroll
    for (int i = 0; i < 4; ++i) { const GAS bf16_t* p = U + (rowb + t0 + i) * NU; br[i] = *(const GAS u32x4m*)(p + C_SB + ch * 8); zr[i] = *(const GAS u32x4m*)(p + C_SZ + ch * 8); }
    float w0[8], w1[8], w2[8];
#pragma unroll
    for (int e = 0; e < 8; ++e) { w0[e] = w[ch * 8 + e]; w1[e] = w[256 + ch * 8 + e]; w2[e] = w[512 + ch * 8 + e]; }
    asm volatile("" ::: "memory");
    float cv[6][8];
#pragma unroll
    for (int r = 0; r < 6; ++r) { const unsigned aw[4] = {cr[r].x, cr[r].y, cr[r].z, cr[r].w}, vw[4] = {vr[r].x, vr[r].y, vr[r].z, vr[r].w};
#pragma unroll
        for (int e = 0; e < 4; ++e) { cv[r][2 * e] = __uint_as_float(aw[e] << 16) * __uint_as_float(vw[e] << 16); cv[r][2 * e + 1] = __uint_as_float(aw[e] & 0xffff0000u) * __uint_as_float(vw[e] & 0xffff0000u); } }
#pragma unroll
    for (int i = 0; i < 4; ++i) {
        const unsigned bw[4] = {br[i].x, br[i].y, br[i].z, br[i].w}, zw[4] = {zr[i].x, zr[i].y, zr[i].z, zr[i].w}; unsigned ow[4];
#pragma unroll
        for (int e = 0; e < 4; ++e) {
            const float c0 = w0[2 * e] * cv[i][2 * e] + w1[2 * e] * cv[i + 1][2 * e] + w2[2 * e] * cv[i + 2][2 * e];
            const float c1 = w0[2 * e + 1] * cv[i][2 * e + 1] + w1[2 * e + 1] * cv[i + 1][2 * e + 1] + w2[2 * e + 1] * cv[i + 2][2 * e + 1];
            ow[e] = pkbf(__uint_as_float(bw[e] << 16) * c0 * siluf_(__uint_as_float(zw[e] << 16)), __uint_as_float(bw[e] & 0xffff0000u) * c1 * siluf_(__uint_as_float(zw[e] & 0xffff0000u))); }
        *(GAS u32x4m*)(Y + (rowb + t0 + i) * NY + 2 * NW + ch * 8) = (u32x4m){ow[0], ow[1], ow[2], ow[3]};
    }
}

constexpr size_t HG_ST_BYTES = (size_t)NB * 4 * 2 * 64 * 8192;
constexpr int H1_WLDS = 10240, H3_WLDS = 14848;
__device__ __forceinline__ void wave_lds_sync() { asm volatile("s_waitcnt lgkmcnt(0)" ::: "memory"); __builtin_amdgcn_wave_barrier(); asm volatile("" ::: "memory"); }
__device__ __forceinline__ void hgrn_gate(float fl, float lb, float& f, float& g) { const float s = __builtin_amdgcn_rcpf(1.f + __expf(-fl)); f = lb + (1.f - lb) * s; g = __builtin_amdgcn_logf(f) * 0.69314718056f; }
typedef unsigned u32x4h __attribute__((ext_vector_type(4)));

__device__ __forceinline__ void hgrn_h1_item(int item, const GAS bf16_t* U, const GAS float* LBl, GAS unsigned char* ST, GAS float* DC, MIX_LAS unsigned char* wl, int lane) {
    const int j = item & 63, dir = (item >> 6) & 1, h = (item >> 7) & 3, b = item >> 9;
    const int c = dir ? 63 - j : j;
    const size_t row0 = (size_t)b * NS + (size_t)c * 64;
    const int fcol = (dir ? C_HFB : C_HFF) + h * 64 + lane, vcol = C_HI + h * 64 + lane;
    const float lb = LBl[dir * 256 + h * 64 + lane];
    const int r32 = lane & 31, hi = lane >> 5;
    MIX_LAS unsigned char* KT = wl; MIX_LAS unsigned char* VT = wl + 5120;
    f32x16_t acc[2][2];
#pragma unroll
    for (int a = 0; a < 2; ++a)
#pragma unroll
        for (int bb = 0; bb < 2; ++bb)
#pragma unroll
            for (int r = 0; r < 16; ++r) acc[a][bb][r] = 0.f;
    float rsum = 0.f;
#pragma unroll
    for (int half = 0; half < 2; ++half) {
        unsigned kw[16], vw[16], fr[32], vr[32];
#pragma unroll
        for (int i = 0; i < 32; ++i) {
            const int tau = 63 - 32 * half - i, u = dir ? 63 - tau : tau;
            const GAS bf16_t* p = U + (row0 + u) * NU; fr[i] = p[fcol]; vr[i] = p[vcol];
        }
        asm volatile("" ::: "memory");
#pragma unroll
        for (int pr = 0; pr < 16; ++pr) {
            float f, g;
            hgrn_gate(__uint_as_float(fr[2 * pr] << 16), lb, f, g); const float k_hi = (1.f - f) * __expf(rsum); rsum += g;
            hgrn_gate(__uint_as_float(fr[2 * pr + 1] << 16), lb, f, g); const float k_lo = (1.f - f) * __expf(rsum); rsum += g;
            kw[15 - pr] = pkbf(k_lo, k_hi);
            vw[15 - pr] = vr[2 * pr + 1] | (vr[2 * pr] << 16);
        }
#pragma unroll
        for (int g8 = 0; g8 < 4; ++g8) {
            *(MIX_LAS u32x4h*)(KT + lane * 80 + g8 * 16) = (u32x4h){kw[4 * g8], kw[4 * g8 + 1], kw[4 * g8 + 2], kw[4 * g8 + 3]};
            *(MIX_LAS u32x4h*)(VT + lane * 80 + g8 * 16) = (u32x4h){vw[4 * g8], vw[4 * g8 + 1], vw[4 * g8 + 2], vw[4 * g8 + 3]};
        }
        wave_lds_sync();
#pragma unroll
        for (int s = 0; s < 2; ++s) {
            bf16x8_t af[2], bfr[2];
#pragma unroll
            for (int x = 0; x < 2; ++x) { af[x] = *(const MIX_LAS bf16x8_t*)(KT + (r32 + 32 * x) * 80 + (16 * s + 8 * hi) * 2); bfr[x] = *(const MIX_LAS bf16x8_t*)(VT + (r32 + 32 * x) * 80 + (16 * s + 8 * hi) * 2); }
#pragma unroll
            for (int kt = 0; kt < 2; ++kt)
#pragma unroll
                for (int vt = 0; vt < 2; ++vt) acc[kt][vt] = __builtin_amdgcn_mfma_f32_32x32x16_bf16(af[kt], bfr[vt], acc[kt][vt], 0, 0, 0);
        }
        wave_lds_sync();
    }
    DC[(size_t)item * 64 + lane] = __expf(rsum);
    GAS unsigned char* out = ST + (size_t)item * 8192;
#pragma unroll
    for (int kt = 0; kt < 2; ++kt)
#pragma unroll
        for (int vt = 0; vt < 2; ++vt)
#pragma unroll
            for (int g4 = 0; g4 < 4; ++g4) { const int k0 = 32 * kt + 8 * g4 + 4 * hi, v = 32 * vt + r32;
                gu32x2 w; w.x = pkbf(acc[kt][vt][4 * g4], acc[kt][vt][4 * g4 + 1]); w.y = pkbf(acc[kt][vt][4 * g4 + 2], acc[kt][vt][4 * g4 + 3]);
                *(GAS gu32x2*)(out + (v * 64 + k0) * 2) = w; }
}

__device__ __forceinline__ void hgrn_h2_item(int item, GAS unsigned char* ST, const GAS float* DC, int tid) {
    const int seq = item >> 2, e = (item & 3) * 512 + tid, kp = e & 31;
    GAS unsigned char* base = ST + (size_t)seq * 64 * 8192 + (size_t)e * 4;
    const GAS float* dcb = DC + (size_t)seq * 64 * 64 + kp * 2;
    float s0 = 0.f, s1 = 0.f;
    for (int j0 = 0; j0 < 64; j0 += 16) {
        unsigned hc[16]; gf32x2 dc[16];
#pragma unroll
        for (int jj = 0; jj < 16; ++jj) { hc[jj] = *(const GAS unsigned*)(base + (size_t)(j0 + jj) * 8192); dc[jj] = *(const GAS gf32x2*)(dcb + (j0 + jj) * 64); }
#pragma unroll
        for (int jj = 0; jj < 16; ++jj) {
            *(GAS unsigned*)(base + (size_t)(j0 + jj) * 8192) = pkbf(s0, s1);
            s0 = dc[jj].x * s0 + __uint_as_float(hc[jj] << 16); s1 = dc[jj].y * s1 + __uint_as_float(hc[jj] & 0xffff0000u);
        }
    }
}

template <int DIR>
__device__ __forceinline__ void hgrn_h3_dir(f32x16_t (&O)[2][2], const GAS bf16_t* U_, size_t row0, int h, float lb, const GAS unsigned char* Sp, MIX_LAS unsigned char* wl, int lane) {
    const GAS bf16_t* U = U_; asm volatile("" : "+s"(U));
    const int r32 = lane & 31, hi = lane >> 5;
    MIX_LAS unsigned char* Ql = wl; MIX_LAS unsigned char* Kl = wl + 4608; MIX_LAS unsigned char* VTl = wl + 9216; MIX_LAS float* decl = (MIX_LAS float*)(wl + 14336);
    const int fcol = (DIR ? C_HFB : C_HFF) + h * 64 + lane, qcol = C_HQ + h * 64 + lane, vcol = C_HI + h * 64 + lane;
    bf16x8_t kfA[4], vfA[2][2];
#pragma unroll
    for (int sub = 0; sub < 2; ++sub) {
        constexpr int dummy = 0; (void)dummy;
        const int tile = DIR ? 1 - sub : sub;
        float a = 0.f; unsigned vw[16];
        {
            unsigned fr[32], qr[32], vr[32];
#pragma unroll
            for (int x = 0; x < 32; ++x) { const int ul = DIR ? 31 - x : x;
                const GAS bf16_t* p = U + (row0 + 32 * tile + ul) * NU; fr[x] = p[fcol]; qr[x] = p[qcol]; vr[x] = p[vcol]; }
            asm volatile("" ::: "memory");
#pragma unroll
            for (int pr = 0; pr < 16; ++pr) {
#pragma unroll
                for (int x = 0; x < 2; ++x) {
                    const int i = 2 * pr + x, ul = DIR ? 31 - i : i;
                    float f, g; hgrn_gate(__uint_as_float(fr[i] << 16), lb, f, g); a += g;
                    const float qa = __uint_as_float(qr[i] << 16) * __expf(a), ka = (1.f - f) * __expf(fminf(-a, 80.f));
                    *(MIX_LAS unsigned short*)(Ql + ul * 144 + lane * 2) = (unsigned short)(pkbf(qa, 0.f) & 0xffffu);
                    *(MIX_LAS unsigned short*)(Kl + ul * 144 + lane * 2) = (unsigned short)(pkbf(ka, 0.f) & 0xffffu);
                }
                const int ul_even = DIR ? 30 - 2 * pr : 2 * pr;
                const int pe = (ul_even & 0x13) | ((ul_even & 4) << 1) | ((ul_even & 8) >> 1);
                vw[pe >> 1] = DIR ? (vr[2 * pr + 1] | (vr[2 * pr] << 16)) : (vr[2 * pr] | (vr[2 * pr + 1] << 16));
            }
        }
        decl[sub * 64 + lane] = __expf(a);
#pragma unroll
        for (int g8 = 0; g8 < 4; ++g8) *(MIX_LAS u32x4h*)(VTl + lane * 80 + g8 * 16) = (u32x4h){vw[4 * g8], vw[4 * g8 + 1], vw[4 * g8 + 2], vw[4 * g8 + 3]};
        wave_lds_sync();
        bf16x8_t qf[4], kf[4], vf[2][2];
#pragma unroll
        for (int ds = 0; ds < 4; ++ds) { qf[ds] = *(const MIX_LAS bf16x8_t*)(Ql + r32 * 144 + ds * 32 + hi * 16); kf[ds] = *(const MIX_LAS bf16x8_t*)(Kl + r32 * 144 + ds * 32 + hi * 16); }
#pragma unroll
        for (int vt = 0; vt < 2; ++vt)
#pragma unroll
            for (int s = 0; s < 2; ++s) vf[vt][s] = *(const MIX_LAS bf16x8_t*)(VTl + (r32 + 32 * vt) * 80 + (16 * s + 8 * hi) * 2);
        f32x16_t P;
#pragma unroll
        for (int r = 0; r < 16; ++r) P[r] = 0.f;
#pragma unroll
        for (int ds = 0; ds < 4; ++ds) P = __builtin_amdgcn_mfma_f32_32x32x16_bf16(kf[ds], qf[ds], P, 0, 0, 0);
#pragma unroll
        for (int r = 0; r < 16; ++r) { const int s_ = crow_(r, hi); const bool keep = DIR ? (s_ >= r32) : (s_ <= r32); P[r] = keep ? P[r] : 0.f; }
        {
            u32x4h p0, p1;
            p0.x = pkbf(P[0], P[1]); p0.y = pkbf(P[2], P[3]); p0.z = pkbf(P[4], P[5]); p0.w = pkbf(P[6], P[7]);
            p1.x = pkbf(P[8], P[9]); p1.y = pkbf(P[10], P[11]); p1.z = pkbf(P[12], P[13]); p1.w = pkbf(P[14], P[15]);
            const bf16x8_t pf0 = __builtin_bit_cast(bf16x8_t, p0), pf1 = __builtin_bit_cast(bf16x8_t, p1);
#pragma unroll
            for (int vt = 0; vt < 2; ++vt) { O[vt][tile] = __builtin_amdgcn_mfma_f32_32x32x16_bf16(vf[vt][0], pf0, O[vt][tile], 0, 0, 0); O[vt][tile] = __builtin_amdgcn_mfma_f32_32x32x16_bf16(vf[vt][1], pf1, O[vt][tile], 0, 0, 0); }
        }
        if (sub == 0) {
#pragma unroll
            for (int vt = 0; vt < 2; ++vt)
#pragma unroll
                for (int ks = 0; ks < 4; ++ks) { const bf16x8_t sf = *(const GAS bf16x8_t*)(Sp + ((r32 + 32 * vt) * 64 + 16 * ks + 8 * hi) * 2);
                    O[vt][tile] = __builtin_amdgcn_mfma_f32_32x32x16_bf16(sf, qf[ks], O[vt][tile], 0, 0, 0); }
#pragma unroll
            for (int ds = 0; ds < 4; ++ds) kfA[ds] = kf[ds];
#pragma unroll
            for (int vt = 0; vt < 2; ++vt) { vfA[vt][0] = vf[vt][0]; vfA[vt][1] = vf[vt][1]; }
        } else {
            bf16x8_t qd[4];
#pragma unroll
            for (int ds = 0; ds < 4; ++ds) {
                const f32x4m d0 = *(const MIX_LAS f32x4m*)(decl + 16 * ds + 8 * hi), d1 = *(const MIX_LAS f32x4m*)(decl + 16 * ds + 8 * hi + 4);
                const u32x4h qw = __builtin_bit_cast(u32x4h, qf[ds]); u32x4h o;
                o.x = pkbf(__uint_as_float(qw.x << 16) * d0.x, __uint_as_float(qw.x & 0xffff0000u) * d0.y); o.y = pkbf(__uint_as_float(qw.y << 16) * d0.z, __uint_as_float(qw.y & 0xffff0000u) * d0.w);
                o.z = pkbf(__uint_as_float(qw.z << 16) * d1.x, __uint_as_float(qw.z & 0xffff0000u) * d1.y); o.w = pkbf(__uint_as_float(qw.w << 16) * d1.z, __uint_as_float(qw.w & 0xffff0000u) * d1.w);
                qd[ds] = __builtin_bit_cast(bf16x8_t, o);
            }
            f32x16_t P2;
#pragma unroll
            for (int r = 0; r < 16; ++r) P2[r] = 0.f;
#pragma unroll
            for (int ds = 0; ds < 4; ++ds) P2 = __builtin_amdgcn_mfma_f32_32x32x16_bf16(kfA[ds], qd[ds], P2, 0, 0, 0);
            u32x4h p0, p1;
            p0.x = pkbf(P2[0], P2[1]); p0.y = pkbf(P2[2], P2[3]); p0.z = pkbf(P2[4], P2[5]); p0.w = pkbf(P2[6], P2[7]);
            p1.x = pkbf(P2[8], P2[9]); p1.y = pkbf(P2[10], P2[11]); p1.z = pkbf(P2[12], P2[13]); p1.w = pkbf(P2[14], P2[15]);
            const bf16x8_t pf0 = __builtin_bit_cast(bf16x8_t, p0), pf1 = __builtin_bit_cast(bf16x8_t, p1);
#pragma unroll
            for (int vt = 0; vt < 2; ++vt) { O[vt][tile] = __builtin_amdgcn_mfma_f32_32x32x16_bf16(vfA[vt][0], pf0, O[vt][tile], 0, 0, 0); O[vt][tile] = __builtin_amdgcn_mfma_f32_32x32x16_bf16(vfA[vt][1], pf1, O[vt][tile], 0, 0, 0); }
#pragma unroll
            for (int vt = 0; vt < 2; ++vt)
#pragma unroll
                for (int ks = 0; ks < 4; ++ks) { const bf16x8_t sf = *(const GAS bf16x8_t*)(Sp + ((r32 + 32 * vt) * 64 + 16 * ks + 8 * hi) * 2);
                    O[vt][tile] = __builtin_amdgcn_mfma_f32_32x32x16_bf16(sf, qd[ks], O[vt][tile], 0, 0, 0); }
        }
        wave_lds_sync();
    }
}
__device__ __forceinline__ void hgrn_h3_item(int item, const GAS bf16_t* U, const GAS float* LBl, const GAS float* onorm, const GAS unsigned char* ST, GAS bf16_t* Y, MIX_LAS unsigned char* wl, int lane) {
    const int c = item & 63, h = (item >> 6) & 3, b = item >> 8;
    const int r32 = lane & 31, hi = lane >> 5;
    const size_t row0 = (size_t)b * NS + (size_t)c * 64;
    f32x16_t O[2][2];
#pragma unroll
    for (int a = 0; a < 2; ++a)
#pragma unroll
        for (int bb = 0; bb < 2; ++bb)
#pragma unroll
            for (int r = 0; r < 16; ++r) O[a][bb][r] = 0.f;
    const size_t s_f = ((size_t)((b * 4 + h) * 2 + 0) * 64 + c), s_b = ((size_t)((b * 4 + h) * 2 + 1) * 64 + (63 - c));
    hgrn_h3_dir<0>(O, U, row0, h, LBl[0 * 256 + h * 64 + lane], ST + s_f * 8192, wl, lane);
    hgrn_h3_dir<1>(O, U, row0, h, LBl[1 * 256 + h * 64 + lane], ST + s_b * 8192, wl, lane);
    gu32x2 zpre[2][2][4]; f32x4m onv[2][4];
#pragma unroll
    for (int vt = 0; vt < 2; ++vt)
#pragma unroll
        for (int g4 = 0; g4 < 4; ++g4) { const int v0 = 32 * vt + 8 * g4 + 4 * hi; onv[vt][g4] = *(const GAS f32x4m*)(onorm + v0);
#pragma unroll
            for (int tile = 0; tile < 2; ++tile) zpre[tile][vt][g4] = *(const GAS gu32x2*)(U + (row0 + 32 * tile + r32) * NU + C_HZ + h * 64 + v0); }
    asm volatile("" ::: "memory");
#pragma unroll
    for (int tile = 0; tile < 2; ++tile) {
        float ss = 0.f;
#pragma unroll
        for (int vt = 0; vt < 2; ++vt)
#pragma unroll
            for (int r = 0; r < 16; ++r) ss += O[vt][tile][r] * O[vt][tile][r];
        ss += __shfl_xor(ss, 32);
        const float rs = rsqrtf(ss * (1.f / 64.f) + EPSF);
        const size_t m = row0 + 32 * tile + r32;
#pragma unroll
        for (int vt = 0; vt < 2; ++vt)
#pragma unroll
            for (int g4 = 0; g4 < 4; ++g4) { const int v0 = 32 * vt + 8 * g4 + 4 * hi;
                const gu32x2 zw = zpre[tile][vt][g4];
                const f32x4m on = onv[vt][g4];
                gu32x2 w;
                w.x = pkbf(O[vt][tile][4 * g4] * rs * on.x * siluf_(__uint_as_float(zw.x << 16)), O[vt][tile][4 * g4 + 1] * rs * on.y * siluf_(__uint_as_float(zw.x & 0xffff0000u)));
                w.y = pkbf(O[vt][tile][4 * g4 + 2] * rs * on.z * siluf_(__uint_as_float(zw.y << 16)), O[vt][tile][4 * g4 + 3] * rs * on.w * siluf_(__uint_as_float(zw.y & 0xffff0000u)));
                *(GAS gu32x2*)(Y + m * NY + h * 64 + v0) = w; }
    }
}
__global__ void __launch_bounds__(NWAVES * 64, 2) mk_fwd(Args a) {
    extern __shared__ __attribute__((aligned(16))) unsigned char lds_raw[];
    LAS unsigned char* lds = (LAS unsigned char*)lds_raw;
    volatile LAS unsigned* MISC = (volatile LAS unsigned*)(lds + MISC_OFF);
    const int wave_u = __builtin_amdgcn_readfirstlane((int)threadIdx.x >> 6);
    const int wave = wave_u;

    const int G = gridDim.x; const int bx = blockIdx.x; const int vcu = (G % 8 == 0) ? (bx % 8) * (G / 8) + bx / 8 : bx;
    const int gw = vcu * NWAVES + wave, NGW = G * NWAVES;
    unsigned char* ws = a.ws;
    for (int u = TID_(); u < (LDS_BYTES - LDSCTL_OFF) / 4; u += NWAVES * 64) ((LAS unsigned*)(lds + LDSCTL_OFF))[u] = 0u;
    __syncthreads();
    XcdBarrier bar = xcd_barrier_post((unsigned*)(ws + WS_CTL) + CW_BAR + a.li * XCD_BAR_WORDS, MISC + 8, wave_u);
    const int lo = a.ph_lo, hi = a.ph_hi;
#ifndef PROBE_DUP
#define PROBE_DUP -1
#endif
#ifndef PROBE_SUB
#define PROBE_SUB -1
#endif
#ifndef PROBE_TS
#define PROBE_TS -1
#endif
#define TS_BEGIN(k) do { if (PROBE_TS == (k) && l == 1 && bx == 0 && TID_() == 0) *(volatile unsigned*)(ws + 600 * 1024 + 64) = (unsigned)__builtin_amdgcn_s_memrealtime(); } while (0)
#define TS_END(k) do { if (PROBE_TS == (k) && l == 1 && bx == 0 && TID_() == 0) { *(volatile unsigned*)(ws + 600 * 1024) = (unsigned)__builtin_amdgcn_s_memrealtime() - *(volatile unsigned*)(ws + 600 * 1024 + 64); } } while (0)
#define REPS(k) ((PROBE_DUP == (k)) ? 2 : 1)
#define IN(k) (lo <= (k) && (k) < hi)
#define SEAM(k) do { if (IN(k) && IN((k) + 1)) { xcd_barrier(bar); if (PROBE_DUP == 200) xcd_barrier(bar); } } while (0)

#define DEFBUFS(wsp) bf16_t* const H = (bf16_t*)((wsp) + WS_H); bf16_t* const MG = (bf16_t*)((wsp) + WS_U + 160 * MiB); \
    bf16_t* const U = (bf16_t*)((wsp) + WS_U); bf16_t* const GB = (bf16_t*)((wsp) + WS_U); bf16_t* const OUTRAW = (bf16_t*)((wsp) + WS_U); \
    bf16_t* const Y = (bf16_t*)((wsp) + WS_Y); (void)H; (void)MG; (void)U; (void)GB; (void)OUTRAW; (void)Y;
    float* const X = a.out;

    if (IN(0)) for (int rep0 = 0; rep0 < (PROBE_DUP == 100 ? 2 : 1); ++rep0) {
        if (rep0) xcd_barrier(bar);
        DEFBUFS(ws)
        const int tid = TID_(), lane = tid & 63;
        if (bx == 0) {
            float* LB = (float*)(ws + WS_LB); float* BIAS = (float*)(ws + WS_BIAS); const float* lb_logits = a.in[5]; const float* rel_bias = a.in[13];
            { float v[NL], mx = -1e30f, s = 0.f;
#pragma unroll
                for (int l = 0; l < NL; ++l) { v[l] = lb_logits[l * 512 + tid]; mx = fmaxf(mx, v[l]); }
#pragma unroll
                for (int l = 0; l < NL; ++l) { v[l] = __expf(v[l] - mx); s += v[l]; }
                float c = 0.f;
#pragma unroll
                for (int l = 0; l < NL; ++l) { if (l > 0) c += v[l] / s; LB[l * 512 + tid] = c; } }
            for (int i = tid; i < 4 * 257; i += NWAVES * 64) {
                const int h = i / 257, rel = i % 257 - 128; int n = -rel; const int ret = (n < 0) ? 16 : 0; n = n < 0 ? -n : n;
                int bucket;
                if (n < 8) bucket = n; else if (n < 12) bucket = 8; else if (n < 16) bucket = 9; else if (n < 23) bucket = 10; else if (n < 32) bucket = 11;
                else if (n < 46) bucket = 12; else if (n < 64) bucket = 13; else if (n < 91) bucket = 14; else bucket = 15;
                BIAS[i] = rel_bias[(ret + bucket) * 4 + h]; }
        }
        if (wave & 4) x_to_bf16_rows(a.in[0], H, (float*)(ws + WS_RS), ws + WS_X8, (float*)(ws + WS_RQ), gw, NGW, lane);
        convert_weights(ws, a.in[4], a.in[16], a.in[17], a.in[18], a.in[2], 0, 3, lds, gw, NGW, wave, lane);
        {
            bf16_t* MEMN = (bf16_t*)(ws + WS_Y); bf16_t* WKV = (bf16_t*)(ws + WS_Y + 16 * MiB);
            for (int r = gw; r < NL * NB * MEML; r += NGW) { const int l = r / (NB * MEML), row = r - l * (NB * MEML);
                rms_row_to_bf16(a.in[1] + (size_t)row * ND, a.in[14] + l * ND, MEMN + (size_t)r * ND, lane); }
            LAS float* scr = (LAS float*)(lds + RING_OFF + wave * 16384);
            for (int it = gw; it < NL * 256; it += NGW) { const int l = it >> 8; transpose_item(a.in[15] + (size_t)l * ND * 512, ND, 512, WKV + (size_t)l * 512 * ND, scr, it & 255, lane); }
        }
        for (int it = gw; it < NL * 52 * 8; it += NGW) colmax_in_item(it, a.in[4], a.in[2], (float*)(ws + WS_CQI), lane);
        for (int it = gw; it < NL * 5 * 16 * 8; it += NGW) colmax_item(it, a.in[16], a.in[2], (float*)(ws + WS_CQ), lane);
        if (!(wave & 4)) x_to_bf16_rows(a.in[0], H, (float*)(ws + WS_RS), ws + WS_X8, (float*)(ws + WS_RQ), gw, NGW, lane);
        SEAM(0);
    }
    for (int l = 0; l < NL; ++l) {
        const int base = 1 + l * PH_PER_LAYER;
        unsigned char* wsl = ws; asm volatile("" : "+s"(wsl));
        DEFBUFS(wsl)
        if (IN(base + PH_A)) { TS_BEGIN(PH_A);
            pg8::Gemm g{H, (const bf16_t*)(wsl + WS_WIN), ND, ND, ND, 0u, 0u};
            unsigned char* WIN8 = wsl + WS_WIN + (size_t)NU_BF * ND * 2;
            if (l == 0) {
                const float* wi0 = a.in[4]; const float* np0 = a.in[2]; asm volatile("" : "+s"(wi0), "+s"(np0));
                convert_win8(wi0, np0, (const float*)(wsl + WS_CQI), WIN8, 0, lds, vcu * NWAVES + wave_u, NGW, wave_u, lane_id_());
                __syncthreads();
            }
            {
                pg8::TileOrder<1> S; S.init(NM, NU_BF, G, bx);
                pg8::EpiStore E{(GAS bf16_t*)U, NU, (const GAS float*)(wsl + WS_RS)};
                pg8::gemm_phase<pg8::EpiStore, pg8::TileOrder<1>, true>(lds + RING_OFF, g, S, E, wave_u);
            }
            if (l == 0) xcd_barrier(bar);
            {
                pg8::Gemm g8{(const bf16_t*)(wsl + WS_X8), (const bf16_t*)WIN8, ND / 2, ND / 2, ND / 2, 0u, 0u};
                pg8::TileOrder<1> S8; S8.init(NM, NU_I8, G, bx);
                pg8::EpiStoreQ E8{(GAS bf16_t*)U + NU_BF, NU, (const GAS float*)(wsl + WS_RQ), (const GAS float*)(wsl + WS_CQI) + (size_t)l * NU_I8};
                pg8::gemm_phase<pg8::EpiStoreQ, pg8::TileOrder<1>, true, true>(lds + RING_OFF, g8, S8, E8, wave_u);
            }
            if (l == 0) {
                const int u = bx - 128;
                pg8::OneUnit S2; S2.valid = (u >= 0 && u < 64); S2.u.pz = (u >> 4) & 3; S2.u.pm = (u >> 1) & 7; S2.u.pn = u & 1;
                pg8::Gemm g2{(const bf16_t*)(wsl + WS_Y), (const bf16_t*)(wsl + WS_Y + 16 * MiB), ND, ND, ND, (unsigned)(NB * MEML * ND * 2), (unsigned)(512 * ND * 2)};
                pg8::EpiStoreZ E2{(GAS bf16_t*)(wsl + WS_MEMKV), 512, (size_t)NB * MEML * 512};
                pg8::gemm_phase<pg8::EpiStoreZ, pg8::OneUnit, true>(lds + RING_OFF, g2, S2, E2, wave_u);
            }
            SEAM(base + PH_A); TS_END(PH_A);
        }
        if (IN(base + PH_M1)) { TS_BEGIN(PH_M1);
            int tl = TID_(); asm volatile("" : "+v"(tl));
            const float* cw = a.in[7]; const float* cb = a.in[8]; const float* cg = a.in[9]; const float* cbb = a.in[10]; const float* scw = a.in[11]; const float* snk = a.in[12];
            asm volatile("" : "+s"(cw), "+s"(cb), "+s"(cg), "+s"(cbb), "+s"(scw), "+s"(snk));
            const bf16_t* MKV = (const bf16_t*)(wsl + WS_MEMKV) + (size_t)l * NB * MEML * 512;
            const float* BIASp = (const float*)(wsl + WS_BIAS);
#define M1_WA for (int it = bx; it < 512; it += G) winattn_item(it, (const GAS bf16_t*)U, (const GAS float*)BIASp, (const GAS float*)(snk + l * 4), (GAS bf16_t*)Y, lds + RING_OFF, tl);
#define M1_MA for (int it = bx; it < 512; it += G) memattn_item(it, (const GAS bf16_t*)U, (const GAS bf16_t*)MKV, (GAS bf16_t*)Y, lds + RING_OFF, tl);
#define M1_CF for (int it = bx; it < 512; it += G) conformer_item(it, (const GAS bf16_t*)U, (const GAS float*)(cw + l * 31 * 256), (const GAS float*)(cb + l * 256), (const GAS float*)(cg + l * 256), (const GAS float*)(cbb + l * 256), (GAS bf16_t*)Y, lds + RING_OFF, tl);
#define M1_SC for (int it = bx; it < 512; it += G) shortconv_item(it, (const GAS bf16_t*)U, (const GAS float*)(scw + l * 3 * 256), (GAS bf16_t*)Y, tl);
#define M1_H1 { const float* LBl = (const float*)(wsl + WS_LB) + l * 512; unsigned char* ST = wsl + WS_ST; float* DC = (float*)(wsl + WS_ST + HG_ST_BYTES); \
                const int lane = tl & 63, wave = __builtin_amdgcn_readfirstlane(tl >> 6); \
                for (int it = bx * 8 + wave; it < 4096; it += G * 8) hgrn_h1_item(it, (const GAS bf16_t*)U, (const GAS float*)LBl, (GAS unsigned char*)ST, (GAS float*)DC, lds + RING_OFF + wave * H1_WLDS, lane); }
            const bool att_last = ((bx >> 3) & 1) != 0;
            if (!att_last) { M1_WA M1_MA __syncthreads(); }
            M1_CF
            M1_SC
            M1_H1
            if (att_last) { __syncthreads(); M1_WA M1_MA }
            SEAM(base + PH_M1); TS_END(PH_M1);
        }
        if (IN(base + PH_M2)) { TS_BEGIN(PH_M2);
            int tl = TID_(); asm volatile("" : "+v"(tl));
            unsigned char* ST = wsl + WS_ST; const float* DC = (const float*)(wsl + WS_ST + HG_ST_BYTES);
            for (int it = bx; it < 256; it += G) hgrn_h2_item(it, (GAS unsigned char*)ST, (const GAS float*)DC, tl);
            {
                const float* wgt = a.in[16]; const float* npre = a.in[2]; asm volatile("" : "+s"(wgt), "+s"(npre));
                convert_wg8(wgt, npre, (const float*)(wsl + WS_CQ), wsl + WS_WG8, l, lds, vcu * NWAVES + wave_u, NGW, wave_u, tl & 63);
            }
            if (PROBE_DUP == PH_M2) {
                xcd_barrier(bar);
                const float* LBl = (const float*)(wsl + WS_LB) + l * 512; const int lane = tl & 63, wave = __builtin_amdgcn_readfirstlane(tl >> 6);
                for (int it = bx * 8 + wave; it < 4096; it += G * 8) hgrn_h1_item(it, (const GAS bf16_t*)U, (const GAS float*)LBl, (GAS unsigned char*)ST, (GAS float*)DC, lds + RING_OFF + wave * H1_WLDS, lane);
                xcd_barrier(bar);
                for (int it = bx; it < 256; it += G) hgrn_h2_item(it, (GAS unsigned char*)ST, (const GAS float*)DC, tl);
            }
            SEAM(base + PH_M2); TS_END(PH_M2);
        }
        if (IN(base + PH_M3)) { TS_BEGIN(PH_M3);
            int tl = TID_(); asm volatile("" : "+v"(tl));
            const float* onp = a.in[6]; asm volatile("" : "+s"(onp));
            const float* LBl = (const float*)(wsl + WS_LB) + l * 512; const unsigned char* ST = wsl + WS_ST;
            const int lane = tl & 63, wave = __builtin_amdgcn_readfirstlane(tl >> 6);
            for (int rep = 0; rep < REPS(PH_M3); ++rep)
            for (int it = bx * 8 + wave; it < 2048; it += G * 8) hgrn_h3_item(it, (const GAS bf16_t*)U, (const GAS float*)LBl, (const GAS float*)(onp + l * 64), (const GAS unsigned char*)ST, (GAS bf16_t*)Y, lds + RING_OFF + wave * H3_WLDS, lane);
            SEAM(base + PH_M3); TS_END(PH_M3);
        }
        if (IN(base + PH_G)) { TS_BEGIN(PH_G);
            GAS bf16_t* GS = (GAS bf16_t*)(wsl + WS_U) + (size_t)bx * (5 * pg8::GS_SLOT);
            for (int ti = 0; ti * G + bx < (NM / 256) * (ND / 256); ++ti) {
                { pg8::Gemm g{(const bf16_t*)(wsl + WS_X8), (const bf16_t*)(wsl + WS_WG8), ND / 2, ND / 2, ND / 2, 0u, (unsigned)(ND * ND)};
                  pg8::TileRound<5> S; S.T.init(NM, ND, G, bx); S.ti = ti;
                  pg8::EpiGate E{GS, (const GAS float*)(wsl + WS_RQ), (const GAS float*)(wsl + WS_CQ) + (size_t)l * 5120};
                  pg8::gemm_phase<pg8::EpiGate, pg8::TileRound<5>, true, true>(lds + RING_OFF, g, S, E, wave_u); }
                { pg8::Gemm g{Y, (const bf16_t*)(wsl + WS_WB), NY, NW, NW, (unsigned)(NW * 2), (unsigned)(ND * NW * 2)};
                  pg8::TileRound<5> S; S.T.init(NM, ND, G, bx); S.ti = ti;
                  pg8::EpiMerge E{GS, (GAS bf16_t*)MG};
                  pg8::gemm_phase<pg8::EpiMerge, pg8::TileRound<5>, true>(lds + RING_OFF, g, S, E, wave_u); }
            }
        }
        if (IN(base + PH_C)) { SEAM(base + PH_C); TS_END(PH_G); }
        if (IN(base + PH_D)) { TS_BEGIN(PH_D);
            pg8::Gemm g{MG, (const bf16_t*)(wsl + WS_WO), ND, ND, ND, 0u, 0u};
            pg8::TileOrder<1> S; S.init(NM, ND, G, bx);
            pg8::EpiStoreZ E{(GAS bf16_t*)OUTRAW, ND, (size_t)0};
            for (int rep = 0; rep < REPS(PH_D); ++rep) { pg8::gemm_phase<pg8::EpiStoreZ, pg8::TileOrder<1>, true>(lds + RING_OFF, g, S, E, wave_u); if (rep + 1 < REPS(PH_D)) xcd_barrier(bar); }
            SEAM(base + PH_D); TS_END(PH_D);
        }
        if (IN(base + PH_T)) { TS_BEGIN(PH_T);
            int tl = TID_(); asm volatile("" : "+v"(tl)); const int lane = tl & 63, wave = __builtin_amdgcn_readfirstlane(tl >> 6), gw = vcu * NWAVES + wave;
            const float* npre = a.in[2]; const float* npost = a.in[3]; float* Xl = X;
            const float* wi = a.in[4]; const float* wgt = a.in[16]; const float* wbr = a.in[17]; const float* wou = a.in[18];
            asm volatile("" : "+s"(npre), "+s"(npost), "+s"(Xl), "+s"(wi), "+s"(wgt), "+s"(wbr), "+s"(wou));
            const bool has_next = (l + 1 < NL);
            post_rows_bf(H, OUTRAW, npost + l * ND, Xl, (float*)(wsl + WS_RS), wsl + WS_X8, (float*)(wsl + WS_RQ), !has_next, gw, NGW, lane);
            if (has_next) { convert_weights(wsl, wi, wgt, wbr, wou, npre, l + 1, 3, lds, gw, NGW, wave, lane);
                convert_win8(wi, npre, (const float*)(wsl + WS_CQI), wsl + WS_WIN + (size_t)NU_BF * ND * 2, l + 1, lds, gw, NGW, wave, lane); SEAM(base + PH_T); TS_END(PH_T); }
        }
    }
    if (PROBE_TS >= 0) {
        xcd_barrier(bar);
        const unsigned ticks = __hip_atomic_load((unsigned*)(ws + 600 * 1024), __ATOMIC_RELAXED, __HIP_MEMORY_SCOPE_AGENT);
        const float sc = 1.f + sqrtf((float)((ticks + 800u) / 1600u) * 1e-3f);
        for (size_t i = (size_t)bx * 512 + TID_(); i < (size_t)NM * ND / 4; i += (size_t)G * 512) { f32x4_t v = ((GAS f32x4_t*)X)[i]; v = v * sc; ((GAS f32x4_t*)X)[i] = v; }
    }
#undef IN
#undef SEAM
}

extern "C" void kernel_launch(void* const* d_in, const int* in_sizes, int n_in, void* d_out, int out_size, void* d_ws, size_t ws_size, hipStream_t stream) {
    static int grid = 0;
    if (grid == 0) {
        if (n_in != 19 || in_sizes[0] != NM * ND || out_size != NM * ND || ws_size < WS_END) {
            fprintf(stderr, "kernel_launch: unexpected shapes/workspace (n_in %d, in0 %d, out %d, ws %zu, need %zu)\n", n_in, n_in > 0 ? in_sizes[0] : -1, out_size, ws_size, (size_t)WS_END);
            grid = -1; return;
        }
        int dev = 0, cus = 0, per_cu = 0;
        if (hipGetDevice(&dev) != hipSuccess || hipDeviceGetAttribute(&cus, hipDeviceAttributeMultiprocessorCount, dev) != hipSuccess) { grid = -1; return; }
        if (hipFuncSetAttribute((const void*)mk_fwd, hipFuncAttributeMaxDynamicSharedMemorySize, LDS_BYTES) != hipSuccess) { fprintf(stderr, "kernel_launch: hipFuncSetAttribute failed\n"); grid = -1; return; }
        if (hipOccupancyMaxActiveBlocksPerMultiprocessor(&per_cu, (const void*)mk_fwd, NWAVES * 64, LDS_BYTES) != hipSuccess || per_cu < 1)
            fprintf(stderr, "kernel_launch: occupancy query reports %d workgroups per CU\n", per_cu);
        (void)hipGetLastError();
        grid = cus;
    }
    if (grid < 0) return;
    const float* x = (const float*)d_in[0]; const float* mem = (const float*)d_in[1];
    const float* lb_logits = (const float*)d_in[5]; const float* hg_onorm = (const float*)d_in[6];
    const float* conf_dw_w = (const float*)d_in[7]; const float* conf_dw_b = (const float*)d_in[8]; const float* conf_ln_g = (const float*)d_in[9]; const float* conf_ln_b = (const float*)d_in[10];
    const float* sc_w = (const float*)d_in[11]; const float* attn_sink = (const float*)d_in[12]; const float* rel_bias = (const float*)d_in[13];
    const float* mem_norm = (const float*)d_in[14]; const float* w_mem_kv = (const float*)d_in[15];
    unsigned char* ws = (unsigned char*)d_ws;
    float* LB = (float*)(ws + WS_LB); float* BIAS = (float*)(ws + WS_BIAS);
    bf16_t* MEMKV = (bf16_t*)(ws + WS_MEMKV); bf16_t* U = (bf16_t*)(ws + WS_U);
    bf16_t* Y = (bf16_t*)(ws + WS_Y); bf16_t* OHG = (bf16_t*)(ws + WS_ST);
    (void)x; (void)mem; (void)lb_logits; (void)rel_bias; (void)mem_norm; (void)w_mem_kv; (void)LB; (void)BIAS; (void)MEMKV; (void)hg_onorm; (void)U; (void)Y; (void)OHG; (void)conf_dw_w; (void)conf_dw_b; (void)conf_ln_g; (void)conf_ln_b; (void)sc_w; (void)attn_sink;

    if (hipMemsetAsync(ws + WS_CTL, 0, CTL_ZERO_BYTES, stream) != hipSuccess) return;
    Args a{};
    for (int i = 0; i < 19; ++i) a.in[i] = (const float*)d_in[i];
    a.out = (float*)d_out; a.ws = ws;
    int li = 0;
    auto launch = [&](int lo, int hi) {
        a.ph_lo = lo; a.ph_hi = hi; a.li = li++; a.pad = 0;
        hipLaunchKernelGGL(mk_fwd, dim3(grid), dim3(NWAVES * 64), LDS_BYTES, stream, a);
    };
    launch(0, PH_TOTAL);
}
```
